# Optimizing an MI355X kernel written in HIP

```python
import jax, jax.numpy as jnp
from jax import lax
import numpy as np

D_MODEL = 2048
BATCH = 2
SEQ = 4096
DEPTH = 4

GRID_W = 64
CTX_LEN = 256
N_MIXERS = 3
HEAD_DIM = 128
A_Q_HEADS = 16
A_KV_HEADS = 4
A_GROUPS = A_Q_HEADS // A_KV_HEADS
A_Q_DIM = A_Q_HEADS * HEAD_DIM
A_KV_DIM = A_KV_HEADS * HEAD_DIM
Q_BLOCK = 128
ROPE_BASE = 10000.0
B_HEADS = D_MODEL // HEAD_DIM
WIN_R = 8
WIN_C = 16
POOL_WINDOWS = (2, 4, 8, 16)
POOL_GROUP = D_MODEL // len(POOL_WINDOWS)
PEER_HEADS = 8
PEER_QDIM = 256
PEER_NKEYS = 128
PEER_N = PEER_NKEYS * PEER_NKEYS
PEER_TOPK = 16
PEER_CHUNK = 128
N_MOD = 6
EPS = 1e-6
N_A = (DEPTH + 2) // 3
N_B = (DEPTH + 1) // 3
N_C = DEPTH // 3

kernel_name = "hybrid_dit_gqa_natten_pool_peer"


def rms_norm(x, w):
    x32 = x.astype(jnp.float32)
    y = x32 * lax.rsqrt(jnp.mean(x32 * x32, axis=-1, keepdims=True) + EPS)
    return (y * w.astype(jnp.float32)).astype(x.dtype)


def modulate(h, shift, scale):
    return h * (1.0 + scale) + shift


def softmax32(s, dtype):
    return jax.nn.softmax(s.astype(jnp.float32), axis=-1).astype(dtype)


def grid_angles(S):
    t = jnp.arange(S)
    row = (t // GRID_W).astype(jnp.float32)
    col = (t % GRID_W).astype(jnp.float32)
    half = HEAD_DIM // 2
    inv = ROPE_BASE ** (-jnp.arange(0, half, 2, dtype=jnp.float32) / half)
    return row[:, None] * inv[None, :], col[:, None] * inv[None, :]


def rope_rotate(x, ang):
    shape = (ang.shape[0],) + (1,) * (x.ndim - 3) + (ang.shape[1],)
    cos = jnp.cos(ang).reshape(shape)
    sin = jnp.sin(ang).reshape(shape)
    x32 = x.astype(jnp.float32)
    x1, x2 = jnp.split(x32, 2, axis=-1)
    return jnp.concatenate([x1 * cos - x2 * sin, x2 * cos + x1 * sin], axis=-1).astype(x.dtype)


def apply_rope_2d(x, ang_row, ang_col):
    half = HEAD_DIM // 2
    return jnp.concatenate([rope_rotate(x[..., :half], ang_row), rope_rotate(x[..., half:], ang_col)], axis=-1)


def gqa_axial_attention(h_ctx, h_lat, wqkv, q_gain, k_gain, wo, need_ctx_out):
    B, S, _ = h_lat.shape
    C = h_ctx.shape[1]
    scale = HEAD_DIM ** -0.5

    def split_q(q):
        return rms_norm(q.reshape(q.shape[:2] + (A_KV_HEADS, A_GROUPS, HEAD_DIM)), q_gain)

    def split_kv(kv):
        k = rms_norm(kv[..., :A_KV_DIM].reshape(kv.shape[:2] + (A_KV_HEADS, HEAD_DIM)), k_gain)
        v = kv[..., A_KV_DIM:].reshape(kv.shape[:2] + (A_KV_HEADS, HEAD_DIM))
        return k, v

    def attend(q, k, v):
        s = jnp.einsum('bqkgd,bskd->bkgqs', q, k)
        p = softmax32(s, v.dtype)
        return jnp.einsum('bkgqs,bskd->bqkgd', p, v)

    ang_r, ang_c = grid_angles(S)
    qkv = h_lat @ wqkv
    q_lat = apply_rope_2d(split_q(qkv[..., :A_Q_DIM]), ang_r, ang_c) * scale
    k_lat, v_lat = split_kv(qkv[..., A_Q_DIM:])
    k_lat = apply_rope_2d(k_lat, ang_r, ang_c)
    k_ctx, v_ctx = split_kv(h_ctx @ wqkv[:, A_Q_DIM:])
    k_all = jnp.concatenate([k_ctx, k_lat], axis=1)
    v_all = jnp.concatenate([v_ctx, v_lat], axis=1)

    nb = S // Q_BLOCK
    q_blocks = jnp.moveaxis(q_lat.reshape(B, nb, Q_BLOCK, A_KV_HEADS, A_GROUPS, HEAD_DIM), 1, 0)
    o = lax.map(lambda qb: attend(qb, k_all, v_all), q_blocks)
    o_lat = jnp.moveaxis(o, 0, 1).reshape(B, S, A_Q_DIM) @ wo
    o_ctx = None
    if need_ctx_out:
        q_ctx = split_q(h_ctx @ wqkv[:, :A_Q_DIM]) * scale
        o_ctx = attend(q_ctx, k_ctx, v_ctx).reshape(B, C, A_Q_DIM) @ wo
    return o_ctx, o_lat


def neighborhood_attention(h_ctx, h_lat, wqkv, rpb, wo, need_ctx_out):
    B, S, D = h_lat.shape
    C = h_ctx.shape[1]
    rows = S // GRID_W
    wr = min(WIN_R, rows)
    nwin = wr * WIN_C
    scale = HEAD_DIM ** -0.5

    def heads(t):
        return t.reshape(t.shape[:2] + (B_HEADS, HEAD_DIM))

    qkv = h_lat @ wqkv
    q_lat = heads(qkv[..., :D]) * scale
    k_grid = heads(qkv[..., D:2 * D]).reshape(B, rows, GRID_W, B_HEADS, HEAD_DIM)
    v_grid = heads(qkv[..., 2 * D:]).reshape(B, rows, GRID_W, B_HEADS, HEAD_DIM)
    kv_ctx = h_ctx @ wqkv[:, D:]
    k_ctx = heads(kv_ctx[..., :D])
    v_ctx = heads(kv_ctx[..., D:])

    cols = np.arange(GRID_W)
    col_start = np.clip(cols - WIN_C // 2, 0, GRID_W - WIN_C)
    key_cols = col_start[:, None] + np.arange(WIN_C)[None, :]
    col_rel = key_cols - cols[:, None] + (WIN_C - 1)

    def row_block(args):
        r, q_row = args
        r0 = jnp.clip(r - wr // 2, 0, rows - wr)
        kw = lax.dynamic_slice_in_dim(k_grid, r0, wr, axis=1)[:, :, key_cols]
        vw = lax.dynamic_slice_in_dim(v_grid, r0, wr, axis=1)[:, :, key_cols]
        rel_r = r0 + jnp.arange(wr) - r + (WIN_R - 1)
        bias = rpb[:, rel_r][:, :, col_rel]
        bias = jnp.transpose(bias, (0, 2, 1, 3)).reshape(B_HEADS, GRID_W, nwin)
        s_win = jnp.einsum('bqhd,brqjhd->bhqrj', q_row, kw).reshape(B, B_HEADS, GRID_W, nwin) + bias
        s_ctx = jnp.einsum('bqhd,bchd->bhqc', q_row, k_ctx)
        p = softmax32(jnp.concatenate([s_win, s_ctx], axis=-1), v_ctx.dtype)
        p_win = p[..., :nwin].reshape(B, B_HEADS, GRID_W, wr, WIN_C)
        return (jnp.einsum('bhqrj,brqjhd->bqhd', p_win, vw)
                + jnp.einsum('bhqc,bchd->bqhd', p[..., nwin:], v_ctx))

    q_rows = jnp.moveaxis(q_lat.reshape(B, rows, GRID_W, B_HEADS, HEAD_DIM), 1, 0)
    o = lax.map(row_block, (jnp.arange(rows), q_rows))
    o_lat = jnp.moveaxis(o, 0, 1).reshape(B, S, D) @ wo
    o_ctx = None
    if need_ctx_out:
        q_ctx = heads(h_ctx @ wqkv[:, :D]) * scale
        p = softmax32(jnp.einsum('bqhd,bkhd->bhqk', q_ctx, k_ctx), v_ctx.dtype)
        o_ctx = jnp.einsum('bhqk,bkhd->bqhd', p, v_ctx).reshape(B, C, D) @ wo
    return o_ctx, o_lat


def multiscale_pool_mixer(h_ctx, h_lat, w_grp, ls, need_ctx_out):
    def mix(h):
        B, L, D = h.shape
        h32 = h.astype(jnp.float32)
        cs = jnp.concatenate([jnp.zeros((B, 1, D), jnp.float32), jnp.cumsum(h32, axis=1)], axis=1)
        t = np.arange(L)
        outs = []
        for g, w in enumerate(POOL_WINDOWS):
            lo = np.maximum(t - w // 2, 0)
            hi = np.minimum(t + w - w // 2, L)
            inv_cnt = (1.0 / (hi - lo)).astype(np.float32)[None, :, None]
            sl = slice(g * POOL_GROUP, (g + 1) * POOL_GROUP)
            outs.append((cs[:, hi, sl] - cs[:, lo, sl]) * inv_cnt - h32[:, :, sl])
        y = jnp.stack(outs, axis=2).astype(h.dtype)
        return jnp.einsum('blgc,gce->blge', y, w_grp).reshape(B, L, D) * ls

    o_ctx = mix(h_ctx) if need_ctx_out else None
    return o_ctx, mix(h_lat)


def peer_ffn(h, wq, sub_keys, u, v):
    T, D = h.shape
    hq = PEER_QDIM // 2

    def chunk(xc):
        q = (xc @ wq).reshape(PEER_CHUNK, PEER_HEADS, 2, hq)
        s1 = jnp.einsum('thd,kd->thk', q[:, :, 0], sub_keys[0]).astype(jnp.float32)
        s2 = jnp.einsum('thd,kd->thk', q[:, :, 1], sub_keys[1]).astype(jnp.float32)
        v1, i1 = lax.top_k(s1, PEER_TOPK)
        v2, i2 = lax.top_k(s2, PEER_TOPK)
        cand = (v1[..., :, None] + v2[..., None, :]).reshape(PEER_CHUNK, PEER_HEADS, PEER_TOPK * PEER_TOPK)
        sc, ci = lax.top_k(cand, PEER_TOPK)
        e1 = jnp.take_along_axis(i1, ci // PEER_TOPK, axis=-1)
        e2 = jnp.take_along_axis(i2, ci % PEER_TOPK, axis=-1)
        idx = e1 * PEER_NKEYS + e2
        g = jax.nn.softmax(sc, axis=-1).astype(xc.dtype)
        act = jax.nn.gelu(jnp.einsum('td,thkd->thk', xc, u[idx]))
        return jnp.einsum('thk,thkd->td', g * act, v[idx])

    out = lax.map(chunk, h.reshape(T // PEER_CHUNK, PEER_CHUNK, D))
    return out.reshape(T, D)


def setup_inputs(seed: int = 0) -> dict:
    key = jax.random.key(seed)
    ks = jax.random.split(key, 21)
    f32 = jnp.float32
    D = D_MODEL

    def nrm(k, shape, std):
        return jax.random.normal(k, shape, f32) * std

    return {
        "x": nrm(ks[0], (BATCH, SEQ, D), 1.0),
        "c": nrm(ks[1], (BATCH, D), 1.0),
        "ctx": nrm(ks[2], (BATCH, CTX_LEN, D), 1.0),
        "c_ctx": nrm(ks[3], (D,), 1.0),
        "mod_w": nrm(ks[4], (DEPTH, D, N_MOD * D), 0.5 * D ** -0.5),
        "mod_b": nrm(ks[5], (DEPTH, N_MOD * D), 0.02),
        "norm_w": 1.0 + nrm(ks[6], (DEPTH, 2, D), 0.05),
        "final_norm_w": 1.0 + nrm(ks[7], (D,), 0.05),
        "a_wqkv": nrm(ks[8], (N_A, D, A_Q_DIM + 2 * A_KV_DIM), D ** -0.5),
        "a_q_gain": 1.0 + nrm(ks[9], (N_A, HEAD_DIM), 0.05),
        "a_k_gain": 1.0 + nrm(ks[10], (N_A, HEAD_DIM), 0.05),
        "a_wo": nrm(ks[11], (N_A, A_Q_DIM, D), A_Q_DIM ** -0.5),
        "b_wqkv": nrm(ks[12], (N_B, D, 3 * D), D ** -0.5),
        "b_rpb": nrm(ks[13], (N_B, B_HEADS, 2 * WIN_R - 1, 2 * WIN_C - 1), 0.1),
        "b_wo": nrm(ks[14], (N_B, D, D), D ** -0.5),
        "pool_w": nrm(ks[15], (N_C, len(POOL_WINDOWS), POOL_GROUP, POOL_GROUP), POOL_GROUP ** -0.5),
        "pool_scale": 0.5 + nrm(ks[16], (N_C, D), 0.05),
        "peer_wq": nrm(ks[17], (DEPTH, D, PEER_HEADS * PEER_QDIM), D ** -0.5),
        "peer_sub_keys": nrm(ks[18], (DEPTH, 2, PEER_NKEYS, PEER_QDIM // 2), (PEER_QDIM // 2) ** -0.5),
        "peer_u": nrm(ks[19], (DEPTH, PEER_N, D), D ** -0.5),
        "peer_v": nrm(ks[20], (DEPTH, PEER_N, D), 0.3),
    }


def reference(x, c, ctx, c_ctx, mod_w, mod_b, norm_w, final_norm_w, a_wqkv, a_q_gain, a_k_gain, a_wo,
              b_wqkv, b_rpb, b_wo, pool_w, pool_scale, peer_wq, peer_sub_keys, peer_u, peer_v):
    B, S, D = x.shape
    C = ctx.shape[1]
    xc = ctx
    sc_lat = jax.nn.silu(c)
    sc_ctx = jax.nn.silu(c_ctx)
    for i in range(DEPTH):
        last = i == DEPTH - 1
        kind, j = i % N_MIXERS, i // N_MIXERS
        m_lat = [m[:, None, :] for m in jnp.split(sc_lat @ mod_w[i] + mod_b[i], N_MOD, axis=-1)]
        h_lat = modulate(rms_norm(x, norm_w[i, 0]), m_lat[0], m_lat[1])
        h_ctx = None
        if not (last and kind == 2):
            m_ctx = jnp.split(sc_ctx @ mod_w[i] + mod_b[i], N_MOD, axis=-1)
            h_ctx = modulate(rms_norm(xc, norm_w[i, 0]), m_ctx[0], m_ctx[1])
        if kind == 0:
            o_ctx, o_lat = gqa_axial_attention(h_ctx, h_lat, a_wqkv[j], a_q_gain[j], a_k_gain[j], a_wo[j], not last)
        elif kind == 1:
            o_ctx, o_lat = neighborhood_attention(h_ctx, h_lat, b_wqkv[j], b_rpb[j], b_wo[j], not last)
        else:
            o_ctx, o_lat = multiscale_pool_mixer(h_ctx, h_lat, pool_w[j], pool_scale[j], not last)
        x = x + m_lat[2] * o_lat
        f_lat = modulate(rms_norm(x, norm_w[i, 1]), m_lat[3], m_lat[4]).reshape(B * S, D)
        if last:
            f = peer_ffn(f_lat, peer_wq[i], peer_sub_keys[i], peer_u[i], peer_v[i])
            x = x + m_lat[5] * f.reshape(B, S, D)
        else:
            xc = xc + m_ctx[2] * o_ctx
            f_ctx = modulate(rms_norm(xc, norm_w[i, 1]), m_ctx[3], m_ctx[4]).reshape(B * C, D)
            f = peer_ffn(jnp.concatenate([f_ctx, f_lat], axis=0), peer_wq[i], peer_sub_keys[i], peer_u[i], peer_v[i])
            xc = xc + m_ctx[5] * f[:B * C].reshape(B, C, D)
            x = x + m_lat[5] * f[B * C:].reshape(B, S, D)
    return rms_norm(x, final_norm_w)
```

```cpp
#include <hip/hip_runtime.h>
#include <cstdio>
#include <cstdint>

#ifndef ONE_LAUNCH
#define ONE_LAUNCH 0
#endif
#ifndef NAIVE_ROUTE
#define NAIVE_ROUTE 0
#endif
#ifndef NAIVE_EXPERT
#define NAIVE_EXPERT 0
#endif
#ifndef NAIVE_PQ
#define NAIVE_PQ 0
#endif
#ifndef PHMASK
#define PHMASK 0xFFFF
#endif
#define PHM(b) ((PHMASK >> (b)) & 1)
#ifndef MIXMASK
#define MIXMASK 15
#endif
#ifndef PEERMASK
#define PEERMASK 15
#endif
#define MIXON(L) ((MIXMASK >> (L)) & 1)
#define PEERON(L) ((PEERMASK >> (L)) & 1)

constexpr int DM = 2048, NB = 2, SEQ = 4096, CTX = 256, RPB = CTX + SEQ  , MR = NB * RPB  ;
constexpr int NMOD = 6 * DM;
constexpr int NEXP = 16384;
constexpr float EPS = 1e-6f;

#define LAS __attribute__((address_space(3)))
typedef unsigned short bf16;
typedef short bf16x8 __attribute__((ext_vector_type(8)));
typedef short s16x4 __attribute__((ext_vector_type(4)));
typedef float f32x4 __attribute__((ext_vector_type(4)));
typedef float f32x16 __attribute__((ext_vector_type(16)));
typedef unsigned u32x4 __attribute__((ext_vector_type(4)));
typedef unsigned u32x2 __attribute__((ext_vector_type(2)));
typedef __bf16 bf2v __attribute__((ext_vector_type(2)));

__device__ __forceinline__ unsigned f2bf(float f) { unsigned u = __builtin_bit_cast(unsigned, f); return (u + 0x7fffu + ((u >> 16) & 1u)) >> 16; }
__device__ __forceinline__ unsigned pk2(float lo, float hi) { unsigned r; asm volatile("v_cvt_pk_bf16_f32 %0, %1, %2" : "=v"(r) : "v"(lo), "v"(hi)); return r; }
__device__ __forceinline__ float dot2bf(unsigned a, unsigned b, float acc) { const unsigned a_ = a, b_ = b; return __builtin_amdgcn_fdot2_f32_bf16(__builtin_bit_cast(bf2v, a_), __builtin_bit_cast(bf2v, b_), acc, false); }
__device__ __forceinline__ float bflo(unsigned w) { return __builtin_bit_cast(float, w << 16); }
__device__ __forceinline__ float bfhi(unsigned w) { return __builtin_bit_cast(float, w & 0xffff0000u); }
__device__ __forceinline__ float bf2f(bf16 b) { return __builtin_bit_cast(float, ((unsigned)b) << 16); }
__device__ __forceinline__ int opaque_tid() { int t = threadIdx.x; asm volatile("" : "+v"(t)); return t; }
__device__ __forceinline__ float wave_sum(float v) {
#pragma unroll
    for (int o = 1; o < 64; o <<= 1) v += __shfl_xor(v, o);
    return v;
}

#define XB_TMO      128
#define XB_XCNT(j)  (256  + 64 * (j))
#define XB_XSUB(j)  (1280 + 64 * (j))
#define XB_XGEN(j)  (2304 + 64 * (j))
#define XB_TOP      3328
#define XB_TOPGEN   3392
#define XCD_BAR_WORDS 3456
#define XB_SPIN_CAP (1u << 18)

__device__ __forceinline__ unsigned xb_ld(unsigned* p)              { return __hip_atomic_load(p, __ATOMIC_RELAXED, __HIP_MEMORY_SCOPE_AGENT); }
__device__ __forceinline__ unsigned xb_add(unsigned* p, unsigned v) { return __hip_atomic_fetch_add(p, v, __ATOMIC_RELAXED, __HIP_MEMORY_SCOPE_AGENT); }
__device__ __forceinline__ unsigned xb_xcc_id() { return (unsigned)__builtin_amdgcn_s_getreg((3 << 11) | 20) & 0xFu; }
#define XB_SPIN(cond, bar) do { unsigned _sp = 0; while (cond) { __builtin_amdgcn_s_sleep(1); \
    if ((++_sp & 255u) == 0u) { if (xb_ld(&(bar)[XB_TMO])) break; if (_sp > XB_SPIN_CAP) { atomicAdd(&(bar)[XB_TMO], 1u); break; } } } } while (0)

struct XcdBarrier { unsigned* bar; unsigned x; volatile LAS unsigned* st; };

__device__ __forceinline__ XcdBarrier xcd_barrier_post(unsigned* bar, volatile LAS unsigned* st) {
    XcdBarrier b; b.bar = bar; b.x = xb_xcc_id(); b.st = st;
    if (threadIdx.x == 0) (void)xb_add(&bar[XB_XCNT(b.x)], 1u);
    return b;
}
__device__ __forceinline__ void xcd_barrier_complete(unsigned* bar, unsigned x, unsigned& nloc, unsigned& nx) {
    const unsigned G = gridDim.x * gridDim.y * gridDim.z;
    unsigned sum, cnt, mine, sp = 0u;
    for (;;) {
        sum = 0u; cnt = 0u; mine = 0u;
#pragma unroll
        for (unsigned j = 0; j < 16; ++j) { const unsigned c = xb_ld(&bar[XB_XCNT(j)]); sum += c; cnt += (c > 0u) ? 1u : 0u; mine = (j == x) ? c : mine; }
        if (sum == G) break;
        __builtin_amdgcn_s_sleep(1);
        if ((++sp & 255u) == 0u) { if (xb_ld(&bar[XB_TMO])) break; if (sp > XB_SPIN_CAP) { atomicAdd(&bar[XB_TMO], 1u); break; } }
    }
    nloc = mine > 0u ? mine : 1u; nx = cnt > 0u ? cnt : 1u;
}
__device__ __forceinline__ void xcd_barrier(const XcdBarrier& b) {
    asm volatile("s_waitcnt vmcnt(0)" ::: "memory");
    __syncthreads();
    if (threadIdx.x == 0) {
        unsigned* bar = b.bar;
        __builtin_amdgcn_s_waitcnt(0);
        unsigned nloc = b.st[0], nx = b.st[1];
        if (nloc == 0u) { xcd_barrier_complete(bar, b.x, nloc, nx); b.st[0] = nloc; b.st[1] = nx; }
        const unsigned old = xb_add(&bar[XB_XSUB(b.x)], 1u);
        const unsigned gen = old / nloc;
        if (old + 1u == (gen + 1u) * nloc) {
            __builtin_amdgcn_fence(__ATOMIC_RELEASE, "agent");
            asm volatile("s_waitcnt vmcnt(0)" ::: "memory");
            const unsigned og = xb_add(&bar[XB_TOP], 1u);
            const unsigned tg = og / nx;
            if (og + 1u == (tg + 1u) * nx) xb_add(&bar[XB_TOPGEN], 1u);
            else XB_SPIN(xb_ld(&bar[XB_TOPGEN]) == tg, bar);
            __builtin_amdgcn_fence(__ATOMIC_ACQUIRE, "agent");
            xb_add(&bar[XB_XGEN(b.x)], 1u);
            asm volatile("s_waitcnt vmcnt(0)" ::: "memory");
        } else {
            XB_SPIN(xb_ld(&bar[XB_XGEN(b.x)]) == gen, bar);
            __builtin_amdgcn_fence(__ATOMIC_ACQUIRE, "agent");
            asm volatile("s_waitcnt vmcnt(0)" ::: "memory");
        }
    }
    __syncthreads();
}

namespace pg8 {
constexpr int BM = 256, BK = 64, HALF = 128, HTB = HALF * BK * 2, STAGE_BYTES = 8 * HTB, NXCD = 8, WGM = 8;
__host__ __device__ __forceinline__ int lds_byte(int r, int c) { const int st = (r >> 4) * 2 + (c >> 5), rr = r & 15, cc = c & 31, ob = rr * 64 + cc * 2; return st * 1024 + (ob ^ (((ob >> 9) & 1) << 5)); }
__host__ __device__ __forceinline__ void stage_rc(int b, int& R, int& C) { const int st = b / 1024, sb = b % 1024, swz = sb ^ (((sb >> 9) & 1) << 5); R = (st >> 1) * 16 + swz / 64; C = (st & 1) * 32 + (swz % 64) / 2; }
__host__ __device__ __forceinline__ int perm32(int rho) { const int n = rho >> 4, i = rho & 15; return 8 * (i >> 2) + 4 * n + (i & 3); }

struct Unit { int pm, pn; };
struct Gemm { const bf16* A; const bf16* Bt; int M, N, K; };

struct StaticOrder {
    int nM, nN, nwg, G, c;
    __host__ __device__ void init(int M, int N, int G_, int c_) { nM = M / BM; nN = N / BM; nwg = nM * nN; G = G_; c = c_; }
    __host__ __device__ bool next(int i, Unit& u) const {
        const long L = (long)i * G + c; if (L >= nwg) return false;
        int wgid = (int)L; { const int q = nwg / NXCD, r = nwg % NXCD, xcd = wgid % NXCD, off = wgid / NXCD; wgid = (xcd < r ? xcd * (q + 1) : r * (q + 1) + (xcd - r) * q) + off; }
        const int nig = WGM * nN, gid = wgid / nig, fm = gid * WGM, gsz = (nM - fm) < WGM ? (nM - fm) : WGM;
        u.pm = fm + ((wgid % nig) % gsz); u.pn = (wgid % nig) / gsz; return true;
    }
    __device__ __forceinline__ void a_ready(const Unit&) const {}
    __device__ __forceinline__ void done(const Unit&) const {}
};
struct FlexOrder {
    int nM, nN, nwg, G, c, grouped;
    __device__ void init(int M, int N, int G_, int c_, int grouped_) { nM = M / BM; nN = N / BM; nwg = grouped_ ? 272 : nM * nN; G = G_; c = c_; grouped = grouped_; }
    __device__ bool next(int i, Unit& u) const {
        const long L = (long)i * G + c; if (L >= nwg) return false;
        if (grouped) { const int g = (int)L / 68, r = (int)L % 68; u.pm = g * 34 + (r >> 1); u.pn = g * 2 + (r & 1); return true; }
        int wgid = (int)L; { const int q = nwg / NXCD, r = nwg % NXCD, xcd = wgid % NXCD, off = wgid / NXCD; wgid = (xcd < r ? xcd * (q + 1) : r * (q + 1) + (xcd - r) * q) + off; }
        const int nig = WGM * nN, gid = wgid / nig, fm = gid * WGM, gsz = (nM - fm) < WGM ? (nM - fm) : WGM;
        u.pm = fm + ((wgid % nig) % gsz); u.pn = (wgid % nig) / gsz; return true;
    }
    __device__ __forceinline__ void a_ready(const Unit&) const {}
    __device__ __forceinline__ void done(const Unit&) const {}
};

struct EpiBf16 {
    static constexpr bool PERM = true, AFTER_DRAIN = false;
    bf16* O; int ldc;
    __device__ __forceinline__ void operator()(const f32x4 (&acc)[2][2][4][2], const Unit& u, int wr, int wc, int fr, int fq) const {
        const int row0 = u.pm * BM + wr * 64 + fr; const int col0 = u.pn * BM + wc * 32 + 8 * fq;
#pragma unroll
        for (int ai = 0; ai < 2; ++ai)
#pragma unroll
            for (int m = 0; m < 4; ++m) { bf16* rowp = O + (size_t)(row0 + ai * HALF + m * 16) * ldc + col0;
#pragma unroll
                for (int bj = 0; bj < 2; ++bj) { const f32x4 v0 = acc[ai][bj][m][0], v1 = acc[ai][bj][m][1];
                    u32x4 w; w.x = pk2(v0[0], v0[1]); w.y = pk2(v0[2], v0[3]); w.z = pk2(v1[0], v1[1]); w.w = pk2(v1[2], v1[3]);
                    *(u32x4*)(rowp + bj * HALF) = w; } }
    }
};
struct EpiResid {
    static constexpr bool PERM = false, AFTER_DRAIN = false;
    float* X; const float* modl; int gate_off; const float* ls; int pm_mod;
    __device__ __forceinline__ void operator()(const f32x4 (&acc)[2][2][4][2], const Unit& u, int wr, int wc, int fr, int fq) const {
        const int pm = u.pm % pm_mod; const int bb = pm / 17, isctx = (pm % 17) == 0; const int v = isctx ? 2 : bb;
        const float* gate = modl + (size_t)v * NMOD + gate_off;
        const int row0 = pm * BM + wr * 64 + fr, col0 = u.pn * BM + wc * 32 + 4 * fq;
        f32x4 gv[2][2];
#pragma unroll
        for (int bj = 0; bj < 2; ++bj)
#pragma unroll
            for (int n = 0; n < 2; ++n) { gv[bj][n] = *(const f32x4*)(gate + col0 + bj * HALF + n * 16); if (ls) gv[bj][n] = gv[bj][n] * *(const f32x4*)(ls + col0 + bj * HALF + n * 16); }
#pragma unroll
        for (int ai = 0; ai < 2; ++ai)
#pragma unroll
            for (int m = 0; m < 4; ++m) { float* rowp = X + (size_t)(row0 + ai * HALF + m * 16) * DM + col0;
#pragma unroll
                for (int bj = 0; bj < 2; ++bj)
#pragma unroll
                    for (int n = 0; n < 2; ++n) { f32x4* p = (f32x4*)(rowp + bj * HALF + n * 16); *p = *p + acc[ai][bj][m][n] * gv[bj][n]; } }
    }
};

template <class Epi, class Sched>
__device__ __forceinline__ void gemm_phase(LAS unsigned char* lds, const Gemm g, const Sched& S, const Epi& E) {
    const int tid = opaque_tid(), wid = __builtin_amdgcn_readfirstlane(tid >> 6), lane = tid & 63, wr = wid >> 2, wc = wid & 3, fr = lane & 15, fq = lane >> 4;
    const int K = g.K, nt = K / BK;
    unsigned voffA[2], voffB[2];
#pragma unroll
    for (int i = 0; i < 2; ++i) { int R, C; stage_rc(tid * 16 + i * 8192, R, C); const int Rb = Epi::PERM ? ((R & ~31) + perm32(R & 31)) : R;
        voffA[i] = (unsigned)(R * K + C) * 2u; voffB[i] = (unsigned)(Rb * K + C) * 2u; }
    const size_t kstep = (size_t)(BK * 2);
    const size_t hstep = (size_t)HALF * K * 2;
    const size_t tstep = 2 * hstep;
    const unsigned ldsw = (unsigned)wid * 1024u;
    const int aoff = lds_byte(wr * 64 + fr, fq * 8), boff = lds_byte(wc * 32 + fr, fq * 8);
#define PG8_SA(b, h) (((b) * 2 + (h)) * HTB)
#define PG8_SB(b, h) ((4 + (b) * 2 + (h)) * HTB)
#define PG8_STAGE(bufoff, gbase, voff) do { _Pragma("unroll") for (int _i = 0; _i < 2; ++_i) \
        __builtin_amdgcn_global_load_lds((const unsigned*)((const char*)(gbase) + (voff)[_i]), (LAS unsigned*)(lds + (bufoff) + ldsw + _i * 8192), 16, 0, 0); } while (0)
#define PG8_LDA(dst, b, h) do { _Pragma("unroll") for (int m = 0; m < 4; ++m) _Pragma("unroll") for (int k = 0; k < 2; ++k) dst[m][k] = *(const LAS bf16x8*)(lds + PG8_SA(b, h) + aoff + m * 2048 + k * 1024); } while (0)
#define PG8_LDB(dst, b, h) do { _Pragma("unroll") for (int n = 0; n < 2; ++n) _Pragma("unroll") for (int k = 0; k < 2; ++k) dst[n][k] = *(const LAS bf16x8*)(lds + PG8_SB(b, h) + boff + n * 2048 + k * 1024); } while (0)
#define PG8_MMA(ai, bj, At, Bt) do { __builtin_amdgcn_s_setprio(1); _Pragma("unroll") for (int m = 0; m < 4; ++m) _Pragma("unroll") for (int n = 0; n < 2; ++n) _Pragma("unroll") for (int k = 0; k < 2; ++k) \
        acc[ai][bj][m][n] = __builtin_amdgcn_mfma_f32_16x16x32_bf16(Bt[n][k], At[m][k], acc[ai][bj][m][n], 0, 0, 0); __builtin_amdgcn_s_setprio(0); } while (0)
#define PG8_WAIT_V(n) asm volatile("s_waitcnt vmcnt(" #n ")" ::: "memory")
#define PG8_WAIT_L(n) asm volatile("s_waitcnt lgkmcnt(" #n ")" ::: "memory")
#define PG8_BAR __builtin_amdgcn_s_barrier()
#define PG8_SCHED __builtin_amdgcn_sched_barrier(0)
    Unit cur, nxt; int ui = 0;
    if (!S.next(0, cur)) return;
    f32x4 acc[2][2][4][2];
#pragma unroll
    for (int a = 0; a < 2; ++a)
#pragma unroll
        for (int b = 0; b < 2; ++b)
#pragma unroll
            for (int m = 0; m < 4; ++m)
#pragma unroll
                for (int n = 0; n < 2; ++n) acc[a][b][m][n] = (f32x4){0.f, 0.f, 0.f, 0.f};
    bf16x8 At[4][2], B0[2][2], B1[2][2];
    const char* cA = (const char*)g.A + (size_t)cur.pm * tstep; const char* cB = (const char*)g.Bt + (size_t)cur.pn * tstep;
    S.a_ready(cur);
    PG8_STAGE(PG8_SB(0, 0), cB, voffB); PG8_STAGE(PG8_SA(0, 0), cA, voffA); PG8_STAGE(PG8_SB(0, 1), cB + hstep, voffB); PG8_STAGE(PG8_SA(0, 1), cA + hstep, voffA);
    if (wr == 1) PG8_BAR;
    PG8_WAIT_V(4); PG8_BAR;
    PG8_STAGE(PG8_SB(1, 0), cB + kstep, voffB); PG8_STAGE(PG8_SA(1, 0), cA + kstep, voffA); PG8_STAGE(PG8_SB(1, 1), cB + hstep + kstep, voffB);
    PG8_WAIT_V(6); PG8_BAR;
    for (;;) {
        const bool has_next = S.next(ui + 1, nxt);
        const char* nA = has_next ? (const char*)g.A + (size_t)nxt.pm * tstep : cA; const char* nB = has_next ? (const char*)g.Bt + (size_t)nxt.pn * tstep : cB;
        for (int t = 0; t < nt; t += 2) {
            const bool last = (t == nt - 2);
            const char* a1 = cA + (size_t)(t + 1) * kstep;
            const char* a2 = last ? nA : cA + (size_t)(t + 2) * kstep; const char* b2 = last ? nB : cB + (size_t)(t + 2) * kstep;
            const char* a3 = a2 + kstep; const char* b3 = b2 + kstep;
            if (last && has_next) S.a_ready(nxt);
            PG8_LDB(B0, 0, 0); PG8_SCHED; PG8_LDA(At, 0, 0); PG8_STAGE(PG8_SA(1, 1), a1 + hstep, voffA);
            PG8_WAIT_L(8); PG8_BAR; PG8_WAIT_L(0); PG8_MMA(0, 0, At, B0); PG8_BAR; PG8_SCHED;
            PG8_LDB(B1, 0, 1); PG8_STAGE(PG8_SB(0, 0), b2, voffB);
            PG8_BAR; PG8_WAIT_L(0); PG8_MMA(0, 1, At, B1); PG8_BAR;
            PG8_LDA(At, 0, 1); PG8_STAGE(PG8_SA(0, 0), a2, voffA);
            PG8_BAR; PG8_WAIT_L(0); PG8_MMA(1, 0, At, B0); PG8_BAR; PG8_SCHED;
            PG8_STAGE(PG8_SB(0, 1), b2 + hstep, voffB);
            PG8_WAIT_V(6); PG8_BAR; PG8_MMA(1, 1, At, B1); PG8_BAR;
            PG8_LDB(B0, 1, 0); PG8_SCHED; PG8_LDA(At, 1, 0); PG8_STAGE(PG8_SA(0, 1), a2 + hstep, voffA);
            PG8_WAIT_L(8); PG8_BAR; PG8_WAIT_L(0); PG8_MMA(0, 0, At, B0); PG8_BAR; PG8_SCHED;
            PG8_LDB(B1, 1, 1); PG8_STAGE(PG8_SB(1, 0), b3, voffB);
            PG8_BAR; PG8_WAIT_L(0); PG8_MMA(0, 1, At, B1); PG8_BAR;
            PG8_LDA(At, 1, 1); PG8_STAGE(PG8_SA(1, 0), a3, voffA);
            PG8_BAR; PG8_WAIT_L(0); PG8_MMA(1, 0, At, B0); PG8_BAR; PG8_SCHED;
            PG8_STAGE(PG8_SB(1, 1), b3 + hstep, voffB);
            PG8_WAIT_V(6); PG8_BAR; PG8_MMA(1, 1, At, B1); PG8_BAR;
        }
        E(acc, cur, wr, wc, fr, fq); S.done(cur);
        if (!has_next) break;
#pragma unroll
        for (int a = 0; a < 2; ++a)
#pragma unroll
            for (int b = 0; b < 2; ++b)
#pragma unroll
                for (int m = 0; m < 4; ++m)
#pragma unroll
                    for (int n = 0; n < 2; ++n) acc[a][b][m][n] = (f32x4){0.f, 0.f, 0.f, 0.f};
        cur = nxt; cA = nA; cB = nB; ++ui;
    }
    PG8_WAIT_V(0);
    if (wr == 0) PG8_BAR;
    PG8_BAR;
#undef PG8_SA
#undef PG8_SB
#undef PG8_STAGE
#undef PG8_LDA
#undef PG8_LDB
#undef PG8_MMA
#undef PG8_WAIT_V
#undef PG8_WAIT_L
#undef PG8_BAR
#undef PG8_SCHED
}
}

namespace att {
constexpr int D = 128, NW = 8, QBLK = 32, KVBLK = 64;
constexpr float SCALE = 0.088388347648318440f;
constexpr float THR = 8.f;
constexpr size_t SHM_V = KVBLK * D * 2, SHM_K = KVBLK * D * 2, SHM_ATTN = 2 * SHM_V + 2 * SHM_K + NW * 64 * 4;
#define KSWZ(row, colB) ((row) * 256 + ((colB) ^ (((row) & 7) << 4)))
#define SBAR() __builtin_amdgcn_sched_barrier(0)
__device__ __forceinline__ int crow(int r, int hi) { return (r & 3) + 8 * (r >> 2) + 4 * hi; }

__device__ __forceinline__ void partialSM(f32x16& p0, f32x16& p1, float& m_reg, float& mn, float& alpha) {
  constexpr float C = SCALE * 1.4426950408889634f;
  float pmax = p0[0];
#pragma unroll
  for (int r = 1; r < 16; ++r) pmax = fmaxf(pmax, p0[r]);
#pragma unroll
  for (int r = 0; r < 16; ++r) pmax = fmaxf(pmax, p1[r]);
  { auto rr = __builtin_amdgcn_permlane32_swap(__float_as_uint(pmax), __float_as_uint(pmax), false, false);
    pmax = fmaxf(__uint_as_float(rr[0]), __uint_as_float(rr[1])); }
  if (__builtin_expect(__all(pmax - m_reg <= THR / SCALE), 1)) { mn = m_reg; alpha = 1.f; }
  else { mn = fmaxf(m_reg, pmax); alpha = __builtin_amdgcn_exp2f((m_reg - mn) * C); m_reg = mn; }
  float mnC = -mn * C;
#pragma unroll
  for (int r = 0; r < 16; ++r) p0[r] = fmaf(p0[r], C, mnC);
#pragma unroll
  for (int r = 0; r < 16; ++r) p1[r] = fmaf(p1[r], C, mnC);
#pragma unroll
  for (int r = 0; r < 16; ++r) p0[r] = __builtin_amdgcn_exp2f(p0[r]);
}
__device__ __forceinline__ void finishSM(f32x16& p0, f32x16& p1, float alpha, float& l_reg, bf16x8& pa0, bf16x8& pa1, bf16x8& pa2, bf16x8& pa3) {
#pragma unroll
  for (int r = 0; r < 16; ++r) p1[r] = __builtin_amdgcn_exp2f(p1[r]);
  float ps = 0;
#pragma unroll
  for (int r = 0; r < 16; ++r) ps += p0[r];
#pragma unroll
  for (int r = 0; r < 16; ++r) ps += p1[r];
  { auto rr = __builtin_amdgcn_permlane32_swap(__float_as_uint(ps), __float_as_uint(ps), false, false);
    ps = __uint_as_float(rr[0]) + __uint_as_float(rr[1]); }
  l_reg = l_reg * alpha + ps;
#define PK4(P, BASE, OUT) do { unsigned a0 = pk2(P[BASE + 0], P[BASE + 1]), a1 = pk2(P[BASE + 2], P[BASE + 3]);   \
    unsigned b0 = pk2(P[BASE + 4], P[BASE + 5]), b1 = pk2(P[BASE + 6], P[BASE + 7]);                              \
    auto r0 = __builtin_amdgcn_permlane32_swap(a0, b0, false, false); auto r1 = __builtin_amdgcn_permlane32_swap(a1, b1, false, false); \
    u32x4 w = {r0[0], r1[0], r0[1], r1[1]}; OUT = *reinterpret_cast<bf16x8*>(&w); } while (0)
  PK4(p0, 0, pa0); PK4(p0, 8, pa1); PK4(p1, 0, pa2); PK4(p1, 8, pa3);
#undef PK4
}
__device__ __forceinline__ void qkt(f32x16& p0, f32x16& p1, const bf16* Ks, const bf16x8* qr, int r32, int hi) {
  p0 = f32x16{}; p1 = f32x16{};
#pragma unroll
  for (int d0 = 0; d0 < 8; ++d0) { int cb = (d0 * 16 + hi * 8) * 2;
    bf16x8 b0 = *reinterpret_cast<const bf16x8*>((const char*)Ks + KSWZ(r32, cb));
    bf16x8 b1 = *reinterpret_cast<const bf16x8*>((const char*)Ks + KSWZ(32 + r32, cb));
    p0 = __builtin_amdgcn_mfma_f32_32x32x16_bf16(b0, qr[d0], p0, 0, 0, 0);
    p1 = __builtin_amdgcn_mfma_f32_32x32x16_bf16(b1, qr[d0], p1, 0, 0, 0); }
}
__device__ __forceinline__ int v_st(int k, int c) { const int kk = (k & ~0xC) | ((k & 4) << 1) | ((k & 8) >> 1); return ((kk >> 3) * 4 + (c >> 5)) * 512 + ((kk & 7) * 32 + (c & 31)) * 2; }
__device__ __forceinline__ int v_rd_base(int lane) { return ((lane & 3) << 3) | (((lane >> 2) & 3) << 6) | (((lane >> 4) & 1) << 5) | (((lane >> 5) & 1) << 8); }
constexpr int v_rd_off(int d0, int ks, int half) { return d0 * 512 + ks * 4096 + half * 2048; }
template <int OFF> __device__ __forceinline__ s16x4 tr_read(int vb) {
  s16x4 r; asm volatile("ds_read_b64_tr_b16 %0, %1 offset:%2" : "=&v"(r) : "v"(vb), "i"(OFF) : "memory"); return r;
}
template <int D0> __device__ __forceinline__ void pv_one(f32x16& od, int vb, bf16x8 pa0, bf16x8 pa1, bf16x8 pa2, bf16x8 pa3) {
  const s16x4 l0 = tr_read<v_rd_off(D0, 0, 0)>(vb), h0 = tr_read<v_rd_off(D0, 0, 1)>(vb), l1 = tr_read<v_rd_off(D0, 1, 0)>(vb), h1 = tr_read<v_rd_off(D0, 1, 1)>(vb);
  const s16x4 l2 = tr_read<v_rd_off(D0, 2, 0)>(vb), h2 = tr_read<v_rd_off(D0, 2, 1)>(vb), l3 = tr_read<v_rd_off(D0, 3, 0)>(vb), h3 = tr_read<v_rd_off(D0, 3, 1)>(vb);
  asm volatile("s_waitcnt lgkmcnt(0)" ::: "memory"); SBAR();
#define PK(L, H) (bf16x8){L[0], L[1], L[2], L[3], H[0], H[1], H[2], H[3]}
  od = __builtin_amdgcn_mfma_f32_32x32x16_bf16(pa0, PK(l0, h0), od, 0, 0, 0);
  od = __builtin_amdgcn_mfma_f32_32x32x16_bf16(pa1, PK(l1, h1), od, 0, 0, 0);
  od = __builtin_amdgcn_mfma_f32_32x32x16_bf16(pa2, PK(l2, h2), od, 0, 0, 0);
  od = __builtin_amdgcn_mfma_f32_32x32x16_bf16(pa3, PK(l3, h3), od, 0, 0, 0);
#undef PK
}
__device__ __forceinline__ void pv_d0(f32x16* o, int vb, bf16x8 pa0, bf16x8 pa1, bf16x8 pa2, bf16x8 pa3) {
  pv_one<0>(o[0], vb, pa0, pa1, pa2, pa3); pv_one<1>(o[1], vb, pa0, pa1, pa2, pa3); pv_one<2>(o[2], vb, pa0, pa1, pa2, pa3); pv_one<3>(o[3], vb, pa0, pa1, pa2, pa3);
}

template <int LD>
__device__ __forceinline__ void attn_body(const bf16* __restrict__ Qb, const bf16* __restrict__ Kh, const bf16* __restrict__ Vh, bf16* __restrict__ Ob,
                                          int NT, char* lds) {
  const int tid = opaque_tid(), wid = tid >> 6, lane = tid & 63, r32 = lane & 31, hi = lane >> 5;
  bf16* V_lds = (bf16*)lds; bf16* K_lds = (bf16*)(lds + 2 * SHM_V);
  float* ws = (float*)(lds + 2 * SHM_V + 2 * SHM_K) + wid * 64; float* li_l = ws; float* al_l = ws + 32;
  float m_reg = -1e30f, l_reg = 0; f32x16 o[4] = {}; bf16x8 qr[8];
  const bf16* Qw = Qb + (long)(wid * QBLK + r32) * LD + hi * 8;
#pragma unroll
  for (int d0 = 0; d0 < 8; ++d0) qr[d0] = *reinterpret_cast<const bf16x8*>(Qw + d0 * 16);
  const int sr = tid >> 4, sc = (tid & 15) * 8, vst0 = v_st(sr, sc), vst1 = v_st(32 + sr, sc);
  const int vb0 = (int)(uintptr_t)V_lds + v_rd_base(lane);
  struct { bf16x8 vs0, vs1, ks0, ks1; } sr_[2];
#define TROW(j) (64 * (j))
#define SLOAD(i, k0) do { const long _k = (k0); sr_[i].vs0 = *reinterpret_cast<const bf16x8*>(&Vh[(_k + sr) * LD + sc]); sr_[i].vs1 = *reinterpret_cast<const bf16x8*>(&Vh[(_k + 32 + sr) * LD + sc]); \
    sr_[i].ks0 = *reinterpret_cast<const bf16x8*>(&Kh[(_k + sr) * LD + sc]); sr_[i].ks1 = *reinterpret_cast<const bf16x8*>(&Kh[(_k + 32 + sr) * LD + sc]); } while (0)
#define SWRITE(b, i) do { *(bf16x8*)((char*)V_lds + (b) * SHM_V + vst0) = sr_[i].vs0;          \
    *(bf16x8*)((char*)V_lds + (b) * SHM_V + vst1) = sr_[i].vs1; int kc = sc * 2;               \
    *(bf16x8*)((char*)K_lds + (b) * SHM_K + KSWZ(sr, kc)) = sr_[i].ks0;                       \
    *(bf16x8*)((char*)K_lds + (b) * SHM_K + KSWZ(32 + sr, kc)) = sr_[i].ks1; } while (0)
#define SWAIT() asm volatile("s_waitcnt vmcnt(4)" ::: "memory")
#define RESC(a) do { if (__any((a) < 1.f)) { if (hi == 0) al_l[r32] = (a); asm volatile("s_waitcnt lgkmcnt(0)" ::: "memory"); \
    _Pragma("unroll") for (int d = 0; d < 4; ++d) _Pragma("unroll") for (int r = 0; r < 16; ++r) o[d][r] *= al_l[crow(r, hi)]; } } while (0)
  f32x16 pA0, pA1, pB0, pB1; float mnA, mnB, alA, alB; bf16x8 pa0, pa1, pa2, pa3;
  constexpr int SE = 0, SO = 1;
  SLOAD(SE, TROW(0)); asm volatile("s_waitcnt vmcnt(0)" ::: "memory"); SWRITE(0, SE); __syncthreads();
  qkt(pA0, pA1, K_lds, qr, r32, hi); partialSM(pA0, pA1, m_reg, mnA, alA);
  SLOAD(SO, TROW(1)); if (2 < NT) SLOAD(SE, TROW(2));
  SWAIT(); SWRITE(1, SO); __syncthreads();
  for (int j = 1; j + 1 < NT; j += 2) {
    SBAR(); qkt(pB0, pB1, (bf16*)((char*)K_lds + SHM_K), qr, r32, hi);
    finishSM(pA0, pA1, alA, l_reg, pa0, pa1, pa2, pa3); SBAR();
    SLOAD(SO, TROW(j + 2)); SBAR();
    pv_d0(o, vb0, pa0, pa1, pa2, pa3); partialSM(pB0, pB1, m_reg, mnB, alB);
    __syncthreads(); SWAIT(); SWRITE(0, SE);
    RESC(alB); __syncthreads();
    SBAR(); qkt(pA0, pA1, K_lds, qr, r32, hi);
    finishSM(pB0, pB1, alB, l_reg, pa0, pa1, pa2, pa3); SBAR();
    if (j + 3 < NT) SLOAD(SE, TROW(j + 3)); SBAR();
    pv_d0(o, vb0 + (int)SHM_V, pa0, pa1, pa2, pa3); partialSM(pA0, pA1, m_reg, mnA, alA);
    __syncthreads(); SWAIT(); SWRITE(1, SO);
    RESC(alA); __syncthreads();
  }
  SBAR(); qkt(pB0, pB1, (bf16*)((char*)K_lds + SHM_K), qr, r32, hi);
  finishSM(pA0, pA1, alA, l_reg, pa0, pa1, pa2, pa3); SBAR();
  pv_d0(o, vb0, pa0, pa1, pa2, pa3); partialSM(pB0, pB1, m_reg, mnB, alB);
  __syncthreads(); RESC(alB);
  finishSM(pB0, pB1, alB, l_reg, pa0, pa1, pa2, pa3); SBAR();
  pv_d0(o, vb0 + (int)SHM_V, pa0, pa1, pa2, pa3);
  if (hi == 0) li_l[r32] = l_reg; asm volatile("s_waitcnt lgkmcnt(0)" ::: "memory");
  float rli[16];
#pragma unroll
  for (int r = 0; r < 16; ++r) rli[r] = __builtin_amdgcn_rcpf(li_l[crow(r, hi)]);
  bf16* Ow = Ob + (long)(wid * QBLK) * DM;
#pragma unroll
  for (int r = 0; r < 16; ++r) { const int orow = crow(r, hi);
#pragma unroll
    for (int d0 = 0; d0 < 4; ++d0) Ow[(long)orow * DM + d0 * 32 + r32] = (bf16)f2bf(o[d0][r] * rli[r]); }
  __syncthreads();
#undef TROW
#undef SLOAD
#undef SWRITE
#undef SWAIT
#undef RESC
}
__device__ __forceinline__ void attn_na_body(const bf16* __restrict__ Qb, const bf16* __restrict__ Kh, const bf16* __restrict__ Vh, bf16* __restrict__ Ob,
                                             const int kr_lo, const int qrow0, const float* bl, const int NT, char* lds) {
  constexpr int LD = 6144;
  const int tid = opaque_tid(), wid = tid >> 6, lane = tid & 63, r32 = lane & 31, hi = lane >> 5;
  bf16* V_lds = (bf16*)lds; bf16* K_lds = (bf16*)(lds + 2 * SHM_V);
  float* ws = (float*)(lds + 2 * SHM_V + 2 * SHM_K) + wid * 64; float* li_l = ws; float* al_l = ws + 32;
  float m_reg = -1e30f, l_reg = 0; f32x16 o[4] = {}; bf16x8 qr[8];
  const bf16* Qw = Qb + (long)(wid * QBLK + r32) * LD + hi * 8;
#pragma unroll
  for (int d0 = 0; d0 < 8; ++d0) qr[d0] = *reinterpret_cast<const bf16x8*>(Qw + d0 * 16);
  const int sr = tid >> 4, sc = (tid & 15) * 8, vst0 = v_st(sr, sc), vst1 = v_st(32 + sr, sc);
  const int vb0 = (int)(uintptr_t)V_lds + v_rd_base(lane);
  const int widu = __builtin_amdgcn_readfirstlane(wid);
  const int qrow = qrow0 + (widu >> 1), qcol = (wid & 1) * 32 + r32;
  int r0 = qrow - 4; r0 = r0 < 0 ? 0 : (r0 > 56 ? 56 : r0);
  int c0 = qcol - 8; c0 = c0 < 0 ? 0 : (c0 > 48 ? 48 : c0);
  bf16x8 vs0, vs1, ks0, ks1;
#define NA_TROW(j) ((j) < 4 ? 64 * (j) : 256 + 64 * (kr_lo + (j) - 4))
#define NA_SLOAD(k0) do { const long _k = (k0); vs0 = *reinterpret_cast<const bf16x8*>(&Vh[(_k + sr) * LD + sc]); vs1 = *reinterpret_cast<const bf16x8*>(&Vh[(_k + 32 + sr) * LD + sc]); \
    ks0 = *reinterpret_cast<const bf16x8*>(&Kh[(_k + sr) * LD + sc]); ks1 = *reinterpret_cast<const bf16x8*>(&Kh[(_k + 32 + sr) * LD + sc]); } while (0)
  NA_SLOAD(NA_TROW(0));
  for (int j = 0; j < NT; ++j) {
    __syncthreads();
    *(bf16x8*)((char*)V_lds + vst0) = vs0; *(bf16x8*)((char*)V_lds + vst1) = vs1;
    *(bf16x8*)((char*)K_lds + KSWZ(sr, sc * 2)) = ks0; *(bf16x8*)((char*)K_lds + KSWZ(32 + sr, sc * 2)) = ks1;
    if (j + 1 < NT) NA_SLOAD(NA_TROW(j + 1));
    __syncthreads();
    const int kr = kr_lo + j - 4;
    const bool rowok = (j < 4) || ((unsigned)(kr - r0) < 8u);
    if (rowok) {
      f32x16 p0, p1; float mn, al; bf16x8 pa0, pa1, pa2, pa3;
      qkt(p0, p1, K_lds, qr, r32, hi);
      if (j >= 4) {
        const int bbase = (kr - qrow + 7) * 31 + 15 - qcol;
#pragma unroll
        for (int r = 0; r < 16; ++r) {
          const int kc0 = crow(r, hi), kc1 = 32 + kc0;
          const bool ok0 = (unsigned)(kc0 - c0) < 16u, ok1 = (unsigned)(kc1 - c0) < 16u;
          const float b0 = ok0 ? bl[bbase + kc0] : 0.f, b1 = ok1 ? bl[bbase + kc1] : 0.f;
          p0[r] = ok0 ? p0[r] + b0 : -1e30f; p1[r] = ok1 ? p1[r] + b1 : -1e30f;
        }
      }
      partialSM(p0, p1, m_reg, mn, al);
      if (__any(al < 1.f)) { if (hi == 0) al_l[r32] = al; asm volatile("s_waitcnt lgkmcnt(0)" ::: "memory");
#pragma unroll
        for (int d = 0; d < 4; ++d)
#pragma unroll
          for (int r = 0; r < 16; ++r) o[d][r] *= al_l[crow(r, hi)]; }
      finishSM(p0, p1, al, l_reg, pa0, pa1, pa2, pa3); SBAR();
      pv_d0(o, vb0, pa0, pa1, pa2, pa3);
    }
  }
  if (hi == 0) li_l[r32] = l_reg; asm volatile("s_waitcnt lgkmcnt(0)" ::: "memory");
  float rli[16];
#pragma unroll
  for (int r = 0; r < 16; ++r) rli[r] = __builtin_amdgcn_rcpf(li_l[crow(r, hi)]);
  bf16* Ow = Ob + (long)(wid * QBLK) * DM;
#pragma unroll
  for (int r = 0; r < 16; ++r) { const int orow = crow(r, hi);
#pragma unroll
    for (int d0 = 0; d0 < 4; ++d0) Ow[(long)orow * DM + d0 * 32 + r32] = (bf16)f2bf(o[d0][r] * rli[r]); }
  __syncthreads();
#undef NA_TROW
#undef NA_SLOAD
}
}


constexpr size_t MiB = 1u << 20;
constexpr size_t WS_CTL = 0, CTL_ZERO_BYTES = 1 * MiB;
constexpr size_t WS_MODV = 1 * MiB;
constexpr size_t WS_MODP = 2 * MiB;
constexpr size_t WS_X    = 22 * MiB;
constexpr size_t WS_H    = 92 * MiB;
constexpr size_t WS_QKV  = 128 * MiB;
constexpr size_t WS_O    = 232 * MiB;
constexpr size_t WS_PQ   = 268 * MiB;
constexpr size_t WS_IDX  = 304 * MiB;
constexpr size_t WS_GATE = 310 * MiB;
constexpr size_t WS_AWQKV = 316 * MiB;
constexpr size_t WS_AWO   = 340 * MiB;
constexpr size_t WS_BWQKV = 356 * MiB;
constexpr size_t WS_BWO   = 380 * MiB;
constexpr size_t WS_PW    = 388 * MiB;
constexpr size_t WS_PWQ   = 390 * MiB;
constexpr size_t WS_SK    = 422 * MiB;
constexpr size_t WS_U     = 424 * MiB;
constexpr size_t WS_V     = 680 * MiB;
constexpr size_t WS_END   = 936 * MiB;

constexpr int LDS_BYTES = 147456;
constexpr int MISC_OFF = 131072 + 320;
constexpr int NPHASE = 2 + 4 * 9 + 1;

struct Args {
    const float *x, *c, *ctx, *c_ctx, *mod_w, *mod_b, *norm_w, *final_norm_w, *a_wqkv, *a_q_gain, *a_k_gain, *a_wo, *b_wqkv, *b_rpb, *b_wo, *pool_w, *pool_scale,
                *peer_wq, *peer_sub_keys, *peer_u, *peer_v;
    float* out; unsigned char* ws; int ph_lo, ph_hi;
};

__device__ __forceinline__ void p0_transpose_item(const float* W, int K, int N, bf16* WT, LAS float* scr, int item, int lane) {
    const int nblk = N / 32, kb = item / nblk, nb = item % nblk, k0 = 64 * kb, n0 = 32 * nb;
#pragma unroll 8
    for (int i = 0; i < 32; ++i) { const int kk = 2 * i + (lane >> 5); scr[kk * 33 + (lane & 31)] = W[(size_t)(k0 + kk) * N + n0 + (lane & 31)]; }
    asm volatile("s_waitcnt lgkmcnt(0)" ::: "memory");
    const int c = lane & 7;
#pragma unroll
    for (int j = 0; j < 4; ++j) { const int n = (lane >> 3) + 8 * j; const LAS float* s = scr + (8 * c) * 33 + n;
        u32x4 o; o.x = pk2(s[0 * 33], s[1 * 33]); o.y = pk2(s[2 * 33], s[3 * 33]); o.z = pk2(s[4 * 33], s[5 * 33]); o.w = pk2(s[6 * 33], s[7 * 33]);
        *(u32x4*)(WT + (size_t)(n0 + n) * K + k0 + 8 * c) = o; }
    asm volatile("s_waitcnt lgkmcnt(0)" ::: "memory");
}

__device__ __forceinline__ void norm_mod_row(const float* xrow, const float* w, const float* shift, const float* scale, bf16* orow, int lane) {
    const f32x4* xr = (const f32x4*)xrow + lane;
    f32x4 v[8]; float ss = 0.f;
#pragma unroll
    for (int j = 0; j < 8; ++j) { v[j] = xr[64 * j]; ss += (v[j].x * v[j].x + v[j].y * v[j].y) + (v[j].z * v[j].z + v[j].w * v[j].w); }
    const float rstd = 1.f / sqrtf(wave_sum(ss) * (1.f / DM) + EPS);
    u32x2* o8 = (u32x2*)orow + lane;
#pragma unroll
    for (int j = 0; j < 8; ++j) { const int c = (lane + 64 * j) * 4;
        const f32x4 wv = *(const f32x4*)(w + c), sh = *(const f32x4*)(shift + c), sc = *(const f32x4*)(scale + c);
        const f32x4 h = (v[j] * rstd * wv) * (sc + 1.f) + sh;
        u32x2 pk; pk.x = pk2(h.x, h.y); pk.y = pk2(h.z, h.w); o8[64 * j] = pk; }
}

__device__ __forceinline__ float gelu_tanh(float x) {
    const float z = 0.7978845608028654f * (x + 0.044715f * x * x * x);
    const float e = __expf(2.f * z);
    const float t = 1.f - 2.f / (1.f + e);
    return 0.5f * x * (1.f + t);
}

__device__ __forceinline__ unsigned mono(float f) { const unsigned u = __float_as_uint(f); return u ^ ((unsigned)((int)u >> 31) | 0x80000000u); }
__device__ __forceinline__ float unmono(unsigned m) { const unsigned u = (m & 0x80000000u) ? (m ^ 0x80000000u) : ~m; return __uint_as_float(u); }
#define INS16(L, x) do { unsigned _x = (x); _Pragma("unroll") for (int _j = 0; _j < 16; ++_j) { const unsigned _t = L[_j] > _x ? L[_j] : _x; _x = L[_j] > _x ? _x : L[_j]; L[_j] = _t; } } while (0)

__global__ void __launch_bounds__(512, 2) fwd_kernel(Args a) {
    extern __shared__ __attribute__((aligned(16))) unsigned char lds[];
    LAS unsigned char* L3 = (LAS unsigned char*)lds;
    volatile LAS unsigned* MISC = (volatile LAS unsigned*)(L3 + MISC_OFF);
    const int G = gridDim.x; const int bx = blockIdx.x; const int vcu = (G % 8 == 0) ? (bx % 8) * (G / 8) + bx / 8 : bx;
    const int NGW = G * 8;
    if (threadIdx.x < 32) MISC[threadIdx.x] = 0u;
    __syncthreads();
    XcdBarrier bar; bar.bar = (unsigned*)(a.ws + WS_CTL) + 4096; bar.x = 0; bar.st = nullptr;
#if ONE_LAUNCH
    bar = xcd_barrier_post((unsigned*)(a.ws + WS_CTL) + 4096, MISC + 8);
#endif
    const int lo = a.ph_lo, hi_ph = a.ph_hi;
#define IN(k) (lo <= (k) && (k) < hi_ph)
#if ONE_LAUNCH
#define SEAM(k) do { if (IN(k) && IN((k) + 1)) xcd_barrier(bar); } while (0)
#else
#define SEAM(k) do { } while (0)
#endif
#define WS_LAUNDER() unsigned char* wsl = a.ws; asm volatile("" : "+s"(wsl)); const int tid = opaque_tid(), lane = tid & 63, wave = __builtin_amdgcn_readfirstlane(tid >> 6), gw = vcu * 8 + wave; (void)lane; (void)gw
#define modv  ((float*)(wsl + WS_MODV))
#define modp  ((float*)(wsl + WS_MODP))
#define X     ((float*)(wsl + WS_X))
#define H     ((bf16*)(wsl + WS_H))
#define QKV   ((bf16*)(wsl + WS_QKV))
#define OB    ((bf16*)(wsl + WS_O))
#define PQ    ((bf16*)(wsl + WS_PQ))
#define IDX   ((int*)(wsl + WS_IDX))
#define GATE  ((float*)(wsl + WS_GATE))
#define AWQKV ((bf16*)(wsl + WS_AWQKV))
#define AWO   ((bf16*)(wsl + WS_AWO))
#define BWQKV ((bf16*)(wsl + WS_BWQKV))
#define BWO   ((bf16*)(wsl + WS_BWO))
#define PW    ((bf16*)(wsl + WS_PW))
#define PWQ   ((bf16*)(wsl + WS_PWQ))
#define SK    ((bf16*)(wsl + WS_SK))
#define UB    ((bf16*)(wsl + WS_U))
#define VB    ((bf16*)(wsl + WS_V))
    if (PHM(0) && IN(0)) { WS_LAUNDER();
        float* sm = (float*)lds;
        for (int it = bx; it < 4 * 6 * 32; it += G) {
            const int Lr = it / 192, r = it % 192, cc = r / 32, kc = r % 32;
            __syncthreads();
            if (tid < 192) { const int v = tid >> 6, k = kc * 64 + (tid & 63); const float cv = (v < 2) ? a.c[v * DM + k] : a.c_ctx[k]; sm[tid] = cv / (1.f + __expf(-cv)); }
            __syncthreads();
            const float* W = a.mod_w + ((size_t)Lr * DM + kc * 64) * NMOD + cc * 2048 + tid * 4;
            f32x4 a0 = {0.f, 0.f, 0.f, 0.f}, a1 = a0, a2 = a0;
#pragma unroll 8
            for (int k = 0; k < 64; ++k) { const f32x4 w = *(const f32x4*)(W + (size_t)k * NMOD); a0 += w * sm[k]; a1 += w * sm[64 + k]; a2 += w * sm[128 + k]; }
            float* P = modp + (((size_t)Lr * 32 + kc) * 3) * NMOD + cc * 2048 + tid * 4;
            *(f32x4*)P = a0; *(f32x4*)(P + NMOD) = a1; *(f32x4*)(P + 2 * NMOD) = a2;
        }
        __syncthreads();
        {
            LAS float* scr = (LAS float*)(L3 + wave * 16384);
            constexpr int I_AQ = 32 * 96, I_AO = 32 * 64, I_BQ = 32 * 192, I_BO = 32 * 64, I_PW = 8 * 16, I_WQ = 32 * 64;
            constexpr int NIT = 2 * I_AQ + 2 * I_AO + I_BQ + I_BO + 4 * I_PW + 4 * I_WQ;
            for (int it = gw; it < NIT; it += NGW) {
                int r = it;
                if (r < 2 * I_AQ) { const int j = r / I_AQ; p0_transpose_item(a.a_wqkv + (size_t)j * DM * 3072, DM, 3072, AWQKV + (size_t)j * 3072 * DM, scr, r % I_AQ, lane); continue; } r -= 2 * I_AQ;
                if (r < 2 * I_AO) { const int j = r / I_AO; p0_transpose_item(a.a_wo + (size_t)j * DM * DM, DM, DM, AWO + (size_t)j * DM * DM, scr, r % I_AO, lane); continue; } r -= 2 * I_AO;
                if (r < I_BQ) { p0_transpose_item(a.b_wqkv, DM, 6144, BWQKV, scr, r, lane); continue; } r -= I_BQ;
                if (r < I_BO) { p0_transpose_item(a.b_wo, DM, DM, BWO, scr, r, lane); continue; } r -= I_BO;
                if (r < 4 * I_PW) { const int j = r / I_PW; p0_transpose_item(a.pool_w + (size_t)j * 512 * 512, 512, 512, PW + (size_t)j * 512 * 512, scr, r % I_PW, lane); continue; } r -= 4 * I_PW;
                { const int j = r / I_WQ; p0_transpose_item(a.peer_wq + (size_t)j * DM * DM, DM, DM, PWQ + (size_t)j * DM * DM, scr, r % I_WQ, lane); }
            }
        }
        {
            const size_t n8 = (size_t)4 * NEXP * DM / 8, gt = (size_t)bx * 512 + tid, nth = (size_t)G * 512;
            for (size_t i = gt; i < 2 * n8; i += nth) {
                const bool isu = i < n8; const size_t j = isu ? i : i - n8;
                const f32x4* s = (const f32x4*)((isu ? a.peer_u : a.peer_v) + j * 8);
                const f32x4 x0 = __builtin_nontemporal_load(s), x1 = __builtin_nontemporal_load(s + 1);
                u32x4 o; o.x = pk2(x0.x, x0.y); o.y = pk2(x0.z, x0.w); o.z = pk2(x1.x, x1.y); o.w = pk2(x1.z, x1.w);
                *(u32x4*)((isu ? UB : VB) + j * 8) = o;
            }
            const size_t nk8 = (size_t)4 * 2 * 128 * 128 / 8;
            for (size_t i = gt; i < nk8; i += nth) {
                const f32x4* s = (const f32x4*)(a.peer_sub_keys + i * 8); const f32x4 x0 = s[0], x1 = s[1];
                u32x4 o; o.x = pk2(x0.x, x0.y); o.y = pk2(x0.z, x0.w); o.z = pk2(x1.x, x1.y); o.w = pk2(x1.z, x1.w);
                *(u32x4*)(SK + i * 8) = o;
            }
        }
        for (int row = gw; row < MR; row += NGW) {
            const int b = row / RPB, r = row % RPB;
            const f32x4* src = (const f32x4*)(r < CTX ? a.ctx + ((size_t)b * CTX + r) * DM : a.x + ((size_t)b * SEQ + (r - CTX)) * DM) + lane;
            f32x4* dst = (f32x4*)(X + (size_t)row * DM) + lane;
#pragma unroll
            for (int j = 0; j < 8; ++j) dst[64 * j] = src[64 * j];
        }
    }
    SEAM(0);
    if (PHM(1) && IN(1)) { WS_LAUNDER();
        for (int i = bx * 512 + tid; i < 4 * 3 * NMOD; i += G * 512) {
            const int Lr = i / (3 * NMOD), r = i % (3 * NMOD), n = r % NMOD;
            float s = a.mod_b[Lr * NMOD + n];
            for (int kc = 0; kc < 32; ++kc) s += modp[((size_t)Lr * 32 + kc) * 3 * NMOD + r];
            modv[i] = s;
        }
    }
    SEAM(1);

    for (int Lr = 0; Lr < 4; ++Lr) {
        const int kind = Lr % 3, jj = Lr / 3, pb = 2 + Lr * 9;
#define modl (modv + (size_t)Lr * 3 * NMOD)
        if (MIXON(Lr) && PHM(2) && IN(pb + 0)) { WS_LAUNDER();
            const float* w = a.norm_w + (size_t)(Lr * 2 + 0) * DM;
            for (int row = gw; row < MR; row += NGW) { const int b = row / RPB, r = row % RPB, v = r < CTX ? 2 : b; const float* mv = modl + (size_t)v * NMOD;
                norm_mod_row(X + (size_t)row * DM, w, mv + 0 * DM, mv + 1 * DM, H + (size_t)row * DM, lane); }
        }
        SEAM(pb + 0);
        if (MIXON(Lr) && PHM(3) && IN(pb + 1)) { WS_LAUNDER();
            if (kind != 2) { const int N = kind == 0 ? 3072 : 6144; pg8::Gemm g{H, kind == 0 ? AWQKV + (size_t)jj * 3072 * DM : BWQKV, MR, N, DM};
                pg8::FlexOrder S; S.init(MR, N, G, bx, 0); pg8::EpiBf16 E{QKV, N};
                pg8::gemm_phase<pg8::EpiBf16, pg8::FlexOrder>(L3, g, S, E); }
            else {
                for (int row = gw; row < MR; row += NGW) {
                    const int r = row % RPB; const int isl = r >= CTX; const int t = isl ? r - CTX : r, Ls = isl ? SEQ : CTX; const int row0 = row - t;
#pragma unroll
                    for (int g = 0; g < 4; ++g) {
                        const int w = 2 << g; int lo_ = t - w / 2; lo_ = lo_ < 0 ? 0 : lo_; int hi_ = t + w - w / 2; hi_ = hi_ > Ls ? Ls : hi_;
                        float s[8] = {0.f, 0.f, 0.f, 0.f, 0.f, 0.f, 0.f, 0.f};
                        for (int q = lo_; q < hi_; ++q) { const u32x4 hv = *(const u32x4*)(H + (size_t)(row0 + q) * DM + g * 512 + lane * 8);
                            s[0] += bflo(hv.x); s[1] += bfhi(hv.x); s[2] += bflo(hv.y); s[3] += bfhi(hv.y); s[4] += bflo(hv.z); s[5] += bfhi(hv.z); s[6] += bflo(hv.w); s[7] += bfhi(hv.w); }
                        const u32x4 hs = *(const u32x4*)(H + (size_t)row * DM + g * 512 + lane * 8); const float ic = 1.f / (float)(hi_ - lo_);
                        u32x4 o; o.x = pk2(s[0] * ic - bflo(hs.x), s[1] * ic - bfhi(hs.x)); o.y = pk2(s[2] * ic - bflo(hs.y), s[3] * ic - bfhi(hs.y));
                        o.z = pk2(s[4] * ic - bflo(hs.z), s[5] * ic - bfhi(hs.z)); o.w = pk2(s[6] * ic - bflo(hs.w), s[7] * ic - bfhi(hs.w));
                        *(u32x4*)(OB + ((size_t)g * MR + row) * 512 + lane * 8) = o;
                    }
                }
            }
        }
        SEAM(pb + 1);
        if (MIXON(Lr) && PHM(4) && IN(pb + 2) && kind == 0) { WS_LAUNDER();
            const float* qg = a.a_q_gain + jj * 128; const float* kg = a.a_k_gain + jj * 128;
            const int i = lane & 31, base = (lane >> 5) * 64;
            const float inv = exp2f(-(float)(2 * i) * (1.f / 64.f) * 13.287712379549449f);
            const float g1q = qg[base + i], g2q = qg[base + i + 32], g1k = kg[base + i], g2k = kg[base + i + 32];
            for (int row = gw; row < MR; row += NGW) {
                const int r = row % RPB; const bool isl = r >= CTX; const int t = r - CTX;
                float cs = 1.f, sn = 0.f;
                if (isl) { const float pos = (float)((lane < 32) ? (t >> 6) : (t & 63)); const float ang = pos * inv; cs = cosf(ang); sn = sinf(ang); }
                bf16* p = QKV + (size_t)row * 3072;
                for (int s = 0; s < 20; ++s) {
                    bf16* ph = p + s * 128 + base + i;
                    const float x1 = bf2f(ph[0]), x2 = bf2f(ph[32]);
                    const float rstd = 1.f / sqrtf(wave_sum(x1 * x1 + x2 * x2) * (1.f / 128.f) + EPS);
                    const float y1 = x1 * rstd * (s < 16 ? g1q : g1k), y2 = x2 * rstd * (s < 16 ? g2q : g2k);
                    ph[0] = (bf16)f2bf(y1 * cs - y2 * sn); ph[32] = (bf16)f2bf(y2 * cs + y1 * sn);
                }
            }
        }
        if (kind == 0) SEAM(pb + 2);
        if (MIXON(Lr) && PHM(5) && IN(pb + 3) && kind == 0) { WS_LAUNDER();
            for (int it = vcu; it < 512 + 32; it += G) {
                const bool isl = it < 512; const int q = isl ? it : it - 512;
                const int qb = isl ? (q & 15) : 0, h = isl ? ((q >> 4) & 15) : (q & 15), b = isl ? (q >> 8) : (q >> 4), kvh = h >> 2;
                const bf16* base = QKV + (size_t)b * RPB * 3072; const int qrow0 = isl ? CTX + qb * 256 : 0;
                att::attn_body<3072>(base + (size_t)qrow0 * 3072 + h * 128, base + 2048 + kvh * 128, base + 2560 + kvh * 128, OB + ((size_t)b * RPB + qrow0) * DM + h * 128, isl ? 68 : 4, (char*)lds);
            }
        }
        if (MIXON(Lr) && PHM(12) && IN(pb + 3) && kind == 1) { WS_LAUNDER();
            float* bl = (float*)((char*)lds + att::SHM_ATTN);
            for (int it = vcu; it < 512 + 32; it += G) {
                const bool isl = it < 512; const int q = isl ? it : it - 512;
                const int qb = isl ? (q & 15) : 0, h = isl ? ((q >> 4) & 15) : (q & 15), b = isl ? (q >> 8) : (q >> 4);
                int kr_lo = qb * 4 - 4; kr_lo = kr_lo < 0 ? 0 : (kr_lo > 52 ? 52 : kr_lo);
                { const float* rp = a.b_rpb + (size_t)h * 465; for (int z = tid; z < 465; z += 512) bl[z] = rp[z] * (1.f / att::SCALE); __syncthreads(); }
                const bf16* base = QKV + (size_t)b * RPB * 6144; const int qrow0 = isl ? CTX + qb * 256 : 0;
                att::attn_na_body(base + (size_t)qrow0 * 6144 + h * 128, base + 2048 + h * 128, base + 4096 + h * 128, OB + ((size_t)b * RPB + qrow0) * DM + h * 128, kr_lo, qb * 4, bl, isl ? 16 : 4, (char*)lds);
            }
        }
        if (kind != 2) SEAM(pb + 3);
        if (MIXON(Lr) && PHM(6) && IN(pb + 4)) { WS_LAUNDER();
            const bool grp = kind == 2;
            pg8::Gemm g{OB, grp ? PW : (kind == 0 ? AWO + (size_t)jj * DM * DM : BWO), grp ? 4 * MR : MR, DM, grp ? 512 : DM};
            pg8::FlexOrder S; S.init(MR, DM, G, bx, grp ? 1 : 0); pg8::EpiResid E{X, modl, 2 * DM, grp ? a.pool_scale : nullptr, grp ? 34 : (1 << 20)};
            pg8::gemm_phase<pg8::EpiResid, pg8::FlexOrder>(L3, g, S, E);
        }
        SEAM(pb + 4);
        if (PEERON(Lr) && PHM(7) && IN(pb + 5)) { WS_LAUNDER();
            const float* w = a.norm_w + (size_t)(Lr * 2 + 1) * DM;
            for (int row = gw; row < MR; row += NGW) { const int b = row / RPB, r = row % RPB, v = r < CTX ? 2 : b; const float* mv = modl + (size_t)v * NMOD;
                norm_mod_row(X + (size_t)row * DM, w, mv + 3 * DM, mv + 4 * DM, H + (size_t)row * DM, lane); }
        }
        SEAM(pb + 5);
        if (PEERON(Lr) && PHM(8) && IN(pb + 6)) { WS_LAUNDER();
#if NAIVE_PQ
            { const float* wq = a.peer_wq + (size_t)Lr * DM * DM;
              for (size_t o = (size_t)bx * 512 + tid; o < (size_t)MR * DM; o += (size_t)G * 512) { const int row = (int)(o / DM), n = (int)(o % DM); float s = 0.f;
                  for (int k = 0; k < DM; ++k) s += bf2f(H[(size_t)row * DM + k]) * wq[(size_t)k * DM + n];
                  PQ[o] = (bf16)f2bf(s); } }
#else
            pg8::Gemm g{H, PWQ + (size_t)Lr * DM * DM, MR, DM, DM}; pg8::FlexOrder S; S.init(MR, DM, G, bx, 0); pg8::EpiBf16 E{PQ, DM};
            pg8::gemm_phase<pg8::EpiBf16, pg8::FlexOrder>(L3, g, S, E);
#endif
        }
        SEAM(pb + 6);

#if NAIVE_ROUTE
        if (PEERON(Lr) && PHM(9) && IN(pb + 7)) { WS_LAUNDER();
            for (int task = gw; task < MR * 8; task += NGW) {
                const int tok = task >> 3, h = task & 7;
                const bf16* qrow = PQ + (size_t)tok * DM + h * 256;
                const bf16* sk = SK + (size_t)Lr * 2 * 128 * 128;
                float s1a = 0.f, s1b = 0.f, s2a = 0.f, s2b = 0.f;
                for (int d = 0; d < 128; ++d) { const float q1 = bf2f(qrow[d]), q2 = bf2f(qrow[128 + d]);
                    s1a += q1 * bf2f(sk[(size_t)lane * 128 + d]); s1b += q1 * bf2f(sk[(size_t)(64 + lane) * 128 + d]);
                    s2a += q2 * bf2f(sk[(size_t)(128 + lane) * 128 + d]); s2b += q2 * bf2f(sk[(size_t)(192 + lane) * 128 + d]); }
                float v1 = 0.f, v2 = 0.f; int i1 = 0, i2 = 0;
                for (int q = 0; q < 16; ++q) {
                    { float bv = s1a > s1b ? s1a : s1b; int bi = s1a > s1b ? lane : lane + 64;
                      for (int o = 1; o < 64; o <<= 1) { const float ov = __shfl_xor(bv, o); const int oi = __shfl_xor(bi, o); if (ov > bv || (ov == bv && oi < bi)) { bv = ov; bi = oi; } }
                      if (lane == q) { v1 = bv; i1 = bi; } if (bi == lane) s1a = -3e38f; if (bi == lane + 64) s1b = -3e38f; }
                    { float bv = s2a > s2b ? s2a : s2b; int bi = s2a > s2b ? lane : lane + 64;
                      for (int o = 1; o < 64; o <<= 1) { const float ov = __shfl_xor(bv, o); const int oi = __shfl_xor(bi, o); if (ov > bv || (ov == bv && oi < bi)) { bv = ov; bi = oi; } }
                      if (lane == q) { v2 = bv; i2 = bi; } if (bi == lane) s2a = -3e38f; if (bi == lane + 64) s2b = -3e38f; }
                }
                float cv[4]; int ce[4];
#pragma unroll
                for (int z = 0; z < 4; ++z) { const int c = lane + 64 * z, ca = c >> 4, cb = c & 15; cv[z] = __shfl(v1, ca) + __shfl(v2, cb); ce[z] = __shfl(i1, ca) * 128 + __shfl(i2, cb); }
                float sv = 0.f; int se = 0;
                for (int q = 0; q < 16; ++q) {
                    float bv = cv[0]; int bz = 0;
#pragma unroll
                    for (int z = 1; z < 4; ++z) if (cv[z] > bv) { bv = cv[z]; bz = z; }
                    int bi = lane + 64 * bz; int be = bz == 0 ? ce[0] : (bz == 1 ? ce[1] : (bz == 2 ? ce[2] : ce[3]));
                    for (int o = 1; o < 64; o <<= 1) { const float ov = __shfl_xor(bv, o); const int oi = __shfl_xor(bi, o); const int oe = __shfl_xor(be, o); if (ov > bv || (ov == bv && oi < bi)) { bv = ov; bi = oi; be = oe; } }
                    if (lane == q) { sv = bv; se = be; }
#pragma unroll
                    for (int z = 0; z < 4; ++z) if (bi == lane + 64 * z) cv[z] = -3e38f;
                }
                const float mx = __shfl(sv, 0); float ev = lane < 16 ? __expf(sv - mx) : 0.f; const float su = wave_sum(ev);
                if (lane < 16) { IDX[(size_t)tok * 128 + h * 16 + lane] = se; GATE[(size_t)tok * 128 + h * 16 + lane] = ev / su; }
            }
        }
#else
        if (PEERON(Lr) && PHM(9) && IN(pb + 7)) { WS_LAUNDER();
            const int j32 = lane & 31, hi = lane >> 5;
            for (int task = gw; task < (MR / 32) * 8; task += NGW) {
                const int grp = task >> 3, h = task & 7, tok = grp * 32 + j32;
                const bf16* qrow = PQ + (size_t)tok * DM + h * 256;
                const bf16* sk = SK + (size_t)Lr * 2 * 128 * 128;
                f32x16 p1[4], p2[4];
#pragma unroll
                for (int kt = 0; kt < 4; ++kt) { p1[kt] = f32x16{}; p2[kt] = f32x16{}; }
#pragma unroll 1
                for (int ks = 0; ks < 8; ++ks) {
                    const bf16x8 q1 = *(const bf16x8*)(qrow + ks * 16 + hi * 8), q2 = *(const bf16x8*)(qrow + 128 + ks * 16 + hi * 8);
#pragma unroll
                    for (int kt = 0; kt < 4; ++kt) {
                        const bf16x8 k1 = *(const bf16x8*)(sk + (size_t)(kt * 32 + j32) * 128 + ks * 16 + hi * 8);
                        const bf16x8 k2 = *(const bf16x8*)(sk + (size_t)(128 + kt * 32 + j32) * 128 + ks * 16 + hi * 8);
                        p1[kt] = __builtin_amdgcn_mfma_f32_32x32x16_bf16(k1, q1, p1[kt], 0, 0, 0);
                        p2[kt] = __builtin_amdgcn_mfma_f32_32x32x16_bf16(k2, q2, p2[kt], 0, 0, 0);
                    }
                }
                unsigned Lt[16];
#pragma unroll
                for (int q = 0; q < 16; ++q) Lt[q] = 0u;
#pragma unroll
                for (int kt = 0; kt < 4; ++kt)
#pragma unroll
                    for (int r = 0; r < 16; ++r) {
                        auto rr = __builtin_amdgcn_permlane32_swap(__float_as_uint(p1[kt][r]), __float_as_uint(p2[kt][r]), false, false);
                        const unsigned ka = (mono(__uint_as_float(rr[0])) & 0xFFFFFF80u) | (unsigned)(kt * 32 + att::crow(r, 0));
                        const unsigned kb = (mono(__uint_as_float(rr[1])) & 0xFFFFFF80u) | (unsigned)(kt * 32 + att::crow(r, 1));
                        INS16(Lt, ka); INS16(Lt, kb);
                    }
                unsigned L1[16], L2[16]; float v1[16], v2[16];
#pragma unroll
                for (int q = 0; q < 16; ++q) { auto rr = __builtin_amdgcn_permlane32_swap(Lt[q], Lt[q], false, false); L1[q] = rr[0]; L2[q] = rr[1];
                    v1[q] = unmono(L1[q] & 0xFFFFFF80u); v2[q] = unmono(L2[q] & 0xFFFFFF80u); }
                unsigned Cd[16];
#pragma unroll
                for (int q = 0; q < 16; ++q) Cd[q] = 0u;
#pragma unroll
                for (int ia = 0; ia < 16; ++ia)
#pragma unroll
                    for (int ib = 0; ib < 16; ++ib) if ((ia + 1) * (ib + 1) <= 16) { const unsigned kx = (mono(v1[ia] + v2[ib]) & 0xFFFFFF00u) | (unsigned)(ia * 16 + ib); INS16(Cd, kx); }
                int eid[16];
#pragma unroll
                for (int q = 0; q < 16; ++q) {
                    const unsigned ia = (Cd[q] >> 4) & 15u, ib = Cd[q] & 15u;
                    unsigned e1 = L1[0], e2 = L2[0];
#pragma unroll
                    for (int z = 1; z < 16; ++z) { e1 = (ia == (unsigned)z) ? L1[z] : e1; e2 = (ib == (unsigned)z) ? L2[z] : e2; }
                    eid[q] = (int)((e1 & 127u) * 128u + (e2 & 127u));
                }
                {
                    const float mx = unmono(Cd[0] & 0xFFFFFF00u); float ev[16], su = 0.f;
#pragma unroll
                    for (int q = 0; q < 16; ++q) { ev[q] = __expf(unmono(Cd[q] & 0xFFFFFF00u) - mx); su += ev[q]; }
                    const float inv = 1.f / su;
                    if (hi == 0) {
                        int* ip = IDX + (size_t)tok * 128 + h * 16; float* gp = GATE + (size_t)tok * 128 + h * 16;
#pragma unroll
                        for (int q = 0; q < 16; ++q) { ip[q] = eid[q]; gp[q] = ev[q] * inv; }
                    }
                }
            }
        }
#endif
        SEAM(pb + 7);
#if NAIVE_EXPERT
        if (PEERON(Lr) && PHM(10) && IN(pb + 8)) { WS_LAUNDER();
            float* fs = (float*)lds; float* cfs = fs + 2048;
            for (int row = vcu; row < MR; row += G) {
                const int b = row / RPB, r = row % RPB, v = r < CTX ? 2 : b; const float* g5 = modl + (size_t)v * NMOD + 5 * DM;
                for (int c = tid; c < DM; c += 512) fs[c] = bf2f(H[(size_t)row * DM + c]);
                __syncthreads();
                for (int k = wave; k < 128; k += 8) { const int e = IDX[(size_t)row * 128 + k]; const float* u = a.peer_u + ((size_t)Lr * NEXP + e) * DM; float d = 0.f;
                    for (int c = lane; c < DM; c += 64) d += fs[c] * u[c];
                    d = wave_sum(d); if (lane == 0) cfs[k] = gelu_tanh(d) * GATE[(size_t)row * 128 + k]; }
                __syncthreads();
                f32x4 o = {0.f, 0.f, 0.f, 0.f};
                for (int k = 0; k < 128; ++k) { const int e = IDX[(size_t)row * 128 + k]; const f32x4 vv = *(const f32x4*)(a.peer_v + ((size_t)Lr * NEXP + e) * DM + tid * 4); o += vv * cfs[k]; }
                f32x4* p = (f32x4*)(X + (size_t)row * DM + tid * 4); const f32x4 gv = *(const f32x4*)(g5 + tid * 4); *p = *p + gv * o;
                __syncthreads();
            }
        }
#else
        if (PEERON(Lr) && PHM(10) && IN(pb + 8)) { WS_LAUNDER();
            const bf16* Ul = UB + (size_t)Lr * NEXP * DM; const bf16* Vl = VB + (size_t)Lr * NEXP * DM;
            for (int row = gw; row < MR; row += NGW) {
                const int b = row / RPB, r = row % RPB, v = r < CTX ? 2 : b; const float* g5 = modl + (size_t)v * NMOD + 5 * DM;
                u32x4 xq[4];
#pragma unroll
                for (int c = 0; c < 4; ++c) xq[c] = *(const u32x4*)(H + (size_t)row * DM + c * 512 + lane * 8);
                const int ia = IDX[(size_t)row * 128 + lane], ib = IDX[(size_t)row * 128 + 64 + lane];
                const float ga = GATE[(size_t)row * 128 + lane], gb = GATE[(size_t)row * 128 + 64 + lane];
                float acc[32];
#pragma unroll
                for (int q = 0; q < 32; ++q) acc[q] = 0.f;
#pragma unroll 2
                for (int k = 0; k < 128; ++k) {
                    const int e = __builtin_amdgcn_readlane(k < 64 ? ia : ib, k & 63);
                    const float gt = __uint_as_float(__builtin_amdgcn_readlane(__float_as_uint(k < 64 ? ga : gb), k & 63));
                    const u32x4* ur = (const u32x4*)(Ul + (size_t)e * DM) + lane; const u32x4* vr = (const u32x4*)(Vl + (size_t)e * DM) + lane;
                    u32x4 uw[4], vw[4];
#pragma unroll
                    for (int c = 0; c < 4; ++c) { uw[c] = ur[c * 64]; vw[c] = vr[c * 64]; }
                    float d = 0.f;
#pragma unroll
                    for (int c = 0; c < 4; ++c) {
                        d = dot2bf(uw[c].x, xq[c].x, d); d = dot2bf(uw[c].y, xq[c].y, d); d = dot2bf(uw[c].z, xq[c].z, d); d = dot2bf(uw[c].w, xq[c].w, d);
                    }
                    d = wave_sum(d);
                    const float cf = gelu_tanh(d) * gt;
#pragma unroll
                    for (int c = 0; c < 4; ++c) {
                        acc[c * 8 + 0] += cf * bflo(vw[c].x); acc[c * 8 + 1] += cf * bfhi(vw[c].x); acc[c * 8 + 2] += cf * bflo(vw[c].y); acc[c * 8 + 3] += cf * bfhi(vw[c].y);
                        acc[c * 8 + 4] += cf * bflo(vw[c].z); acc[c * 8 + 5] += cf * bfhi(vw[c].z); acc[c * 8 + 6] += cf * bflo(vw[c].w); acc[c * 8 + 7] += cf * bfhi(vw[c].w);
                    }
                }
                float* xr = X + (size_t)row * DM;
#pragma unroll
                for (int c = 0; c < 4; ++c)
#pragma unroll
                    for (int hq = 0; hq < 2; ++hq) { const int col = c * 512 + lane * 8 + hq * 4; f32x4* p = (f32x4*)(xr + col); const f32x4 gv = *(const f32x4*)(g5 + col);
                        f32x4 o = *p; o.x += gv.x * acc[c * 8 + hq * 4 + 0]; o.y += gv.y * acc[c * 8 + hq * 4 + 1]; o.z += gv.z * acc[c * 8 + hq * 4 + 2]; o.w += gv.w * acc[c * 8 + hq * 4 + 3]; *p = o; }
            }
        }
#endif
        SEAM(pb + 8);
    }
    if (PHM(11) && IN(NPHASE - 1)) { WS_LAUNDER();
        for (int rr = gw; rr < NB * SEQ; rr += NGW) {
            const int b = rr / SEQ, t = rr % SEQ; const f32x4* xr = (const f32x4*)(X + ((size_t)b * RPB + CTX + t) * DM) + lane;
            f32x4 v[8]; float ss = 0.f;
#pragma unroll
            for (int j = 0; j < 8; ++j) { v[j] = xr[64 * j]; ss += (v[j].x * v[j].x + v[j].y * v[j].y) + (v[j].z * v[j].z + v[j].w * v[j].w); }
            const float rstd = 1.f / sqrtf(wave_sum(ss) * (1.f / DM) + EPS);
            f32x4* o = (f32x4*)(a.out + (size_t)rr * DM) + lane;
#pragma unroll
            for (int j = 0; j < 8; ++j) { const f32x4 wv = *((const f32x4*)a.final_norm_w + lane + 64 * j); o[64 * j] = v[j] * rstd * wv; }
        }
    }
#undef IN
#undef SEAM
}

extern "C" void kernel_launch(void* const* d_in, const int* in_sizes, int n_in, void* d_out, int out_size, void* d_ws, size_t ws_size, hipStream_t stream) {
    static int grid = 0;
    if (grid == 0) {
        if (n_in != 21 || out_size != NB * SEQ * DM || ws_size < WS_END) { fprintf(stderr, "kernel_launch: unexpected shapes (n_in %d out %d ws %zu)\n", n_in, out_size, ws_size); grid = -1; return; }
        int dev = 0, cus = 0, per_cu = 0;
        if (hipGetDevice(&dev) != hipSuccess || hipDeviceGetAttribute(&cus, hipDeviceAttributeMultiprocessorCount, dev) != hipSuccess) { grid = -1; return; }
        if (hipFuncSetAttribute((const void*)fwd_kernel, hipFuncAttributeMaxDynamicSharedMemorySize, LDS_BYTES) != hipSuccess) { fprintf(stderr, "kernel_launch: hipFuncSetAttribute failed\n"); grid = -1; return; }
        if (hipOccupancyMaxActiveBlocksPerMultiprocessor(&per_cu, (const void*)fwd_kernel, 512, LDS_BYTES) != hipSuccess || per_cu < 1) { fprintf(stderr, "kernel_launch: occupancy query reports %d\n", per_cu); (void)hipGetLastError(); grid = -1; return; }
        grid = cus;
    }
    if (grid < 0) return;
    (void)hipMemsetAsync((char*)d_ws + WS_CTL, 0, CTL_ZERO_BYTES, stream);
    Args a{};
    const float** f = (const float**)&a;
    for (int i = 0; i < 21; ++i) f[i] = (const float*)d_in[i];
    a.out = (float*)d_out; a.ws = (unsigned char*)d_ws;
#if ONE_LAUNCH
    a.ph_lo = 0; a.ph_hi = NPHASE;
    hipLaunchKernelGGL(fwd_kernel, dim3(grid), dim3(512), LDS_BYTES, stream, a);
#else
    for (int p = 0; p < NPHASE; ++p) {
        if (p >= 2 && p < NPHASE - 1) { const int L = (p - 2) / 9, k = (p - 2) % 9, kind = L % 3; if ((k == 2 && kind != 0) || (k == 3 && kind == 2)) continue; }
        a.ph_lo = p; a.ph_hi = p + 1;
        hipLaunchKernelGGL(fwd_kernel, dim3(grid), dim3(512), LDS_BYTES, stream, a);
    }
#endif
}
```

```cpp
#include <hip/hip_runtime.h>
#include <cstdio>
#include <cstdint>

#ifndef ONE_LAUNCH
#define ONE_LAUNCH 1
#endif
#ifndef NAIVE_ROUTE
#define NAIVE_ROUTE 0
#endif
#ifndef NAIVE_EXPERT
#define NAIVE_EXPERT 0
#endif
#ifndef NAIVE_PQ
#define NAIVE_PQ 0
#endif
#ifndef PHMASK
#define PHMASK 0xFFFF
#endif
#define PHM(b) ((PHMASK >> (b)) & 1)
#ifndef MIXMASK
#define MIXMASK 15
#endif
#ifndef PEERMASK
#define PEERMASK 15
#endif
#define MIXON(L) ((MIXMASK >> (L)) & 1)
#define PEERON(L) ((PEERMASK >> (L)) & 1)

constexpr int DM = 2048, NB = 2, SEQ = 4096, CTX = 256, RPB = CTX + SEQ  , MR = NB * RPB  ;
constexpr int NMOD = 6 * DM;
constexpr int NEXP = 16384;
constexpr float EPS = 1e-6f;

#define LAS __attribute__((address_space(3)))
typedef unsigned short bf16;
typedef short bf16x8 __attribute__((ext_vector_type(8)));
typedef short s16x4 __attribute__((ext_vector_type(4)));
typedef float f32x4 __attribute__((ext_vector_type(4)));
typedef float f32x16 __attribute__((ext_vector_type(16)));
typedef unsigned u32x4 __attribute__((ext_vector_type(4)));
typedef unsigned u32x2 __attribute__((ext_vector_type(2)));
typedef __bf16 bf2v __attribute__((ext_vector_type(2)));

__device__ __forceinline__ unsigned f2bf(float f) { unsigned u = __builtin_bit_cast(unsigned, f); return (u + 0x7fffu + ((u >> 16) & 1u)) >> 16; }
__device__ __forceinline__ unsigned pk2(float lo, float hi) { unsigned r; asm volatile("v_cvt_pk_bf16_f32 %0, %1, %2" : "=v"(r) : "v"(lo), "v"(hi)); return r; }
__device__ __forceinline__ float dot2bf(unsigned a, unsigned b, float acc) { const unsigned a_ = a, b_ = b; return __builtin_amdgcn_fdot2_f32_bf16(__builtin_bit_cast(bf2v, a_), __builtin_bit_cast(bf2v, b_), acc, false); }
__device__ __forceinline__ float bflo(unsigned w) { return __builtin_bit_cast(float, w << 16); }
__device__ __forceinline__ float bfhi(unsigned w) { return __builtin_bit_cast(float, w & 0xffff0000u); }
__device__ __forceinline__ float bf2f(bf16 b) { return __builtin_bit_cast(float, ((unsigned)b) << 16); }
__device__ __forceinline__ int opaque_tid() { int t = threadIdx.x; asm volatile("" : "+v"(t)); return t; }
__device__ __forceinline__ float wave_sum(float v) {
#pragma unroll
    for (int o = 1; o < 64; o <<= 1) v += __shfl_xor(v, o);
    return v;
}

#define XB_TMO      128
#define XB_XCNT(j)  (256  + 64 * (j))
#define XB_XSUB(j)  (1280 + 64 * (j))
#define XB_XGEN(j)  (2304 + 64 * (j))
#define XB_TOP      3328
#define XB_TOPGEN   3392
#define XCD_BAR_WORDS 3456
#define XB_SPIN_CAP (1u << 18)

__device__ __forceinline__ unsigned xb_ld(unsigned* p)              { return __hip_atomic_load(p, __ATOMIC_RELAXED, __HIP_MEMORY_SCOPE_AGENT); }
__device__ __forceinline__ unsigned xb_add(unsigned* p, unsigned v) { return __hip_atomic_fetch_add(p, v, __ATOMIC_RELAXED, __HIP_MEMORY_SCOPE_AGENT); }
__device__ __forceinline__ unsigned xb_xcc_id() { return (unsigned)__builtin_amdgcn_s_getreg((3 << 11) | 20) & 0xFu; }
#define XB_SPIN(cond, bar) do { unsigned _sp = 0; while (cond) { __builtin_amdgcn_s_sleep(1); \
    if ((++_sp & 255u) == 0u) { if (xb_ld(&(bar)[XB_TMO])) break; if (_sp > XB_SPIN_CAP) { atomicAdd(&(bar)[XB_TMO], 1u); break; } } } } while (0)

struct XcdBarrier { unsigned* bar; unsigned x; volatile LAS unsigned* st; };

__device__ __forceinline__ XcdBarrier xcd_barrier_post(unsigned* bar, volatile LAS unsigned* st) {
    XcdBarrier b; b.bar = bar; b.x = xb_xcc_id(); b.st = st;
    if (threadIdx.x == 0) (void)xb_add(&bar[XB_XCNT(b.x)], 1u);
    return b;
}
__device__ __forceinline__ void xcd_barrier_complete(unsigned* bar, unsigned x, unsigned& nloc, unsigned& nx) {
    const unsigned G = gridDim.x * gridDim.y * gridDim.z;
    unsigned sum, cnt, mine, sp = 0u;
    for (;;) {
        sum = 0u; cnt = 0u; mine = 0u;
#pragma unroll
        for (unsigned j = 0; j < 16; ++j) { const unsigned c = xb_ld(&bar[XB_XCNT(j)]); sum += c; cnt += (c > 0u) ? 1u : 0u; mine = (j == x) ? c : mine; }
        if (sum == G) break;
        __builtin_amdgcn_s_sleep(1);
        if ((++sp & 255u) == 0u) { if (xb_ld(&bar[XB_TMO])) break; if (sp > XB_SPIN_CAP) { atomicAdd(&bar[XB_TMO], 1u); break; } }
    }
    nloc = mine > 0u ? mine : 1u; nx = cnt > 0u ? cnt : 1u;
}
__device__ __forceinline__ void xcd_barrier(const XcdBarrier& b) {
    asm volatile("s_waitcnt vmcnt(0)" ::: "memory");
    __syncthreads();
    if (threadIdx.x == 0) {
        unsigned* bar = b.bar;
        __builtin_amdgcn_s_waitcnt(0);
        unsigned nloc = b.st[0], nx = b.st[1];
        if (nloc == 0u) { xcd_barrier_complete(bar, b.x, nloc, nx); b.st[0] = nloc; b.st[1] = nx; }
        const unsigned old = xb_add(&bar[XB_XSUB(b.x)], 1u);
        const unsigned gen = old / nloc;
        if (old + 1u == (gen + 1u) * nloc) {
            __builtin_amdgcn_fence(__ATOMIC_RELEASE, "agent");
            asm volatile("s_waitcnt vmcnt(0)" ::: "memory");
            const unsigned og = xb_add(&bar[XB_TOP], 1u);
            const unsigned tg = og / nx;
            if (og + 1u == (tg + 1u) * nx) xb_add(&bar[XB_TOPGEN], 1u);
            else XB_SPIN(xb_ld(&bar[XB_TOPGEN]) == tg, bar);
            __builtin_amdgcn_fence(__ATOMIC_ACQUIRE, "agent");
            xb_add(&bar[XB_XGEN(b.x)], 1u);
            asm volatile("s_waitcnt vmcnt(0)" ::: "memory");
        } else {
            XB_SPIN(xb_ld(&bar[XB_XGEN(b.x)]) == gen, bar);
            __builtin_amdgcn_fence(__ATOMIC_ACQUIRE, "agent");
            asm volatile("s_waitcnt vmcnt(0)" ::: "memory");
        }
    }
    __syncthreads();
}

namespace pg8 {
constexpr int BM = 256, BK = 64, HALF = 128, HTB = HALF * BK * 2, STAGE_BYTES = 8 * HTB, NXCD = 8, WGM = 8;
__host__ __device__ __forceinline__ int lds_byte(int r, int c) { const int st = (r >> 4) * 2 + (c >> 5), rr = r & 15, cc = c & 31, ob = rr * 64 + cc * 2; return st * 1024 + (ob ^ (((ob >> 9) & 1) << 5)); }
__host__ __device__ __forceinline__ void stage_rc(int b, int& R, int& C) { const int st = b / 1024, sb = b % 1024, swz = sb ^ (((sb >> 9) & 1) << 5); R = (st >> 1) * 16 + swz / 64; C = (st & 1) * 32 + (swz % 64) / 2; }
__host__ __device__ __forceinline__ int perm32(int rho) { const int n = rho >> 4, i = rho & 15; return 8 * (i >> 2) + 4 * n + (i & 3); }

struct Unit { int pm, pn; };
struct Gemm { const bf16* A; const bf16* Bt; int M, N, K; };

struct StaticOrder {
    int nM, nN, nwg, G, c;
    __host__ __device__ void init(int M, int N, int G_, int c_) { nM = M / BM; nN = N / BM; nwg = nM * nN; G = G_; c = c_; }
    __host__ __device__ bool next(int i, Unit& u) const {
        const long L = (long)i * G + c; if (L >= nwg) return false;
        int wgid = (int)L; { const int q = nwg / NXCD, r = nwg % NXCD, xcd = wgid % NXCD, off = wgid / NXCD; wgid = (xcd < r ? xcd * (q + 1) : r * (q + 1) + (xcd - r) * q) + off; }
        const int nig = WGM * nN, gid = wgid / nig, fm = gid * WGM, gsz = (nM - fm) < WGM ? (nM - fm) : WGM;
        u.pm = fm + ((wgid % nig) % gsz); u.pn = (wgid % nig) / gsz; return true;
    }
    __device__ __forceinline__ void a_ready(const Unit&) const {}
    __device__ __forceinline__ void done(const Unit&) const {}
};
struct FlexOrder {
    int nM, nN, nwg, G, c, grouped;
    __device__ void init(int M, int N, int G_, int c_, int grouped_) { nM = M / BM; nN = N / BM; nwg = grouped_ ? 272 : nM * nN; G = G_; c = c_; grouped = grouped_; }
    __device__ bool next(int i, Unit& u) const {
        const long L = (long)i * G + c; if (L >= nwg) return false;
        if (grouped) { const int g = (int)L / 68, r = (int)L % 68; u.pm = g * 34 + (r >> 1); u.pn = g * 2 + (r & 1); return true; }
        int wgid = (int)L; { const int q = nwg / NXCD, r = nwg % NXCD, xcd = wgid % NXCD, off = wgid / NXCD; wgid = (xcd < r ? xcd * (q + 1) : r * (q + 1) + (xcd - r) * q) + off; }
        const int nig = WGM * nN, gid = wgid / nig, fm = gid * WGM, gsz = (nM - fm) < WGM ? (nM - fm) : WGM;
        u.pm = fm + ((wgid % nig) % gsz); u.pn = (wgid % nig) / gsz; return true;
    }
    __device__ __forceinline__ void a_ready(const Unit&) const {}
    __device__ __forceinline__ void done(const Unit&) const {}
};

struct EpiBf16 {
    static constexpr bool PERM = true, AFTER_DRAIN = false;
    bf16* O; int ldc;
    __device__ __forceinline__ void operator()(const f32x4 (&acc)[2][2][4][2], const Unit& u, int wr, int wc, int fr, int fq) const {
        const int row0 = u.pm * BM + wr * 64 + fr; const int col0 = u.pn * BM + wc * 32 + 8 * fq;
#pragma unroll
        for (int ai = 0; ai < 2; ++ai)
#pragma unroll
            for (int m = 0; m < 4; ++m) { bf16* rowp = O + (size_t)(row0 + ai * HALF + m * 16) * ldc + col0;
#pragma unroll
                for (int bj = 0; bj < 2; ++bj) { const f32x4 v0 = acc[ai][bj][m][0], v1 = acc[ai][bj][m][1];
                    u32x4 w; w.x = pk2(v0[0], v0[1]); w.y = pk2(v0[2], v0[3]); w.z = pk2(v1[0], v1[1]); w.w = pk2(v1[2], v1[3]);
                    *(u32x4*)(rowp + bj * HALF) = w; } }
    }
};
struct EpiResid {
    static constexpr bool PERM = false, AFTER_DRAIN = false;
    float* X; const float* modl; int gate_off; const float* ls; int pm_mod;
    __device__ __forceinline__ void operator()(const f32x4 (&acc)[2][2][4][2], const Unit& u, int wr, int wc, int fr, int fq) const {
        const int pm = u.pm % pm_mod; const int bb = pm / 17, isctx = (pm % 17) == 0; const int v = isctx ? 2 : bb;
        const float* gate = modl + (size_t)v * NMOD + gate_off;
        const int row0 = pm * BM + wr * 64 + fr, col0 = u.pn * BM + wc * 32 + 4 * fq;
        f32x4 gv[2][2];
#pragma unroll
        for (int bj = 0; bj < 2; ++bj)
#pragma unroll
            for (int n = 0; n < 2; ++n) { gv[bj][n] = *(const f32x4*)(gate + col0 + bj * HALF + n * 16); if (ls) gv[bj][n] = gv[bj][n] * *(const f32x4*)(ls + col0 + bj * HALF + n * 16); }
#pragma unroll
        for (int ai = 0; ai < 2; ++ai)
#pragma unroll
            for (int m = 0; m < 4; ++m) { float* rowp = X + (size_t)(row0 + ai * HALF + m * 16) * DM + col0;
#pragma unroll
                for (int bj = 0; bj < 2; ++bj)
#pragma unroll
                    for (int n = 0; n < 2; ++n) { f32x4* p = (f32x4*)(rowp + bj * HALF + n * 16); *p = *p + acc[ai][bj][m][n] * gv[bj][n]; } }
    }
};

template <class Epi, class Sched>
__device__ __forceinline__ void gemm_phase(LAS unsigned char* lds, const Gemm g, const Sched& S, const Epi& E) {
    const int tid = opaque_tid(), wid = __builtin_amdgcn_readfirstlane(tid >> 6), lane = tid & 63, wr = wid >> 2, wc = wid & 3, fr = lane & 15, fq = lane >> 4;
    const int K = g.K, nt = K / BK;
    unsigned voffA[2], voffB[2];
#pragma unroll
    for (int i = 0; i < 2; ++i) { int R, C; stage_rc(tid * 16 + i * 8192, R, C); const int Rb = Epi::PERM ? ((R & ~31) + perm32(R & 31)) : R;
        voffA[i] = (unsigned)(R * K + C) * 2u; voffB[i] = (unsigned)(Rb * K + C) * 2u; }
    const size_t kstep = (size_t)(BK * 2);
    const size_t hstep = (size_t)HALF * K * 2;
    const size_t tstep = 2 * hstep;
    const unsigned ldsw = (unsigned)wid * 1024u;
    const int aoff = lds_byte(wr * 64 + fr, fq * 8), boff = lds_byte(wc * 32 + fr, fq * 8);
#define PG8_SA(b, h) (((b) * 2 + (h)) * HTB)
#define PG8_SB(b, h) ((4 + (b) * 2 + (h)) * HTB)
#define PG8_STAGE(bufoff, gbase, voff) do { _Pragma("unroll") for (int _i = 0; _i < 2; ++_i) \
        __builtin_amdgcn_global_load_lds((const unsigned*)((const char*)(gbase) + (voff)[_i]), (LAS unsigned*)(lds + (bufoff) + ldsw + _i * 8192), 16, 0, 0); } while (0)
#define PG8_LDA(dst, b, h) do { _Pragma("unroll") for (int m = 0; m < 4; ++m) _Pragma("unroll") for (int k = 0; k < 2; ++k) dst[m][k] = *(const LAS bf16x8*)(lds + PG8_SA(b, h) + aoff + m * 2048 + k * 1024); } while (0)
#define PG8_LDB(dst, b, h) do { _Pragma("unroll") for (int n = 0; n < 2; ++n) _Pragma("unroll") for (int k = 0; k < 2; ++k) dst[n][k] = *(const LAS bf16x8*)(lds + PG8_SB(b, h) + boff + n * 2048 + k * 1024); } while (0)
#define PG8_MMA(ai, bj, At, Bt) do { __builtin_amdgcn_s_setprio(1); _Pragma("unroll") for (int m = 0; m < 4; ++m) _Pragma("unroll") for (int n = 0; n < 2; ++n) _Pragma("unroll") for (int k = 0; k < 2; ++k) \
        acc[ai][bj][m][n] = __builtin_amdgcn_mfma_f32_16x16x32_bf16(Bt[n][k], At[m][k], acc[ai][bj][m][n], 0, 0, 0); __builtin_amdgcn_s_setprio(0); } while (0)
#define PG8_WAIT_V(n) asm volatile("s_waitcnt vmcnt(" #n ")" ::: "memory")
#define PG8_WAIT_L(n) asm volatile("s_waitcnt lgkmcnt(" #n ")" ::: "memory")
#define PG8_BAR __builtin_amdgcn_s_barrier()
#define PG8_SCHED __builtin_amdgcn_sched_barrier(0)
    Unit cur, nxt; int ui = 0;
    if (!S.next(0, cur)) return;
    f32x4 acc[2][2][4][2];
#pragma unroll
    for (int a = 0; a < 2; ++a)
#pragma unroll
        for (int b = 0; b < 2; ++b)
#pragma unroll
            for (int m = 0; m < 4; ++m)
#pragma unroll
                for (int n = 0; n < 2; ++n) acc[a][b][m][n] = (f32x4){0.f, 0.f, 0.f, 0.f};
    bf16x8 At[4][2], B0[2][2], B1[2][2];
    const char* cA = (const char*)g.A + (size_t)cur.pm * tstep; const char* cB = (const char*)g.Bt + (size_t)cur.pn * tstep;
    S.a_ready(cur);
    PG8_STAGE(PG8_SB(0, 0), cB, voffB); PG8_STAGE(PG8_SA(0, 0), cA, voffA); PG8_STAGE(PG8_SB(0, 1), cB + hstep, voffB); PG8_STAGE(PG8_SA(0, 1), cA + hstep, voffA);
    if (wr == 1) PG8_BAR;
    PG8_WAIT_V(4); PG8_BAR;
    PG8_STAGE(PG8_SB(1, 0), cB + kstep, voffB); PG8_STAGE(PG8_SA(1, 0), cA + kstep, voffA); PG8_STAGE(PG8_SB(1, 1), cB + hstep + kstep, voffB);
    PG8_WAIT_V(6); PG8_BAR;
    for (;;) {
        const bool has_next = S.next(ui + 1, nxt);
        const char* nA = has_next ? (const char*)g.A + (size_t)nxt.pm * tstep : cA; const char* nB = has_next ? (const char*)g.Bt + (size_t)nxt.pn * tstep : cB;
        for (int t = 0; t < nt; t += 2) {
            const bool last = (t == nt - 2);
            const char* a1 = cA + (size_t)(t + 1) * kstep;
            const char* a2 = last ? nA : cA + (size_t)(t + 2) * kstep; const char* b2 = last ? nB : cB + (size_t)(t + 2) * kstep;
            const char* a3 = a2 + kstep; const char* b3 = b2 + kstep;
            if (last && has_next) S.a_ready(nxt);
            PG8_LDB(B0, 0, 0); PG8_SCHED; PG8_LDA(At, 0, 0); PG8_STAGE(PG8_SA(1, 1), a1 + hstep, voffA);
            PG8_WAIT_L(8); PG8_BAR; PG8_WAIT_L(0); PG8_MMA(0, 0, At, B0); PG8_BAR; PG8_SCHED;
            PG8_LDB(B1, 0, 1); PG8_STAGE(PG8_SB(0, 0), b2, voffB);
            PG8_BAR; PG8_WAIT_L(0); PG8_MMA(0, 1, At, B1); PG8_BAR;
            PG8_LDA(At, 0, 1); PG8_STAGE(PG8_SA(0, 0), a2, voffA);
            PG8_BAR; PG8_WAIT_L(0); PG8_MMA(1, 0, At, B0); PG8_BAR; PG8_SCHED;
            PG8_STAGE(PG8_SB(0, 1), b2 + hstep, voffB);
            PG8_WAIT_V(6); PG8_BAR; PG8_MMA(1, 1, At, B1); PG8_BAR;
            PG8_LDB(B0, 1, 0); PG8_SCHED; PG8_LDA(At, 1, 0); PG8_STAGE(PG8_SA(0, 1), a2 + hstep, voffA);
            PG8_WAIT_L(8); PG8_BAR; PG8_WAIT_L(0); PG8_MMA(0, 0, At, B0); PG8_BAR; PG8_SCHED;
            PG8_LDB(B1, 1, 1); PG8_STAGE(PG8_SB(1, 0), b3, voffB);
            PG8_BAR; PG8_WAIT_L(0); PG8_MMA(0, 1, At, B1); PG8_BAR;
            PG8_LDA(At, 1, 1); PG8_STAGE(PG8_SA(1, 0), a3, voffA);
            PG8_BAR; PG8_WAIT_L(0); PG8_MMA(1, 0, At, B0); PG8_BAR; PG8_SCHED;
            PG8_STAGE(PG8_SB(1, 1), b3 + hstep, voffB);
            PG8_WAIT_V(6); PG8_BAR; PG8_MMA(1, 1, At, B1); PG8_BAR;
        }
        E(acc, cur, wr, wc, fr, fq); S.done(cur);
        if (!has_next) break;
#pragma unroll
        for (int a = 0; a < 2; ++a)
#pragma unroll
            for (int b = 0; b < 2; ++b)
#pragma unroll
                for (int m = 0; m < 4; ++m)
#pragma unroll
                    for (int n = 0; n < 2; ++n) acc[a][b][m][n] = (f32x4){0.f, 0.f, 0.f, 0.f};
        cur = nxt; cA = nA; cB = nB; ++ui;
    }
    PG8_WAIT_V(0);
    if (wr == 0) PG8_BAR;
    PG8_BAR;
#undef PG8_SA
#undef PG8_SB
#undef PG8_STAGE
#undef PG8_LDA
#undef PG8_LDB
#undef PG8_MMA
#undef PG8_WAIT_V
#undef PG8_WAIT_L
#undef PG8_BAR
#undef PG8_SCHED
}
}

namespace att {
constexpr int D = 128, NW = 8, QBLK = 32, KVBLK = 64;
constexpr float SCALE = 0.088388347648318440f;
constexpr float THR = 8.f;
constexpr size_t SHM_V = KVBLK * D * 2, SHM_K = KVBLK * D * 2, SHM_ATTN = 2 * SHM_V + 2 * SHM_K + NW * 64 * 4;
#define KSWZ(row, colB) ((row) * 256 + ((colB) ^ (((row) & 7) << 4)))
#define SBAR() __builtin_amdgcn_sched_barrier(0)
__device__ __forceinline__ int crow(int r, int hi) { return (r & 3) + 8 * (r >> 2) + 4 * hi; }

__device__ __forceinline__ void partialSM(f32x16& p0, f32x16& p1, float& m_reg, float& mn, float& alpha) {
  constexpr float C = SCALE * 1.4426950408889634f;
  float pmax = p0[0];
#pragma unroll
  for (int r = 1; r < 16; ++r) pmax = fmaxf(pmax, p0[r]);
#pragma unroll
  for (int r = 0; r < 16; ++r) pmax = fmaxf(pmax, p1[r]);
  { auto rr = __builtin_amdgcn_permlane32_swap(__float_as_uint(pmax), __float_as_uint(pmax), false, false);
    pmax = fmaxf(__uint_as_float(rr[0]), __uint_as_float(rr[1])); }
  if (__builtin_expect(__all(pmax - m_reg <= THR / SCALE), 1)) { mn = m_reg; alpha = 1.f; }
  else { mn = fmaxf(m_reg, pmax); alpha = __builtin_amdgcn_exp2f((m_reg - mn) * C); m_reg = mn; }
  float mnC = -mn * C;
#pragma unroll
  for (int r = 0; r < 16; ++r) p0[r] = fmaf(p0[r], C, mnC);
#pragma unroll
  for (int r = 0; r < 16; ++r) p1[r] = fmaf(p1[r], C, mnC);
#pragma unroll
  for (int r = 0; r < 16; ++r) p0[r] = __builtin_amdgcn_exp2f(p0[r]);
}
__device__ __forceinline__ void finishSM(f32x16& p0, f32x16& p1, float alpha, float& l_reg, bf16x8& pa0, bf16x8& pa1, bf16x8& pa2, bf16x8& pa3) {
#pragma unroll
  for (int r = 0; r < 16; ++r) p1[r] = __builtin_amdgcn_exp2f(p1[r]);
  float ps = 0;
#pragma unroll
  for (int r = 0; r < 16; ++r) ps += p0[r];
#pragma unroll
  for (int r = 0; r < 16; ++r) ps += p1[r];
  { auto rr = __builtin_amdgcn_permlane32_swap(__float_as_uint(ps), __float_as_uint(ps), false, false);
    ps = __uint_as_float(rr[0]) + __uint_as_float(rr[1]); }
  l_reg = l_reg * alpha + ps;
#define PK4(P, BASE, OUT) do { unsigned a0 = pk2(P[BASE + 0], P[BASE + 1]), a1 = pk2(P[BASE + 2], P[BASE + 3]);   \
    unsigned b0 = pk2(P[BASE + 4], P[BASE + 5]), b1 = pk2(P[BASE + 6], P[BASE + 7]);                              \
    auto r0 = __builtin_amdgcn_permlane32_swap(a0, b0, false, false); auto r1 = __builtin_amdgcn_permlane32_swap(a1, b1, false, false); \
    u32x4 w = {r0[0], r1[0], r0[1], r1[1]}; OUT = *reinterpret_cast<bf16x8*>(&w); } while (0)
  PK4(p0, 0, pa0); PK4(p0, 8, pa1); PK4(p1, 0, pa2); PK4(p1, 8, pa3);
#undef PK4
}
__device__ __forceinline__ void qkt(f32x16& p0, f32x16& p1, const bf16* Ks, const bf16x8* qr, int r32, int hi) {
  p0 = f32x16{}; p1 = f32x16{};
#pragma unroll
  for (int d0 = 0; d0 < 8; ++d0) { int cb = (d0 * 16 + hi * 8) * 2;
    bf16x8 b0 = *reinterpret_cast<const bf16x8*>((const char*)Ks + KSWZ(r32, cb));
    bf16x8 b1 = *reinterpret_cast<const bf16x8*>((const char*)Ks + KSWZ(32 + r32, cb));
    p0 = __builtin_amdgcn_mfma_f32_32x32x16_bf16(b0, qr[d0], p0, 0, 0, 0);
    p1 = __builtin_amdgcn_mfma_f32_32x32x16_bf16(b1, qr[d0], p1, 0, 0, 0); }
}
__device__ __forceinline__ int v_st(int k, int c) { const int kk = (k & ~0xC) | ((k & 4) << 1) | ((k & 8) >> 1); return ((kk >> 3) * 4 + (c >> 5)) * 512 + ((kk & 7) * 32 + (c & 31)) * 2; }
__device__ __forceinline__ int v_rd_base(int lane) { return ((lane & 3) << 3) | (((lane >> 2) & 3) << 6) | (((lane >> 4) & 1) << 5) | (((lane >> 5) & 1) << 8); }
constexpr int v_rd_off(int d0, int ks, int half) { return d0 * 512 + ks * 4096 + half * 2048; }
template <int OFF> __device__ __forceinline__ s16x4 tr_read(int vb) {
  s16x4 r; asm volatile("ds_read_b64_tr_b16 %0, %1 offset:%2" : "=&v"(r) : "v"(vb), "i"(OFF) : "memory"); return r;
}
template <int D0> __device__ __forceinline__ void pv_one(f32x16& od, int vb, bf16x8 pa0, bf16x8 pa1, bf16x8 pa2, bf16x8 pa3) {
  const s16x4 l0 = tr_read<v_rd_off(D0, 0, 0)>(vb), h0 = tr_read<v_rd_off(D0, 0, 1)>(vb), l1 = tr_read<v_rd_off(D0, 1, 0)>(vb), h1 = tr_read<v_rd_off(D0, 1, 1)>(vb);
  const s16x4 l2 = tr_read<v_rd_off(D0, 2, 0)>(vb), h2 = tr_read<v_rd_off(D0, 2, 1)>(vb), l3 = tr_read<v_rd_off(D0, 3, 0)>(vb), h3 = tr_read<v_rd_off(D0, 3, 1)>(vb);
  asm volatile("s_waitcnt lgkmcnt(0)" ::: "memory"); SBAR();
#define PK(L, H) (bf16x8){L[0], L[1], L[2], L[3], H[0], H[1], H[2], H[3]}
  od = __builtin_amdgcn_mfma_f32_32x32x16_bf16(pa0, PK(l0, h0), od, 0, 0, 0);
  od = __builtin_amdgcn_mfma_f32_32x32x16_bf16(pa1, PK(l1, h1), od, 0, 0, 0);
  od = __builtin_amdgcn_mfma_f32_32x32x16_bf16(pa2, PK(l2, h2), od, 0, 0, 0);
  od = __builtin_amdgcn_mfma_f32_32x32x16_bf16(pa3, PK(l3, h3), od, 0, 0, 0);
#undef PK
}
__device__ __forceinline__ void pv_d0(f32x16* o, int vb, bf16x8 pa0, bf16x8 pa1, bf16x8 pa2, bf16x8 pa3) {
  pv_one<0>(o[0], vb, pa0, pa1, pa2, pa3); pv_one<1>(o[1], vb, pa0, pa1, pa2, pa3); pv_one<2>(o[2], vb, pa0, pa1, pa2, pa3); pv_one<3>(o[3], vb, pa0, pa1, pa2, pa3);
}

template <int LD>
__device__ __forceinline__ void attn_body(const bf16* __restrict__ Qb, const bf16* __restrict__ Kh, const bf16* __restrict__ Vh, bf16* __restrict__ Ob,
                                          int NT, char* lds) {
  const int tid = opaque_tid(), wid = tid >> 6, lane = tid & 63, r32 = lane & 31, hi = lane >> 5;
  bf16* V_lds = (bf16*)lds; bf16* K_lds = (bf16*)(lds + 2 * SHM_V);
  float* ws = (float*)(lds + 2 * SHM_V + 2 * SHM_K) + wid * 64; float* li_l = ws; float* al_l = ws + 32;
  float m_reg = -1e30f, l_reg = 0; f32x16 o[4] = {}; bf16x8 qr[8];
  const bf16* Qw = Qb + (long)(wid * QBLK + r32) * LD + hi * 8;
#pragma unroll
  for (int d0 = 0; d0 < 8; ++d0) qr[d0] = *reinterpret_cast<const bf16x8*>(Qw + d0 * 16);
  const int sr = tid >> 4, sc = (tid & 15) * 8, vst0 = v_st(sr, sc), vst1 = v_st(32 + sr, sc);
  const int vb0 = (int)(uintptr_t)V_lds + v_rd_base(lane);
  struct { bf16x8 vs0, vs1, ks0, ks1; } sr_[2];
#define TROW(j) (64 * (j))
#define SLOAD(i, k0) do { const long _k = (k0); sr_[i].vs0 = *reinterpret_cast<const bf16x8*>(&Vh[(_k + sr) * LD + sc]); sr_[i].vs1 = *reinterpret_cast<const bf16x8*>(&Vh[(_k + 32 + sr) * LD + sc]); \
    sr_[i].ks0 = *reinterpret_cast<const bf16x8*>(&Kh[(_k + sr) * LD + sc]); sr_[i].ks1 = *reinterpret_cast<const bf16x8*>(&Kh[(_k + 32 + sr) * LD + sc]); } while (0)
#define SWRITE(b, i) do { *(bf16x8*)((char*)V_lds + (b) * SHM_V + vst0) = sr_[i].vs0;          \
    *(bf16x8*)((char*)V_lds + (b) * SHM_V + vst1) = sr_[i].vs1; int kc = sc * 2;               \
    *(bf16x8*)((char*)K_lds + (b) * SHM_K + KSWZ(sr, kc)) = sr_[i].ks0;                       \
    *(bf16x8*)((char*)K_lds + (b) * SHM_K + KSWZ(32 + sr, kc)) = sr_[i].ks1; } while (0)
#define SWAIT() asm volatile("s_waitcnt vmcnt(4)" ::: "memory")
#define RESC(a) do { if (__any((a) < 1.f)) { if (hi == 0) al_l[r32] = (a); asm volatile("s_waitcnt lgkmcnt(0)" ::: "memory"); \
    _Pragma("unroll") for (int d = 0; d < 4; ++d) _Pragma("unroll") for (int r = 0; r < 16; ++r) o[d][r] *= al_l[crow(r, hi)]; } } while (0)
  f32x16 pA0, pA1, pB0, pB1; float mnA, mnB, alA, alB; bf16x8 pa0, pa1, pa2, pa3;
  constexpr int SE = 0, SO = 1;
  SLOAD(SE, TROW(0)); asm volatile("s_waitcnt vmcnt(0)" ::: "memory"); SWRITE(0, SE); __syncthreads();
  qkt(pA0, pA1, K_lds, qr, r32, hi); partialSM(pA0, pA1, m_reg, mnA, alA);
  SLOAD(SO, TROW(1)); if (2 < NT) SLOAD(SE, TROW(2));
  SWAIT(); SWRITE(1, SO); __syncthreads();
  for (int j = 1; j + 1 < NT; j += 2) {
    SBAR(); qkt(pB0, pB1, (bf16*)((char*)K_lds + SHM_K), qr, r32, hi);
    finishSM(pA0, pA1, alA, l_reg, pa0, pa1, pa2, pa3); SBAR();
    SLOAD(SO, TROW(j + 2)); SBAR();
    pv_d0(o, vb0, pa0, pa1, pa2, pa3); partialSM(pB0, pB1, m_reg, mnB, alB);
    __syncthreads(); SWAIT(); SWRITE(0, SE);
    RESC(alB); __syncthreads();
    SBAR(); qkt(pA0, pA1, K_lds, qr, r32, hi);
    finishSM(pB0, pB1, alB, l_reg, pa0, pa1, pa2, pa3); SBAR();
    if (j + 3 < NT) SLOAD(SE, TROW(j + 3)); SBAR();
    pv_d0(o, vb0 + (int)SHM_V, pa0, pa1, pa2, pa3); partialSM(pA0, pA1, m_reg, mnA, alA);
    __syncthreads(); SWAIT(); SWRITE(1, SO);
    RESC(alA); __syncthreads();
  }
  SBAR(); qkt(pB0, pB1, (bf16*)((char*)K_lds + SHM_K), qr, r32, hi);
  finishSM(pA0, pA1, alA, l_reg, pa0, pa1, pa2, pa3); SBAR();
  pv_d0(o, vb0, pa0, pa1, pa2, pa3); partialSM(pB0, pB1, m_reg, mnB, alB);
  __syncthreads(); RESC(alB);
  finishSM(pB0, pB1, alB, l_reg, pa0, pa1, pa2, pa3); SBAR();
  pv_d0(o, vb0 + (int)SHM_V, pa0, pa1, pa2, pa3);
  if (hi == 0) li_l[r32] = l_reg; asm volatile("s_waitcnt lgkmcnt(0)" ::: "memory");
  float rli[16];
#pragma unroll
  for (int r = 0; r < 16; ++r) rli[r] = __builtin_amdgcn_rcpf(li_l[crow(r, hi)]);
  bf16* Ow = Ob + (long)(wid * QBLK) * DM;
#pragma unroll
  for (int r = 0; r < 16; ++r) { const int orow = crow(r, hi);
#pragma unroll
    for (int d0 = 0; d0 < 4; ++d0) Ow[(long)orow * DM + d0 * 32 + r32] = (bf16)f2bf(o[d0][r] * rli[r]); }
  __syncthreads();
#undef TROW
#undef SLOAD
#undef SWRITE
#undef SWAIT
#undef RESC
}
__device__ __forceinline__ void attn_na_body(const bf16* __restrict__ Qb, const bf16* __restrict__ Kh, const bf16* __restrict__ Vh, bf16* __restrict__ Ob,
                                             const int kr_lo, const int qrow0, const float* bl, const int NT, char* lds) {
  constexpr int LD = 6144;
  const int tid = opaque_tid(), wid = tid >> 6, lane = tid & 63, r32 = lane & 31, hi = lane >> 5;
  bf16* V_lds = (bf16*)lds; bf16* K_lds = (bf16*)(lds + 2 * SHM_V);
  float* ws = (float*)(lds + 2 * SHM_V + 2 * SHM_K) + wid * 64; float* li_l = ws; float* al_l = ws + 32;
  float m_reg = -1e30f, l_reg = 0; f32x16 o[4] = {}; bf16x8 qr[8];
  const bf16* Qw = Qb + (long)(wid * QBLK + r32) * LD + hi * 8;
#pragma unroll
  for (int d0 = 0; d0 < 8; ++d0) qr[d0] = *reinterpret_cast<const bf16x8*>(Qw + d0 * 16);
  const int sr = tid >> 4, sc = (tid & 15) * 8, vst0 = v_st(sr, sc), vst1 = v_st(32 + sr, sc);
  const int vb0 = (int)(uintptr_t)V_lds + v_rd_base(lane);
  const int widu = __builtin_amdgcn_readfirstlane(wid);
  const int qrow = qrow0 + (widu >> 1), qcol = (wid & 1) * 32 + r32;
  int r0 = qrow - 4; r0 = r0 < 0 ? 0 : (r0 > 56 ? 56 : r0);
  int c0 = qcol - 8; c0 = c0 < 0 ? 0 : (c0 > 48 ? 48 : c0);
  bf16x8 vs0, vs1, ks0, ks1;
#define NA_TROW(j) ((j) < 4 ? 64 * (j) : 256 + 64 * (kr_lo + (j) - 4))
#define NA_SLOAD(k0) do { const long _k = (k0); vs0 = *reinterpret_cast<const bf16x8*>(&Vh[(_k + sr) * LD + sc]); vs1 = *reinterpret_cast<const bf16x8*>(&Vh[(_k + 32 + sr) * LD + sc]); \
    ks0 = *reinterpret_cast<const bf16x8*>(&Kh[(_k + sr) * LD + sc]); ks1 = *reinterpret_cast<const bf16x8*>(&Kh[(_k + 32 + sr) * LD + sc]); } while (0)
  NA_SLOAD(NA_TROW(0));
  for (int j = 0; j < NT; ++j) {
    __syncthreads();
    *(bf16x8*)((char*)V_lds + vst0) = vs0; *(bf16x8*)((char*)V_lds + vst1) = vs1;
    *(bf16x8*)((char*)K_lds + KSWZ(sr, sc * 2)) = ks0; *(bf16x8*)((char*)K_lds + KSWZ(32 + sr, sc * 2)) = ks1;
    if (j + 1 < NT) NA_SLOAD(NA_TROW(j + 1));
    __syncthreads();
    const int kr = kr_lo + j - 4;
    const bool rowok = (j < 4) || ((unsigned)(kr - r0) < 8u);
    if (rowok) {
      f32x16 p0, p1; float mn, al; bf16x8 pa0, pa1, pa2, pa3;
      qkt(p0, p1, K_lds, qr, r32, hi);
      if (j >= 4) {
        const int bbase = (kr - qrow + 7) * 31 + 15 - qcol;
#pragma unroll
        for (int r = 0; r < 16; ++r) {
          const int kc0 = crow(r, hi), kc1 = 32 + kc0;
          const bool ok0 = (unsigned)(kc0 - c0) < 16u, ok1 = (unsigned)(kc1 - c0) < 16u;
          const float b0 = ok0 ? bl[bbase + kc0] : 0.f, b1 = ok1 ? bl[bbase + kc1] : 0.f;
          p0[r] = ok0 ? p0[r] + b0 : -1e30f; p1[r] = ok1 ? p1[r] + b1 : -1e30f;
        }
      }
      partialSM(p0, p1, m_reg, mn, al);
      if (__any(al < 1.f)) { if (hi == 0) al_l[r32] = al; asm volatile("s_waitcnt lgkmcnt(0)" ::: "memory");
#pragma unroll
        for (int d = 0; d < 4; ++d)
#pragma unroll
          for (int r = 0; r < 16; ++r) o[d][r] *= al_l[crow(r, hi)]; }
      finishSM(p0, p1, al, l_reg, pa0, pa1, pa2, pa3); SBAR();
      pv_d0(o, vb0, pa0, pa1, pa2, pa3);
    }
  }
  if (hi == 0) li_l[r32] = l_reg; asm volatile("s_waitcnt lgkmcnt(0)" ::: "memory");
  float rli[16];
#pragma unroll
  for (int r = 0; r < 16; ++r) rli[r] = __builtin_amdgcn_rcpf(li_l[crow(r, hi)]);
  bf16* Ow = Ob + (long)(wid * QBLK) * DM;
#pragma unroll
  for (int r = 0; r < 16; ++r) { const int orow = crow(r, hi);
#pragma unroll
    for (int d0 = 0; d0 < 4; ++d0) Ow[(long)orow * DM + d0 * 32 + r32] = (bf16)f2bf(o[d0][r] * rli[r]); }
  __syncthreads();
#undef NA_TROW
#undef NA_SLOAD
}
}


constexpr size_t MiB = 1u << 20;
constexpr size_t WS_CTL = 0, CTL_ZERO_BYTES = 1 * MiB;
constexpr size_t WS_MODV = 1 * MiB;
constexpr size_t WS_MODP = 2 * MiB;
constexpr size_t WS_X    = 22 * MiB;
constexpr size_t WS_H    = 92 * MiB;
constexpr size_t WS_QKV  = 128 * MiB;
constexpr size_t WS_O    = 232 * MiB;
constexpr size_t WS_PQ   = 268 * MiB;
constexpr size_t WS_IDX  = 304 * MiB;
constexpr size_t WS_GATE = 310 * MiB;
constexpr size_t WS_AWQKV = 316 * MiB;
constexpr size_t WS_AWO   = 340 * MiB;
constexpr size_t WS_BWQKV = 356 * MiB;
constexpr size_t WS_BWO   = 380 * MiB;
constexpr size_t WS_PW    = 388 * MiB;
constexpr size_t WS_PWQ   = 390 * MiB;
constexpr size_t WS_SK    = 422 * MiB;
constexpr size_t WS_U     = 424 * MiB;
constexpr size_t WS_V     = 680 * MiB;
constexpr size_t WS_END   = 936 * MiB;

constexpr int LDS_BYTES = 147456;
constexpr int MISC_OFF = 131072 + 320;
constexpr int NPHASE = 2 + 4 * 9 + 1;

struct Args {
    const float *x, *c, *ctx, *c_ctx, *mod_w, *mod_b, *norm_w, *final_norm_w, *a_wqkv, *a_q_gain, *a_k_gain, *a_wo, *b_wqkv, *b_rpb, *b_wo, *pool_w, *pool_scale,
                *peer_wq, *peer_sub_keys, *peer_u, *peer_v;
    float* out; unsigned char* ws; int ph_lo, ph_hi;
};

__device__ __forceinline__ void p0_transpose_item(const float* W, int K, int N, bf16* WT, LAS float* scr, int item, int lane) {
    const int nblk = N / 32, kb = item / nblk, nb = item % nblk, k0 = 64 * kb, n0 = 32 * nb;
#pragma unroll 8
    for (int i = 0; i < 32; ++i) { const int kk = 2 * i + (lane >> 5); scr[kk * 33 + (lane & 31)] = W[(size_t)(k0 + kk) * N + n0 + (lane & 31)]; }
    asm volatile("s_waitcnt lgkmcnt(0)" ::: "memory");
    const int c = lane & 7;
#pragma unroll
    for (int j = 0; j < 4; ++j) { const int n = (lane >> 3) + 8 * j; const LAS float* s = scr + (8 * c) * 33 + n;
        u32x4 o; o.x = pk2(s[0 * 33], s[1 * 33]); o.y = pk2(s[2 * 33], s[3 * 33]); o.z = pk2(s[4 * 33], s[5 * 33]); o.w = pk2(s[6 * 33], s[7 * 33]);
        *(u32x4*)(WT + (size_t)(n0 + n) * K + k0 + 8 * c) = o; }
    asm volatile("s_waitcnt lgkmcnt(0)" ::: "memory");
}

__device__ __forceinline__ void norm_mod_row(const float* xrow, const float* w, const float* shift, const float* scale, bf16* orow, int lane) {
    const f32x4* xr = (const f32x4*)xrow + lane;
    f32x4 v[8]; float ss = 0.f;
#pragma unroll
    for (int j = 0; j < 8; ++j) { v[j] = xr[64 * j]; ss += (v[j].x * v[j].x + v[j].y * v[j].y) + (v[j].z * v[j].z + v[j].w * v[j].w); }
    const float rstd = 1.f / sqrtf(wave_sum(ss) * (1.f / DM) + EPS);
    u32x2* o8 = (u32x2*)orow + lane;
#pragma unroll
    for (int j = 0; j < 8; ++j) { const int c = (lane + 64 * j) * 4;
        const f32x4 wv = *(const f32x4*)(w + c), sh = *(const f32x4*)(shift + c), sc = *(const f32x4*)(scale + c);
        const f32x4 h = (v[j] * rstd * wv) * (sc + 1.f) + sh;
        u32x2 pk; pk.x = pk2(h.x, h.y); pk.y = pk2(h.z, h.w); o8[64 * j] = pk; }
}

__device__ __forceinline__ float gelu_tanh(float x) {
    const float z = 0.7978845608028654f * (x + 0.044715f * x * x * x);
    const float e = __expf(2.f * z);
    const float t = 1.f - 2.f / (1.f + e);
    return 0.5f * x * (1.f + t);
}

__device__ __forceinline__ unsigned mono(float f) { const unsigned u = __float_as_uint(f); return u ^ ((unsigned)((int)u >> 31) | 0x80000000u); }
__device__ __forceinline__ float unmono(unsigned m) { const unsigned u = (m & 0x80000000u) ? (m ^ 0x80000000u) : ~m; return __uint_as_float(u); }
#define INS16(L, x) do { unsigned _x = (x); _Pragma("unroll") for (int _j = 0; _j < 16; ++_j) { const unsigned _t = L[_j] > _x ? L[_j] : _x; _x = L[_j] > _x ? _x : L[_j]; L[_j] = _t; } } while (0)

__global__ void __launch_bounds__(512, 2) fwd_kernel(Args a) {
    extern __shared__ __attribute__((aligned(16))) unsigned char lds[];
    LAS unsigned char* L3 = (LAS unsigned char*)lds;
    volatile LAS unsigned* MISC = (volatile LAS unsigned*)(L3 + MISC_OFF);
    const int G = gridDim.x; const int bx = blockIdx.x; const int vcu = (G % 8 == 0) ? (bx % 8) * (G / 8) + bx / 8 : bx;
    const int NGW = G * 8;
    if (threadIdx.x < 32) MISC[threadIdx.x] = 0u;
    __syncthreads();
    XcdBarrier bar; bar.bar = (unsigned*)(a.ws + WS_CTL) + 4096; bar.x = 0; bar.st = nullptr;
#if ONE_LAUNCH
    bar = xcd_barrier_post((unsigned*)(a.ws + WS_CTL) + 4096, MISC + 8);
#endif
    const int lo = a.ph_lo, hi_ph = a.ph_hi;
#define IN(k) (lo <= (k) && (k) < hi_ph)
#if ONE_LAUNCH
#define SEAM(k) do { if (IN(k) && IN((k) + 1)) xcd_barrier(bar); } while (0)
#else
#define SEAM(k) do { } while (0)
#endif
#define WS_LAUNDER() unsigned char* wsl = a.ws; asm volatile("" : "+s"(wsl)); const int tid = opaque_tid(), lane = tid & 63, wave = __builtin_amdgcn_readfirstlane(tid >> 6), gw = vcu * 8 + wave; (void)lane; (void)gw
#define modv  ((float*)(wsl + WS_MODV))
#define modp  ((float*)(wsl + WS_MODP))
#define X     ((float*)(wsl + WS_X))
#define H     ((bf16*)(wsl + WS_H))
#define QKV   ((bf16*)(wsl + WS_QKV))
#define OB    ((bf16*)(wsl + WS_O))
#define PQ    ((bf16*)(wsl + WS_PQ))
#define IDX   ((int*)(wsl + WS_IDX))
#define GATE  ((float*)(wsl + WS_GATE))
#define AWQKV ((bf16*)(wsl + WS_AWQKV))
#define AWO   ((bf16*)(wsl + WS_AWO))
#define BWQKV ((bf16*)(wsl + WS_BWQKV))
#define BWO   ((bf16*)(wsl + WS_BWO))
#define PW    ((bf16*)(wsl + WS_PW))
#define PWQ   ((bf16*)(wsl + WS_PWQ))
#define SK    ((bf16*)(wsl + WS_SK))
#define UB    ((bf16*)(wsl + WS_U))
#define VB    ((bf16*)(wsl + WS_V))
    if (PHM(0) && IN(0)) { WS_LAUNDER();
        float* sm = (float*)lds;
        for (int it = bx; it < 4 * 6 * 32; it += G) {
            const int Lr = it / 192, r = it % 192, cc = r / 32, kc = r % 32;
            __syncthreads();
            if (tid < 192) { const int v = tid >> 6, k = kc * 64 + (tid & 63); const float cv = (v < 2) ? a.c[v * DM + k] : a.c_ctx[k]; sm[tid] = cv / (1.f + __expf(-cv)); }
            __syncthreads();
            const float* W = a.mod_w + ((size_t)Lr * DM + kc * 64) * NMOD + cc * 2048 + tid * 4;
            f32x4 a0 = {0.f, 0.f, 0.f, 0.f}, a1 = a0, a2 = a0;
#pragma unroll 8
            for (int k = 0; k < 64; ++k) { const f32x4 w = *(const f32x4*)(W + (size_t)k * NMOD); a0 += w * sm[k]; a1 += w * sm[64 + k]; a2 += w * sm[128 + k]; }
            float* P = modp + (((size_t)Lr * 32 + kc) * 3) * NMOD + cc * 2048 + tid * 4;
            *(f32x4*)P = a0; *(f32x4*)(P + NMOD) = a1; *(f32x4*)(P + 2 * NMOD) = a2;
        }
        __syncthreads();
        {
            LAS float* scr = (LAS float*)(L3 + wave * 16384);
            constexpr int I_AQ = 32 * 96, I_AO = 32 * 64, I_BQ = 32 * 192, I_BO = 32 * 64, I_PW = 8 * 16, I_WQ = 32 * 64;
            constexpr int NIT = 2 * I_AQ + 2 * I_AO + I_BQ + I_BO + 4 * I_PW + 4 * I_WQ;
            for (int it = gw; it < NIT; it += NGW) {
                int r = it;
                if (r < 2 * I_AQ) { const int j = r / I_AQ; p0_transpose_item(a.a_wqkv + (size_t)j * DM * 3072, DM, 3072, AWQKV + (size_t)j * 3072 * DM, scr, r % I_AQ, lane); continue; } r -= 2 * I_AQ;
                if (r < 2 * I_AO) { const int j = r / I_AO; p0_transpose_item(a.a_wo + (size_t)j * DM * DM, DM, DM, AWO + (size_t)j * DM * DM, scr, r % I_AO, lane); continue; } r -= 2 * I_AO;
                if (r < I_BQ) { p0_transpose_item(a.b_wqkv, DM, 6144, BWQKV, scr, r, lane); continue; } r -= I_BQ;
                if (r < I_BO) { p0_transpose_item(a.b_wo, DM, DM, BWO, scr, r, lane); continue; } r -= I_BO;
                if (r < 4 * I_PW) { const int j = r / I_PW; p0_transpose_item(a.pool_w + (size_t)j * 512 * 512, 512, 512, PW + (size_t)j * 512 * 512, scr, r % I_PW, lane); continue; } r -= 4 * I_PW;
                { const int j = r / I_WQ; p0_transpose_item(a.peer_wq + (size_t)j * DM * DM, DM, DM, PWQ + (size_t)j * DM * DM, scr, r % I_WQ, lane); }
            }
        }
        {
            const size_t n8 = (size_t)4 * NEXP * DM / 8, gt = (size_t)bx * 512 + tid, nth = (size_t)G * 512;
            for (size_t i = gt; i < 2 * n8; i += nth) {
                const bool isu = i < n8; const size_t j = isu ? i : i - n8;
                const f32x4* s = (const f32x4*)((isu ? a.peer_u : a.peer_v) + j * 8);
                const f32x4 x0 = __builtin_nontemporal_load(s), x1 = __builtin_nontemporal_load(s + 1);
                u32x4 o; o.x = pk2(x0.x, x0.y); o.y = pk2(x0.z, x0.w); o.z = pk2(x1.x, x1.y); o.w = pk2(x1.z, x1.w);
                *(u32x4*)((isu ? UB : VB) + j * 8) = o;
            }
            const size_t nk8 = (size_t)4 * 2 * 128 * 128 / 8;
            for (size_t i = gt; i < nk8; i += nth) {
                const f32x4* s = (const f32x4*)(a.peer_sub_keys + i * 8); const f32x4 x0 = s[0], x1 = s[1];
                u32x4 o; o.x = pk2(x0.x, x0.y); o.y = pk2(x0.z, x0.w); o.z = pk2(x1.x, x1.y); o.w = pk2(x1.z, x1.w);
                *(u32x4*)(SK + i * 8) = o;
            }
        }
        for (int row = gw; row < MR; row += NGW) {
            const int b = row / RPB, r = row % RPB;
            const f32x4* src = (const f32x4*)(r < CTX ? a.ctx + ((size_t)b * CTX + r) * DM : a.x + ((size_t)b * SEQ + (r - CTX)) * DM) + lane;
            f32x4* dst = (f32x4*)(X + (size_t)row * DM) + lane;
#pragma unroll
            for (int j = 0; j < 8; ++j) dst[64 * j] = src[64 * j];
        }
    }
    SEAM(0);
    if (PHM(1) && IN(1)) { WS_LAUNDER();
        for (int i = bx * 512 + tid; i < 4 * 3 * NMOD; i += G * 512) {
            const int Lr = i / (3 * NMOD), r = i % (3 * NMOD), n = r % NMOD;
            float s = a.mod_b[Lr * NMOD + n];
            for (int kc = 0; kc < 32; ++kc) s += modp[((size_t)Lr * 32 + kc) * 3 * NMOD + r];
            modv[i] = s;
        }
    }
    SEAM(1);

    for (int Lr = 0; Lr < 4; ++Lr) {
        const int kind = Lr % 3, jj = Lr / 3, pb = 2 + Lr * 9;
#define modl (modv + (size_t)Lr * 3 * NMOD)
        if (MIXON(Lr) && PHM(2) && IN(pb + 0)) { WS_LAUNDER();
            const float* w = a.norm_w + (size_t)(Lr * 2 + 0) * DM;
            for (int row = gw; row < MR; row += NGW) { const int b = row / RPB, r = row % RPB, v = r < CTX ? 2 : b; const float* mv = modl + (size_t)v * NMOD;
                norm_mod_row(X + (size_t)row * DM, w, mv + 0 * DM, mv + 1 * DM, H + (size_t)row * DM, lane); }
        }
        SEAM(pb + 0);
        if (MIXON(Lr) && PHM(3) && IN(pb + 1)) { WS_LAUNDER();
            if (kind != 2) { const int N = kind == 0 ? 3072 : 6144; pg8::Gemm g{H, kind == 0 ? AWQKV + (size_t)jj * 3072 * DM : BWQKV, MR, N, DM};
                pg8::FlexOrder S; S.init(MR, N, G, bx, 0); pg8::EpiBf16 E{QKV, N};
                pg8::gemm_phase<pg8::EpiBf16, pg8::FlexOrder>(L3, g, S, E); }
            else {
                for (int row = gw; row < MR; row += NGW) {
                    const int r = row % RPB; const int isl = r >= CTX; const int t = isl ? r - CTX : r, Ls = isl ? SEQ : CTX; const int row0 = row - t;
#pragma unroll
                    for (int g = 0; g < 4; ++g) {
                        const int w = 2 << g; int lo_ = t - w / 2; lo_ = lo_ < 0 ? 0 : lo_; int hi_ = t + w - w / 2; hi_ = hi_ > Ls ? Ls : hi_;
                        float s[8] = {0.f, 0.f, 0.f, 0.f, 0.f, 0.f, 0.f, 0.f};
                        for (int q = lo_; q < hi_; ++q) { const u32x4 hv = *(const u32x4*)(H + (size_t)(row0 + q) * DM + g * 512 + lane * 8);
                            s[0] += bflo(hv.x); s[1] += bfhi(hv.x); s[2] += bflo(hv.y); s[3] += bfhi(hv.y); s[4] += bflo(hv.z); s[5] += bfhi(hv.z); s[6] += bflo(hv.w); s[7] += bfhi(hv.w); }
                        const u32x4 hs = *(const u32x4*)(H + (size_t)row * DM + g * 512 + lane * 8); const float ic = 1.f / (float)(hi_ - lo_);
                        u32x4 o; o.x = pk2(s[0] * ic - bflo(hs.x), s[1] * ic - bfhi(hs.x)); o.y = pk2(s[2] * ic - bflo(hs.y), s[3] * ic - bfhi(hs.y));
                        o.z = pk2(s[4] * ic - bflo(hs.z), s[5] * ic - bfhi(hs.z)); o.w = pk2(s[6] * ic - bflo(hs.w), s[7] * ic - bfhi(hs.w));
                        *(u32x4*)(OB + ((size_t)g * MR + row) * 512 + lane * 8) = o;
                    }
                }
            }
        }
        SEAM(pb + 1);
        if (MIXON(Lr) && PHM(4) && IN(pb + 2) && kind == 0) { WS_LAUNDER();
            const float* qg = a.a_q_gain + jj * 128; const float* kg = a.a_k_gain + jj * 128;
            const int i = lane & 31, base = (lane >> 5) * 64;
            const float inv = exp2f(-(float)(2 * i) * (1.f / 64.f) * 13.287712379549449f);
            const float g1q = qg[base + i], g2q = qg[base + i + 32], g1k = kg[base + i], g2k = kg[base + i + 32];
            for (int row = gw; row < MR; row += NGW) {
                const int r = row % RPB; const bool isl = r >= CTX; const int t = r - CTX;
                float cs = 1.f, sn = 0.f;
                if (isl) { const float pos = (float)((lane < 32) ? (t >> 6) : (t & 63)); const float ang = pos * inv; cs = cosf(ang); sn = sinf(ang); }
                bf16* p = QKV + (size_t)row * 3072;
                for (int s = 0; s < 20; ++s) {
                    bf16* ph = p + s * 128 + base + i;
                    const float x1 = bf2f(ph[0]), x2 = bf2f(ph[32]);
                    const float rstd = 1.f / sqrtf(wave_sum(x1 * x1 + x2 * x2) * (1.f / 128.f) + EPS);
                    const float y1 = x1 * rstd * (s < 16 ? g1q : g1k), y2 = x2 * rstd * (s < 16 ? g2q : g2k);
                    ph[0] = (bf16)f2bf(y1 * cs - y2 * sn); ph[32] = (bf16)f2bf(y2 * cs + y1 * sn);
                }
            }
        }
        if (kind == 0) SEAM(pb + 2);
        if (MIXON(Lr) && PHM(5) && IN(pb + 3) && kind == 0) { WS_LAUNDER();
            for (int it = vcu; it < 512 + 32; it += G) {
                const bool isl = it < 512; const int q = isl ? it : it - 512;
                const int qb = isl ? (q & 15) : 0, h = isl ? ((q >> 4) & 15) : (q & 15), b = isl ? (q >> 8) : (q >> 4), kvh = h >> 2;
                const bf16* base = QKV + (size_t)b * RPB * 3072; const int qrow0 = isl ? CTX + qb * 256 : 0;
                att::attn_body<3072>(base + (size_t)qrow0 * 3072 + h * 128, base + 2048 + kvh * 128, base + 2560 + kvh * 128, OB + ((size_t)b * RPB + qrow0) * DM + h * 128, isl ? 68 : 4, (char*)lds);
            }
        }
        if (MIXON(Lr) && PHM(12) && IN(pb + 3) && kind == 1) { WS_LAUNDER();
            float* bl = (float*)((char*)lds + att::SHM_ATTN);
            for (int it = vcu; it < 512 + 32; it += G) {
                const bool isl = it < 512; const int q = isl ? it : it - 512;
                const int qb = isl ? (q & 15) : 0, h = isl ? ((q >> 4) & 15) : (q & 15), b = isl ? (q >> 8) : (q >> 4);
                int kr_lo = qb * 4 - 4; kr_lo = kr_lo < 0 ? 0 : (kr_lo > 52 ? 52 : kr_lo);
                { const float* rp = a.b_rpb + (size_t)h * 465; for (int z = tid; z < 465; z += 512) bl[z] = rp[z] * (1.f / att::SCALE); __syncthreads(); }
                const bf16* base = QKV + (size_t)b * RPB * 6144; const int qrow0 = isl ? CTX + qb * 256 : 0;
                att::attn_na_body(base + (size_t)qrow0 * 6144 + h * 128, base + 2048 + h * 128, base + 4096 + h * 128, OB + ((size_t)b * RPB + qrow0) * DM + h * 128, kr_lo, qb * 4, bl, isl ? 16 : 4, (char*)lds);
            }
        }
        if (kind != 2) SEAM(pb + 3);
        if (MIXON(Lr) && PHM(6) && IN(pb + 4)) { WS_LAUNDER();
            const bool grp = kind == 2;
            pg8::Gemm g{OB, grp ? PW : (kind == 0 ? AWO + (size_t)jj * DM * DM : BWO), grp ? 4 * MR : MR, DM, grp ? 512 : DM};
            pg8::FlexOrder S; S.init(MR, DM, G, bx, grp ? 1 : 0); pg8::EpiResid E{X, modl, 2 * DM, grp ? a.pool_scale : nullptr, grp ? 34 : (1 << 20)};
            pg8::gemm_phase<pg8::EpiResid, pg8::FlexOrder>(L3, g, S, E);
        }
        SEAM(pb + 4);
        if (PEERON(Lr) && PHM(7) && IN(pb + 5)) { WS_LAUNDER();
            const float* w = a.norm_w + (size_t)(Lr * 2 + 1) * DM;
            for (int row = gw; row < MR; row += NGW) { const int b = row / RPB, r = row % RPB, v = r < CTX ? 2 : b; const float* mv = modl + (size_t)v * NMOD;
                norm_mod_row(X + (size_t)row * DM, w, mv + 3 * DM, mv + 4 * DM, H + (size_t)row * DM, lane); }
        }
        SEAM(pb + 5);
        if (PEERON(Lr) && PHM(8) && IN(pb + 6)) { WS_LAUNDER();
#if NAIVE_PQ
            { const float* wq = a.peer_wq + (size_t)Lr * DM * DM;
              for (size_t o = (size_t)bx * 512 + tid; o < (size_t)MR * DM; o += (size_t)G * 512) { const int row = (int)(o / DM), n = (int)(o % DM); float s = 0.f;
                  for (int k = 0; k < DM; ++k) s += bf2f(H[(size_t)row * DM + k]) * wq[(size_t)k * DM + n];
                  PQ[o] = (bf16)f2bf(s); } }
#else
            pg8::Gemm g{H, PWQ + (size_t)Lr * DM * DM, MR, DM, DM}; pg8::FlexOrder S; S.init(MR, DM, G, bx, 0); pg8::EpiBf16 E{PQ, DM};
            pg8::gemm_phase<pg8::EpiBf16, pg8::FlexOrder>(L3, g, S, E);
#endif
        }
        SEAM(pb + 6);

#if NAIVE_ROUTE
        if (PEERON(Lr) && PHM(9) && IN(pb + 7)) { WS_LAUNDER();
            for (int task = gw; task < MR * 8; task += NGW) {
                const int tok = task >> 3, h = task & 7;
                const bf16* qrow = PQ + (size_t)tok * DM + h * 256;
                const bf16* sk = SK + (size_t)Lr * 2 * 128 * 128;
                float s1a = 0.f, s1b = 0.f, s2a = 0.f, s2b = 0.f;
                for (int d = 0; d < 128; ++d) { const float q1 = bf2f(qrow[d]), q2 = bf2f(qrow[128 + d]);
                    s1a += q1 * bf2f(sk[(size_t)lane * 128 + d]); s1b += q1 * bf2f(sk[(size_t)(64 + lane) * 128 + d]);
                    s2a += q2 * bf2f(sk[(size_t)(128 + lane) * 128 + d]); s2b += q2 * bf2f(sk[(size_t)(192 + lane) * 128 + d]); }
                float v1 = 0.f, v2 = 0.f; int i1 = 0, i2 = 0;
                for (int q = 0; q < 16; ++q) {
                    { float bv = s1a > s1b ? s1a : s1b; int bi = s1a > s1b ? lane : lane + 64;
                      for (int o = 1; o < 64; o <<= 1) { const float ov = __shfl_xor(bv, o); const int oi = __shfl_xor(bi, o); if (ov > bv || (ov == bv && oi < bi)) { bv = ov; bi = oi; } }
                      if (lane == q) { v1 = bv; i1 = bi; } if (bi == lane) s1a = -3e38f; if (bi == lane + 64) s1b = -3e38f; }
                    { float bv = s2a > s2b ? s2a : s2b; int bi = s2a > s2b ? lane : lane + 64;
                      for (int o = 1; o < 64; o <<= 1) { const float ov = __shfl_xor(bv, o); const int oi = __shfl_xor(bi, o); if (ov > bv || (ov == bv && oi < bi)) { bv = ov; bi = oi; } }
                      if (lane == q) { v2 = bv; i2 = bi; } if (bi == lane) s2a = -3e38f; if (bi == lane + 64) s2b = -3e38f; }
                }
                float cv[4]; int ce[4];
#pragma unroll
                for (int z = 0; z < 4; ++z) { const int c = lane + 64 * z, ca = c >> 4, cb = c & 15; cv[z] = __shfl(v1, ca) + __shfl(v2, cb); ce[z] = __shfl(i1, ca) * 128 + __shfl(i2, cb); }
                float sv = 0.f; int se = 0;
                for (int q = 0; q < 16; ++q) {
                    float bv = cv[0]; int bz = 0;
#pragma unroll
                    for (int z = 1; z < 4; ++z) if (cv[z] > bv) { bv = cv[z]; bz = z; }
                    int bi = lane + 64 * bz; int be = bz == 0 ? ce[0] : (bz == 1 ? ce[1] : (bz == 2 ? ce[2] : ce[3]));
                    for (int o = 1; o < 64; o <<= 1) { const float ov = __shfl_xor(bv, o); const int oi = __shfl_xor(bi, o); const int oe = __shfl_xor(be, o); if (ov > bv || (ov == bv && oi < bi)) { bv = ov; bi = oi; be = oe; } }
                    if (lane == q) { sv = bv; se = be; }
#pragma unroll
                    for (int z = 0; z < 4; ++z) if (bi == lane + 64 * z) cv[z] = -3e38f;
                }
                const float mx = __shfl(sv, 0); float ev = lane < 16 ? __expf(sv - mx) : 0.f; const float su = wave_sum(ev);
                if (lane < 16) { IDX[(size_t)tok * 128 + h * 16 + lane] = se; GATE[(size_t)tok * 128 + h * 16 + lane] = ev / su; }
            }
        }
#else
        if (PEERON(Lr) && PHM(9) && IN(pb + 7)) { WS_LAUNDER();
            const int j32 = lane & 31, hi = lane >> 5;
            for (int task = gw; task < (MR / 32) * 8; task += NGW) {
                const int grp = task >> 3, h = task & 7, tok = grp * 32 + j32;
                const bf16* qrow = PQ + (size_t)tok * DM + h * 256;
                const bf16* sk = SK + (size_t)Lr * 2 * 128 * 128;
                f32x16 p1[4], p2[4];
#pragma unroll
                for (int kt = 0; kt < 4; ++kt) { p1[kt] = f32x16{}; p2[kt] = f32x16{}; }
#pragma unroll 1
                for (int ks = 0; ks < 8; ++ks) {
                    const bf16x8 q1 = *(const bf16x8*)(qrow + ks * 16 + hi * 8), q2 = *(const bf16x8*)(qrow + 128 + ks * 16 + hi * 8);
#pragma unroll
                    for (int kt = 0; kt < 4; ++kt) {
                        const bf16x8 k1 = *(const bf16x8*)(sk + (size_t)(kt * 32 + j32) * 128 + ks * 16 + hi * 8);
                        const bf16x8 k2 = *(const bf16x8*)(sk + (size_t)(128 + kt * 32 + j32) * 128 + ks * 16 + hi * 8);
                        p1[kt] = __builtin_amdgcn_mfma_f32_32x32x16_bf16(k1, q1, p1[kt], 0, 0, 0);
                        p2[kt] = __builtin_amdgcn_mfma_f32_32x32x16_bf16(k2, q2, p2[kt], 0, 0, 0);
                    }
                }
                unsigned Lt[16];
#pragma unroll
                for (int q = 0; q < 16; ++q) Lt[q] = 0u;
#pragma unroll
                for (int kt = 0; kt < 4; ++kt)
#pragma unroll
                    for (int r = 0; r < 16; ++r) {
                        auto rr = __builtin_amdgcn_permlane32_swap(__float_as_uint(p1[kt][r]), __float_as_uint(p2[kt][r]), false, false);
                        const unsigned ka = (mono(__uint_as_float(rr[0])) & 0xFFFFFF80u) | (unsigned)(kt * 32 + att::crow(r, 0));
                        const unsigned kb = (mono(__uint_as_float(rr[1])) & 0xFFFFFF80u) | (unsigned)(kt * 32 + att::crow(r, 1));
                        INS16(Lt, ka); INS16(Lt, kb);
                    }
                unsigned L1[16], L2[16]; float v1[16], v2[16];
#pragma unroll
                for (int q = 0; q < 16; ++q) { auto rr = __builtin_amdgcn_permlane32_swap(Lt[q], Lt[q], false, false); L1[q] = rr[0]; L2[q] = rr[1];
                    v1[q] = unmono(L1[q] & 0xFFFFFF80u); v2[q] = unmono(L2[q] & 0xFFFFFF80u); }
                unsigned Cd[16];
#pragma unroll
                for (int q = 0; q < 16; ++q) Cd[q] = 0u;
#pragma unroll
                for (int ia = 0; ia < 16; ++ia)
#pragma unroll
                    for (int ib = 0; ib < 16; ++ib) if ((ia + 1) * (ib + 1) <= 16) { const unsigned kx = (mono(v1[ia] + v2[ib]) & 0xFFFFFF00u) | (unsigned)(ia * 16 + ib); INS16(Cd, kx); }
                int eid[16];
#pragma unroll
                for (int q = 0; q < 16; ++q) {
                    const unsigned ia = (Cd[q] >> 4) & 15u, ib = Cd[q] & 15u;
                    unsigned e1 = L1[0], e2 = L2[0];
#pragma unroll
                    for (int z = 1; z < 16; ++z) { e1 = (ia == (unsigned)z) ? L1[z] : e1; e2 = (ib == (unsigned)z) ? L2[z] : e2; }
                    eid[q] = (int)((e1 & 127u) * 128u + (e2 & 127u));
                }
                {
                    const float mx = unmono(Cd[0] & 0xFFFFFF00u); float ev[16], su = 0.f;
#pragma unroll
                    for (int q = 0; q < 16; ++q) { ev[q] = __expf(unmono(Cd[q] & 0xFFFFFF00u) - mx); su += ev[q]; }
                    const float inv = 1.f / su;
                    if (hi == 0) {
                        int* ip = IDX + (size_t)tok * 128 + h * 16; float* gp = GATE + (size_t)tok * 128 + h * 16;
#pragma unroll
                        for (int q = 0; q < 16; ++q) { ip[q] = eid[q]; gp[q] = ev[q] * inv; }
                    }
                }
            }
        }
#endif
        SEAM(pb + 7);
#if NAIVE_EXPERT
        if (PEERON(Lr) && PHM(10) && IN(pb + 8)) { WS_LAUNDER();
            float* fs = (float*)lds; float* cfs = fs + 2048;
            for (int row = vcu; row < MR; row += G) {
                const int b = row / RPB, r = row % RPB, v = r < CTX ? 2 : b; const float* g5 = modl + (size_t)v * NMOD + 5 * DM;
                for (int c = tid; c < DM; c += 512) fs[c] = bf2f(H[(size_t)row * DM + c]);
                __syncthreads();
                for (int k = wave; k < 128; k += 8) { const int e = IDX[(size_t)row * 128 + k]; const float* u = a.peer_u + ((size_t)Lr * NEXP + e) * DM; float d = 0.f;
                    for (int c = lane; c < DM; c += 64) d += fs[c] * u[c];
                    d = wave_sum(d); if (lane == 0) cfs[k] = gelu_tanh(d) * GATE[(size_t)row * 128 + k]; }
                __syncthreads();
                f32x4 o = {0.f, 0.f, 0.f, 0.f};
                for (int k = 0; k < 128; ++k) { const int e = IDX[(size_t)row * 128 + k]; const f32x4 vv = *(const f32x4*)(a.peer_v + ((size_t)Lr * NEXP + e) * DM + tid * 4); o += vv * cfs[k]; }
                f32x4* p = (f32x4*)(X + (size_t)row * DM + tid * 4); const f32x4 gv = *(const f32x4*)(g5 + tid * 4); *p = *p + gv * o;
                __syncthreads();
            }
        }
#else
        if (PEERON(Lr) && PHM(10) && IN(pb + 8)) { WS_LAUNDER();
            const bf16* Ul = UB + (size_t)Lr * NEXP * DM; const bf16* Vl = VB + (size_t)Lr * NEXP * DM;
            for (int row = gw; row < MR; row += NGW) {
                const int b = row / RPB, r = row % RPB, v = r < CTX ? 2 : b; const float* g5 = modl + (size_t)v * NMOD + 5 * DM;
                u32x4 xq[4];
#pragma unroll
                for (int c = 0; c < 4; ++c) xq[c] = *(const u32x4*)(H + (size_t)row * DM + c * 512 + lane * 8);
                const int ia = IDX[(size_t)row * 128 + lane], ib = IDX[(size_t)row * 128 + 64 + lane];
                const float ga = GATE[(size_t)row * 128 + lane], gb = GATE[(size_t)row * 128 + 64 + lane];
                float acc[32];
#pragma unroll
                for (int q = 0; q < 32; ++q) acc[q] = 0.f;
#pragma unroll 2
                for (int k = 0; k < 128; ++k) {
                    const int e = __builtin_amdgcn_readlane(k < 64 ? ia : ib, k & 63);
                    const float gt = __uint_as_float(__builtin_amdgcn_readlane(__float_as_uint(k < 64 ? ga : gb), k & 63));
                    const u32x4* ur = (const u32x4*)(Ul + (size_t)e * DM) + lane; const u32x4* vr = (const u32x4*)(Vl + (size_t)e * DM) + lane;
                    u32x4 uw[4], vw[4];
#pragma unroll
                    for (int c = 0; c < 4; ++c) { uw[c] = ur[c * 64]; vw[c] = vr[c * 64]; }
                    float d = 0.f;
#pragma unroll
                    for (int c = 0; c < 4; ++c) {
                        d = dot2bf(uw[c].x, xq[c].x, d); d = dot2bf(uw[c].y, xq[c].y, d); d = dot2bf(uw[c].z, xq[c].z, d); d = dot2bf(uw[c].w, xq[c].w, d);
                    }
                    d = wave_sum(d);
                    const float cf = gelu_tanh(d) * gt;
#pragma unroll
                    for (int c = 0; c < 4; ++c) {
                        acc[c * 8 + 0] += cf * bflo(vw[c].x); acc[c * 8 + 1] += cf * bfhi(vw[c].x); acc[c * 8 + 2] += cf * bflo(vw[c].y); acc[c * 8 + 3] += cf * bfhi(vw[c].y);
                        acc[c * 8 + 4] += cf * bflo(vw[c].z); acc[c * 8 + 5] += cf * bfhi(vw[c].z); acc[c * 8 + 6] += cf * bflo(vw[c].w); acc[c * 8 + 7] += cf * bfhi(vw[c].w);
                    }
                }
                float* xr = X + (size_t)row * DM;
#pragma unroll
                for (int c = 0; c < 4; ++c)
#pragma unroll
                    for (int hq = 0; hq < 2; ++hq) { const int col = c * 512 + lane * 8 + hq * 4; f32x4* p = (f32x4*)(xr + col); const f32x4 gv = *(const f32x4*)(g5 + col);
                        f32x4 o = *p; o.x += gv.x * acc[c * 8 + hq * 4 + 0]; o.y += gv.y * acc[c * 8 + hq * 4 + 1]; o.z += gv.z * acc[c * 8 + hq * 4 + 2]; o.w += gv.w * acc[c * 8 + hq * 4 + 3]; *p = o; }
            }
        }
#endif
        SEAM(pb + 8);
    }
    if (PHM(11) && IN(NPHASE - 1)) { WS_LAUNDER();
        for (int rr = gw; rr < NB * SEQ; rr += NGW) {
            const int b = rr / SEQ, t = rr % SEQ; const f32x4* xr = (const f32x4*)(X + ((size_t)b * RPB + CTX + t) * DM) + lane;
            f32x4 v[8]; float ss = 0.f;
#pragma unroll
            for (int j = 0; j < 8; ++j) { v[j] = xr[64 * j]; ss += (v[j].x * v[j].x + v[j].y * v[j].y) + (v[j].z * v[j].z + v[j].w * v[j].w); }
            const float rstd = 1.f / sqrtf(wave_sum(ss) * (1.f / DM) + EPS);
            f32x4* o = (f32x4*)(a.out + (size_t)rr * DM) + lane;
#pragma unroll
            for (int j = 0; j < 8; ++j) { const f32x4 wv = *((const f32x4*)a.final_norm_w + lane + 64 * j); o[64 * j] = v[j] * rstd * wv; }
        }
    }
#undef IN
#undef SEAM
}

extern "C" void kernel_launch(void* const* d_in, const int* in_sizes, int n_in, void* d_out, int out_size, void* d_ws, size_t ws_size, hipStream_t stream) {
    static int grid = 0;
    if (grid == 0) {
        if (n_in != 21 || out_size != NB * SEQ * DM || ws_size < WS_END) { fprintf(stderr, "kernel_launch: unexpected shapes (n_in %d out %d ws %zu)\n", n_in, out_size, ws_size); grid = -1; return; }
        int dev = 0, cus = 0, per_cu = 0;
        if (hipGetDevice(&dev) != hipSuccess || hipDeviceGetAttribute(&cus, hipDeviceAttributeMultiprocessorCount, dev) != hipSuccess) { grid = -1; return; }
        if (hipFuncSetAttribute((const void*)fwd_kernel, hipFuncAttributeMaxDynamicSharedMemorySize, LDS_BYTES) != hipSuccess) { fprintf(stderr, "kernel_launch: hipFuncSetAttribute failed\n"); grid = -1; return; }
        if (hipOccupancyMaxActiveBlocksPerMultiprocessor(&per_cu, (const void*)fwd_kernel, 512, LDS_BYTES) != hipSuccess || per_cu < 1) { fprintf(stderr, "kernel_launch: occupancy query reports %d\n", per_cu); (void)hipGetLastError(); grid = -1; return; }
        grid = cus;
    }
    if (grid < 0) return;
    (void)hipMemsetAsync((char*)d_ws + WS_CTL, 0, CTL_ZERO_BYTES, stream);
    Args a{};
    const float** f = (const float**)&a;
    for (int i = 0; i < 21; ++i) f[i] = (const float*)d_in[i];
    a.out = (float*)d_out; a.ws = (unsigned char*)d_ws;
#if ONE_LAUNCH
    a.ph_lo = 0; a.ph_hi = NPHASE;
    hipLaunchKernelGGL(fwd_kernel, dim3(grid), dim3(512), LDS_BYTES, stream, a);
#else
    for (int p = 0; p < NPHASE; ++p) {
        if (p >= 2 && p < NPHASE - 1) { const int L = (p - 2) / 9, k = (p - 2) % 9, kind = L % 3; if ((k == 2 && kind != 0) || (k == 3 && kind == 2)) continue; }
        a.ph_lo = p; a.ph_hi = p + 1;
        hipLaunchKernelGGL(fwd_kernel, dim3(grid), dim3(512), LDS_BYTES, stream, a);
    }
#endif
}
```

```cpp
#include <hip/hip_runtime.h>
#include <cstdio>
#include <cstdint>

#ifndef ONE_LAUNCH
#define ONE_LAUNCH 1
#endif
#ifndef NAIVE_ROUTE
#define NAIVE_ROUTE 0
#endif
#ifndef NAIVE_EXPERT
#define NAIVE_EXPERT 0
#endif
#ifndef NAIVE_PQ
#define NAIVE_PQ 0
#endif
#ifndef PHMASK
#define PHMASK 0xFFFF
#endif
#define PHM(b) ((PHMASK >> (b)) & 1)
#ifndef MIXMASK
#define MIXMASK 15
#endif
#ifndef PEERMASK
#define PEERMASK 15
#endif
#define MIXON(L) ((MIXMASK >> (L)) & 1)
#define PEERON(L) ((PEERMASK >> (L)) & 1)

constexpr int DM = 2048, NB = 2, SEQ = 4096, CTX = 256, RPB = CTX + SEQ  , MR = NB * RPB  ;
constexpr int NMOD = 6 * DM;
constexpr int NEXP = 16384;
constexpr float EPS = 1e-6f;

#define LAS __attribute__((address_space(3)))
typedef unsigned short bf16;
typedef short bf16x8 __attribute__((ext_vector_type(8)));
typedef short s16x4 __attribute__((ext_vector_type(4)));
typedef float f32x4 __attribute__((ext_vector_type(4)));
typedef float f32x16 __attribute__((ext_vector_type(16)));
typedef unsigned u32x4 __attribute__((ext_vector_type(4)));
typedef unsigned u32x2 __attribute__((ext_vector_type(2)));
typedef __bf16 bf2v __attribute__((ext_vector_type(2)));

__device__ __forceinline__ unsigned f2bf(float f) { unsigned u = __builtin_bit_cast(unsigned, f); return (u + 0x7fffu + ((u >> 16) & 1u)) >> 16; }
__device__ __forceinline__ unsigned pk2(float lo, float hi) { unsigned r; asm volatile("v_cvt_pk_bf16_f32 %0, %1, %2" : "=v"(r) : "v"(lo), "v"(hi)); return r; }
__device__ __forceinline__ float dot2bf(unsigned a, unsigned b, float acc) { const unsigned a_ = a, b_ = b; return __builtin_amdgcn_fdot2_f32_bf16(__builtin_bit_cast(bf2v, a_), __builtin_bit_cast(bf2v, b_), acc, false); }
__device__ __forceinline__ float bflo(unsigned w) { return __builtin_bit_cast(float, w << 16); }
__device__ __forceinline__ float bfhi(unsigned w) { return __builtin_bit_cast(float, w & 0xffff0000u); }
__device__ __forceinline__ float bf2f(bf16 b) { return __builtin_bit_cast(float, ((unsigned)b) << 16); }
__device__ __forceinline__ int opaque_tid() { int t = threadIdx.x; asm volatile("" : "+v"(t)); return t; }
__device__ __forceinline__ float wave_sum(float v) {
#pragma unroll
    for (int o = 1; o < 64; o <<= 1) v += __shfl_xor(v, o);
    return v;
}

#define XB_TMO      128
#define XB_XCNT(j)  (256  + 64 * (j))
#define XB_XSUB(j)  (1280 + 64 * (j))
#define XB_XGEN(j)  (2304 + 64 * (j))
#define XB_TOP      3328
#define XB_TOPGEN   3392
#define XCD_BAR_WORDS 3456
#define XB_SPIN_CAP (1u << 18)

__device__ __forceinline__ unsigned xb_ld(unsigned* p)              { return __hip_atomic_load(p, __ATOMIC_RELAXED, __HIP_MEMORY_SCOPE_AGENT); }
__device__ __forceinline__ unsigned xb_add(unsigned* p, unsigned v) { return __hip_atomic_fetch_add(p, v, __ATOMIC_RELAXED, __HIP_MEMORY_SCOPE_AGENT); }
__device__ __forceinline__ unsigned xb_xcc_id() { return (unsigned)__builtin_amdgcn_s_getreg((3 << 11) | 20) & 0xFu; }
#define XB_SPIN(cond, bar) do { unsigned _sp = 0; while (cond) { __builtin_amdgcn_s_sleep(1); \
    if ((++_sp & 255u) == 0u) { if (xb_ld(&(bar)[XB_TMO])) break; if (_sp > XB_SPIN_CAP) { atomicAdd(&(bar)[XB_TMO], 1u); break; } } } } while (0)

struct XcdBarrier { unsigned* bar; unsigned x; volatile LAS unsigned* st; };

__device__ __forceinline__ XcdBarrier xcd_barrier_post(unsigned* bar, volatile LAS unsigned* st) {
    XcdBarrier b; b.bar = bar; b.x = xb_xcc_id(); b.st = st;
    if (threadIdx.x == 0) (void)xb_add(&bar[XB_XCNT(b.x)], 1u);
    return b;
}
__device__ __forceinline__ void xcd_barrier_complete(unsigned* bar, unsigned x, unsigned& nloc, unsigned& nx) {
    const unsigned G = gridDim.x * gridDim.y * gridDim.z;
    unsigned sum, cnt, mine, sp = 0u;
    for (;;) {
        sum = 0u; cnt = 0u; mine = 0u;
#pragma unroll
        for (unsigned j = 0; j < 16; ++j) { const unsigned c = xb_ld(&bar[XB_XCNT(j)]); sum += c; cnt += (c > 0u) ? 1u : 0u; mine = (j == x) ? c : mine; }
        if (sum == G) break;
        __builtin_amdgcn_s_sleep(1);
        if ((++sp & 255u) == 0u) { if (xb_ld(&bar[XB_TMO])) break; if (sp > XB_SPIN_CAP) { atomicAdd(&bar[XB_TMO], 1u); break; } }
    }
    nloc = mine > 0u ? mine : 1u; nx = cnt > 0u ? cnt : 1u;
}
__device__ __forceinline__ void xcd_barrier(const XcdBarrier& b) {
    asm volatile("s_waitcnt vmcnt(0)" ::: "memory");
    __syncthreads();
    if (threadIdx.x == 0) {
        unsigned* bar = b.bar;
        __builtin_amdgcn_s_waitcnt(0);
        unsigned nloc = b.st[0], nx = b.st[1];
        if (nloc == 0u) { xcd_barrier_complete(bar, b.x, nloc, nx); b.st[0] = nloc; b.st[1] = nx; }
        const unsigned old = xb_add(&bar[XB_XSUB(b.x)], 1u);
        const unsigned gen = old / nloc;
        if (old + 1u == (gen + 1u) * nloc) {
            __builtin_amdgcn_fence(__ATOMIC_RELEASE, "agent");
            asm volatile("s_waitcnt vmcnt(0)" ::: "memory");
            const unsigned og = xb_add(&bar[XB_TOP], 1u);
            const unsigned tg = og / nx;
            if (og + 1u == (tg + 1u) * nx) xb_add(&bar[XB_TOPGEN], 1u);
            else XB_SPIN(xb_ld(&bar[XB_TOPGEN]) == tg, bar);
            __builtin_amdgcn_fence(__ATOMIC_ACQUIRE, "agent");
            xb_add(&bar[XB_XGEN(b.x)], 1u);
            asm volatile("s_waitcnt vmcnt(0)" ::: "memory");
        } else {
            XB_SPIN(xb_ld(&bar[XB_XGEN(b.x)]) == gen, bar);
            __builtin_amdgcn_fence(__ATOMIC_ACQUIRE, "agent");
            asm volatile("s_waitcnt vmcnt(0)" ::: "memory");
        }
    }
    __syncthreads();
}

namespace pg8 {
constexpr int BM = 256, BK = 64, HALF = 128, HTB = HALF * BK * 2, STAGE_BYTES = 8 * HTB, NXCD = 8, WGM = 8;
__host__ __device__ __forceinline__ int lds_byte(int r, int c) { const int st = (r >> 4) * 2 + (c >> 5), rr = r & 15, cc = c & 31, ob = rr * 64 + cc * 2; return st * 1024 + (ob ^ (((ob >> 9) & 1) << 5)); }
__host__ __device__ __forceinline__ void stage_rc(int b, int& R, int& C) { const int st = b / 1024, sb = b % 1024, swz = sb ^ (((sb >> 9) & 1) << 5); R = (st >> 1) * 16 + swz / 64; C = (st & 1) * 32 + (swz % 64) / 2; }
__host__ __device__ __forceinline__ int perm32(int rho) { const int n = rho >> 4, i = rho & 15; return 8 * (i >> 2) + 4 * n + (i & 3); }

struct Unit { int pm, pn; };
struct Gemm { const bf16* A; const bf16* Bt; int M, N, K; };

struct StaticOrder {
    int nM, nN, nwg, G, c;
    __host__ __device__ void init(int M, int N, int G_, int c_) { nM = M / BM; nN = N / BM; nwg = nM * nN; G = G_; c = c_; }
    __host__ __device__ bool next(int i, Unit& u) const {
        const long L = (long)i * G + c; if (L >= nwg) return false;
        int wgid = (int)L; { const int q = nwg / NXCD, r = nwg % NXCD, xcd = wgid % NXCD, off = wgid / NXCD; wgid = (xcd < r ? xcd * (q + 1) : r * (q + 1) + (xcd - r) * q) + off; }
        const int nig = WGM * nN, gid = wgid / nig, fm = gid * WGM, gsz = (nM - fm) < WGM ? (nM - fm) : WGM;
        u.pm = fm + ((wgid % nig) % gsz); u.pn = (wgid % nig) / gsz; return true;
    }
    __device__ __forceinline__ void a_ready(const Unit&) const {}
    __device__ __forceinline__ void done(const Unit&) const {}
};
struct FlexOrder {
    int nM, nN, nwg, G, c, grouped;
    __device__ void init(int M, int N, int G_, int c_, int grouped_) { nM = M / BM; nN = N / BM; nwg = grouped_ ? 272 : nM * nN; G = G_; c = c_; grouped = grouped_; }
    __device__ bool next(int i, Unit& u) const {
        const long L = (long)i * G + c; if (L >= nwg) return false;
        if (grouped) { const int g = (int)L / 68, r = (int)L % 68; u.pm = g * 34 + (r >> 1); u.pn = g * 2 + (r & 1); return true; }
        int wgid = (int)L; { const int q = nwg / NXCD, r = nwg % NXCD, xcd = wgid % NXCD, off = wgid / NXCD; wgid = (xcd < r ? xcd * (q + 1) : r * (q + 1) + (xcd - r) * q) + off; }
        const int nig = WGM * nN, gid = wgid / nig, fm = gid * WGM, gsz = (nM - fm) < WGM ? (nM - fm) : WGM;
        u.pm = fm + ((wgid % nig) % gsz); u.pn = (wgid % nig) / gsz; return true;
    }
    __device__ __forceinline__ void a_ready(const Unit&) const {}
    __device__ __forceinline__ void done(const Unit&) const {}
};

struct EpiBf16 {
    static constexpr bool PERM = true, AFTER_DRAIN = false;
    bf16* O; int ldc;
    __device__ __forceinline__ void operator()(const f32x4 (&acc)[2][2][4][2], const Unit& u, int wr, int wc, int fr, int fq) const {
        const int row0 = u.pm * BM + wr * 64 + fr; const int col0 = u.pn * BM + wc * 32 + 8 * fq;
#pragma unroll
        for (int ai = 0; ai < 2; ++ai)
#pragma unroll
            for (int m = 0; m < 4; ++m) { bf16* rowp = O + (size_t)(row0 + ai * HALF + m * 16) * ldc + col0;
#pragma unroll
                for (int bj = 0; bj < 2; ++bj) { const f32x4 v0 = acc[ai][bj][m][0], v1 = acc[ai][bj][m][1];
                    u32x4 w; w.x = pk2(v0[0], v0[1]); w.y = pk2(v0[2], v0[3]); w.z = pk2(v1[0], v1[1]); w.w = pk2(v1[2], v1[3]);
                    *(u32x4*)(rowp + bj * HALF) = w; } }
    }
};
struct EpiResid {
    static constexpr bool PERM = false, AFTER_DRAIN = false;
    float* X; const float* modl; int gate_off; const float* ls; int pm_mod;
    __device__ __forceinline__ void operator()(const f32x4 (&acc)[2][2][4][2], const Unit& u, int wr, int wc, int fr, int fq) const {
        const int pm = u.pm % pm_mod; const int bb = pm / 17, isctx = (pm % 17) == 0; const int v = isctx ? 2 : bb;
        const float* gate = modl + (size_t)v * NMOD + gate_off;
        const int row0 = pm * BM + wr * 64 + fr, col0 = u.pn * BM + wc * 32 + 4 * fq;
        f32x4 gv[2][2];
#pragma unroll
        for (int bj = 0; bj < 2; ++bj)
#pragma unroll
            for (int n = 0; n < 2; ++n) { gv[bj][n] = *(const f32x4*)(gate + col0 + bj * HALF + n * 16); if (ls) gv[bj][n] = gv[bj][n] * *(const f32x4*)(ls + col0 + bj * HALF + n * 16); }
#pragma unroll
        for (int ai = 0; ai < 2; ++ai)
#pragma unroll
            for (int m = 0; m < 4; ++m) { float* rowp = X + (size_t)(row0 + ai * HALF + m * 16) * DM + col0;
#pragma unroll
                for (int bj = 0; bj < 2; ++bj)
#pragma unroll
                    for (int n = 0; n < 2; ++n) { f32x4* p = (f32x4*)(rowp + bj * HALF + n * 16); *p = *p + acc[ai][bj][m][n] * gv[bj][n]; } }
    }
};

template <class Epi, class Sched>
__device__ __forceinline__ void gemm_phase(LAS unsigned char* lds, const Gemm g, const Sched& S, const Epi& E) {
    const int tid = opaque_tid(), wid = __builtin_amdgcn_readfirstlane(tid >> 6), lane = tid & 63, wr = wid >> 2, wc = wid & 3, fr = lane & 15, fq = lane >> 4;
    const int K = g.K, nt = K / BK;
    unsigned voffA[2], voffB[2];
#pragma unroll
    for (int i = 0; i < 2; ++i) { int R, C; stage_rc(tid * 16 + i * 8192, R, C); const int Rb = Epi::PERM ? ((R & ~31) + perm32(R & 31)) : R;
        voffA[i] = (unsigned)(R * K + C) * 2u; voffB[i] = (unsigned)(Rb * K + C) * 2u; }
    const size_t kstep = (size_t)(BK * 2);
    const size_t hstep = (size_t)HALF * K * 2;
    const size_t tstep = 2 * hstep;
    const unsigned ldsw = (unsigned)wid * 1024u;
    const int aoff = lds_byte(wr * 64 + fr, fq * 8), boff = lds_byte(wc * 32 + fr, fq * 8);
#define PG8_SA(b, h) (((b) * 2 + (h)) * HTB)
#define PG8_SB(b, h) ((4 + (b) * 2 + (h)) * HTB)
#define PG8_STAGE(bufoff, gbase, voff) do { _Pragma("unroll") for (int _i = 0; _i < 2; ++_i) \
        __builtin_amdgcn_global_load_lds((const unsigned*)((const char*)(gbase) + (voff)[_i]), (LAS unsigned*)(lds + (bufoff) + ldsw + _i * 8192), 16, 0, 0); } while (0)
#define PG8_LDA(dst, b, h) do { _Pragma("unroll") for (int m = 0; m < 4; ++m) _Pragma("unroll") for (int k = 0; k < 2; ++k) dst[m][k] = *(const LAS bf16x8*)(lds + PG8_SA(b, h) + aoff + m * 2048 + k * 1024); } while (0)
#define PG8_LDB(dst, b, h) do { _Pragma("unroll") for (int n = 0; n < 2; ++n) _Pragma("unroll") for (int k = 0; k < 2; ++k) dst[n][k] = *(const LAS bf16x8*)(lds + PG8_SB(b, h) + boff + n * 2048 + k * 1024); } while (0)
#define PG8_MMA(ai, bj, At, Bt) do { __builtin_amdgcn_s_setprio(1); _Pragma("unroll") for (int m = 0; m < 4; ++m) _Pragma("unroll") for (int n = 0; n < 2; ++n) _Pragma("unroll") for (int k = 0; k < 2; ++k) \
        acc[ai][bj][m][n] = __builtin_amdgcn_mfma_f32_16x16x32_bf16(Bt[n][k], At[m][k], acc[ai][bj][m][n], 0, 0, 0); __builtin_amdgcn_s_setprio(0); } while (0)
#define PG8_WAIT_V(n) asm volatile("s_waitcnt vmcnt(" #n ")" ::: "memory")
#define PG8_WAIT_L(n) asm volatile("s_waitcnt lgkmcnt(" #n ")" ::: "memory")
#define PG8_BAR __builtin_amdgcn_s_barrier()
#define PG8_SCHED __builtin_amdgcn_sched_barrier(0)
    Unit cur, nxt; int ui = 0;
    if (!S.next(0, cur)) return;
    f32x4 acc[2][2][4][2];
#pragma unroll
    for (int a = 0; a < 2; ++a)
#pragma unroll
        for (int b = 0; b < 2; ++b)
#pragma unroll
            for (int m = 0; m < 4; ++m)
#pragma unroll
                for (int n = 0; n < 2; ++n) acc[a][b][m][n] = (f32x4){0.f, 0.f, 0.f, 0.f};
    bf16x8 At[4][2], B0[2][2], B1[2][2];
    const char* cA = (const char*)g.A + (size_t)cur.pm * tstep; const char* cB = (const char*)g.Bt + (size_t)cur.pn * tstep;
    S.a_ready(cur);
    PG8_STAGE(PG8_SB(0, 0), cB, voffB); PG8_STAGE(PG8_SA(0, 0), cA, voffA); PG8_STAGE(PG8_SB(0, 1), cB + hstep, voffB); PG8_STAGE(PG8_SA(0, 1), cA + hstep, voffA);
    if (wr == 1) PG8_BAR;
    PG8_WAIT_V(4); PG8_BAR;
    PG8_STAGE(PG8_SB(1, 0), cB + kstep, voffB); PG8_STAGE(PG8_SA(1, 0), cA + kstep, voffA); PG8_STAGE(PG8_SB(1, 1), cB + hstep + kstep, voffB);
    PG8_WAIT_V(6); PG8_BAR;
    for (;;) {
        const bool has_next = S.next(ui + 1, nxt);
        const char* nA = has_next ? (const char*)g.A + (size_t)nxt.pm * tstep : cA; const char* nB = has_next ? (const char*)g.Bt + (size_t)nxt.pn * tstep : cB;
        for (int t = 0; t < nt; t += 2) {
            const bool last = (t == nt - 2);
            const char* a1 = cA + (size_t)(t + 1) * kstep;
            const char* a2 = last ? nA : cA + (size_t)(t + 2) * kstep; const char* b2 = last ? nB : cB + (size_t)(t + 2) * kstep;
            const char* a3 = a2 + kstep; const char* b3 = b2 + kstep;
            if (last && has_next) S.a_ready(nxt);
            PG8_LDB(B0, 0, 0); PG8_SCHED; PG8_LDA(At, 0, 0); PG8_STAGE(PG8_SA(1, 1), a1 + hstep, voffA);
            PG8_WAIT_L(8); PG8_BAR; PG8_WAIT_L(0); PG8_MMA(0, 0, At, B0); PG8_BAR; PG8_SCHED;
            PG8_LDB(B1, 0, 1); PG8_STAGE(PG8_SB(0, 0), b2, voffB);
            PG8_BAR; PG8_WAIT_L(0); PG8_MMA(0, 1, At, B1); PG8_BAR;
            PG8_LDA(At, 0, 1); PG8_STAGE(PG8_SA(0, 0), a2, voffA);
            PG8_BAR; PG8_WAIT_L(0); PG8_MMA(1, 0, At, B0); PG8_BAR; PG8_SCHED;
            PG8_STAGE(PG8_SB(0, 1), b2 + hstep, voffB);
            PG8_WAIT_V(6); PG8_BAR; PG8_MMA(1, 1, At, B1); PG8_BAR;
            PG8_LDB(B0, 1, 0); PG8_SCHED; PG8_LDA(At, 1, 0); PG8_STAGE(PG8_SA(0, 1), a2 + hstep, voffA);
            PG8_WAIT_L(8); PG8_BAR; PG8_WAIT_L(0); PG8_MMA(0, 0, At, B0); PG8_BAR; PG8_SCHED;
            PG8_LDB(B1, 1, 1); PG8_STAGE(PG8_SB(1, 0), b3, voffB);
            PG8_BAR; PG8_WAIT_L(0); PG8_MMA(0, 1, At, B1); PG8_BAR;
            PG8_LDA(At, 1, 1); PG8_STAGE(PG8_SA(1, 0), a3, voffA);
            PG8_BAR; PG8_WAIT_L(0); PG8_MMA(1, 0, At, B0); PG8_BAR; PG8_SCHED;
            PG8_STAGE(PG8_SB(1, 1), b3 + hstep, voffB);
            PG8_WAIT_V(6); PG8_BAR; PG8_MMA(1, 1, At, B1); PG8_BAR;
        }
        E(acc, cur, wr, wc, fr, fq); S.done(cur);
        if (!has_next) break;
#pragma unroll
        for (int a = 0; a < 2; ++a)
#pragma unroll
            for (int b = 0; b < 2; ++b)
#pragma unroll
                for (int m = 0; m < 4; ++m)
#pragma unroll
                    for (int n = 0; n < 2; ++n) acc[a][b][m][n] = (f32x4){0.f, 0.f, 0.f, 0.f};
        cur = nxt; cA = nA; cB = nB; ++ui;
    }
    PG8_WAIT_V(0);
    if (wr == 0) PG8_BAR;
    PG8_BAR;
#undef PG8_SA
#undef PG8_SB
#undef PG8_STAGE
#undef PG8_LDA
#undef PG8_LDB
#undef PG8_MMA
#undef PG8_WAIT_V
#undef PG8_WAIT_L
#undef PG8_BAR
#undef PG8_SCHED
}
}

namespace att {
constexpr int D = 128, NW = 8, QBLK = 32, KVBLK = 64;
constexpr float SCALE = 0.088388347648318440f;
constexpr float THR = 8.f;
constexpr size_t SHM_V = KVBLK * D * 2, SHM_K = KVBLK * D * 2, SHM_ATTN = 2 * SHM_V + 2 * SHM_K + NW * 64 * 4;
#define KSWZ(row, colB) ((row) * 256 + ((colB) ^ (((row) & 7) << 4)))
#define SBAR() __builtin_amdgcn_sched_barrier(0)
__device__ __forceinline__ int crow(int r, int hi) { return (r & 3) + 8 * (r >> 2) + 4 * hi; }

__device__ __forceinline__ void partialSM(f32x16& p0, f32x16& p1, float& m_reg, float& mn, float& alpha) {
  constexpr float C = SCALE * 1.4426950408889634f;
  float pmax = p0[0];
#pragma unroll
  for (int r = 1; r < 16; ++r) pmax = fmaxf(pmax, p0[r]);
#pragma unroll
  for (int r = 0; r < 16; ++r) pmax = fmaxf(pmax, p1[r]);
  { auto rr = __builtin_amdgcn_permlane32_swap(__float_as_uint(pmax), __float_as_uint(pmax), false, false);
    pmax = fmaxf(__uint_as_float(rr[0]), __uint_as_float(rr[1])); }
  if (__builtin_expect(__all(pmax - m_reg <= THR / SCALE), 1)) { mn = m_reg; alpha = 1.f; }
  else { mn = fmaxf(m_reg, pmax); alpha = __builtin_amdgcn_exp2f((m_reg - mn) * C); m_reg = mn; }
  float mnC = -mn * C;
#pragma unroll
  for (int r = 0; r < 16; ++r) p0[r] = fmaf(p0[r], C, mnC);
#pragma unroll
  for (int r = 0; r < 16; ++r) p1[r] = fmaf(p1[r], C, mnC);
#pragma unroll
  for (int r = 0; r < 16; ++r) p0[r] = __builtin_amdgcn_exp2f(p0[r]);
}
__device__ __forceinline__ void finishSM(f32x16& p0, f32x16& p1, float alpha, float& l_reg, bf16x8& pa0, bf16x8& pa1, bf16x8& pa2, bf16x8& pa3) {
#pragma unroll
  for (int r = 0; r < 16; ++r) p1[r] = __builtin_amdgcn_exp2f(p1[r]);
  float ps = 0;
#pragma unroll
  for (int r = 0; r < 16; ++r) ps += p0[r];
#pragma unroll
  for (int r = 0; r < 16; ++r) ps += p1[r];
  { auto rr = __builtin_amdgcn_permlane32_swap(__float_as_uint(ps), __float_as_uint(ps), false, false);
    ps = __uint_as_float(rr[0]) + __uint_as_float(rr[1]); }
  l_reg = l_reg * alpha + ps;
#define PK4(P, BASE, OUT) do { unsigned a0 = pk2(P[BASE + 0], P[BASE + 1]), a1 = pk2(P[BASE + 2], P[BASE + 3]);   \
    unsigned b0 = pk2(P[BASE + 4], P[BASE + 5]), b1 = pk2(P[BASE + 6], P[BASE + 7]);                              \
    auto r0 = __builtin_amdgcn_permlane32_swap(a0, b0, false, false); auto r1 = __builtin_amdgcn_permlane32_swap(a1, b1, false, false); \
    u32x4 w = {r0[0], r1[0], r0[1], r1[1]}; OUT = *reinterpret_cast<bf16x8*>(&w); } while (0)
  PK4(p0, 0, pa0); PK4(p0, 8, pa1); PK4(p1, 0, pa2); PK4(p1, 8, pa3);
#undef PK4
}
__device__ __forceinline__ void qkt(f32x16& p0, f32x16& p1, const bf16* Ks, const bf16x8* qr, int r32, int hi) {
  p0 = f32x16{}; p1 = f32x16{};
#pragma unroll
  for (int d0 = 0; d0 < 8; ++d0) { int cb = (d0 * 16 + hi * 8) * 2;
    bf16x8 b0 = *reinterpret_cast<const bf16x8*>((const char*)Ks + KSWZ(r32, cb));
    bf16x8 b1 = *reinterpret_cast<const bf16x8*>((const char*)Ks + KSWZ(32 + r32, cb));
    p0 = __builtin_amdgcn_mfma_f32_32x32x16_bf16(b0, qr[d0], p0, 0, 0, 0);
    p1 = __builtin_amdgcn_mfma_f32_32x32x16_bf16(b1, qr[d0], p1, 0, 0, 0); }
}
__device__ __forceinline__ int v_st(int k, int c) { const int kk = (k & ~0xC) | ((k & 4) << 1) | ((k & 8) >> 1); return ((kk >> 3) * 4 + (c >> 5)) * 512 + ((kk & 7) * 32 + (c & 31)) * 2; }
__device__ __forceinline__ int v_rd_base(int lane) { return ((lane & 3) << 3) | (((lane >> 2) & 3) << 6) | (((lane >> 4) & 1) << 5) | (((lane >> 5) & 1) << 8); }
constexpr int v_rd_off(int d0, int ks, int half) { return d0 * 512 + ks * 4096 + half * 2048; }
template <int OFF> __device__ __forceinline__ s16x4 tr_read(int vb) {
  s16x4 r; asm volatile("ds_read_b64_tr_b16 %0, %1 offset:%2" : "=&v"(r) : "v"(vb), "i"(OFF) : "memory"); return r;
}
template <int D0> __device__ __forceinline__ void pv_one(f32x16& od, int vb, bf16x8 pa0, bf16x8 pa1, bf16x8 pa2, bf16x8 pa3) {
  const s16x4 l0 = tr_read<v_rd_off(D0, 0, 0)>(vb), h0 = tr_read<v_rd_off(D0, 0, 1)>(vb), l1 = tr_read<v_rd_off(D0, 1, 0)>(vb), h1 = tr_read<v_rd_off(D0, 1, 1)>(vb);
  const s16x4 l2 = tr_read<v_rd_off(D0, 2, 0)>(vb), h2 = tr_read<v_rd_off(D0, 2, 1)>(vb), l3 = tr_read<v_rd_off(D0, 3, 0)>(vb), h3 = tr_read<v_rd_off(D0, 3, 1)>(vb);
  asm volatile("s_waitcnt lgkmcnt(0)" ::: "memory"); SBAR();
#define PK(L, H) (bf16x8){L[0], L[1], L[2], L[3], H[0], H[1], H[2], H[3]}
  od = __builtin_amdgcn_mfma_f32_32x32x16_bf16(pa0, PK(l0, h0), od, 0, 0, 0);
  od = __builtin_amdgcn_mfma_f32_32x32x16_bf16(pa1, PK(l1, h1), od, 0, 0, 0);
  od = __builtin_amdgcn_mfma_f32_32x32x16_bf16(pa2, PK(l2, h2), od, 0, 0, 0);
  od = __builtin_amdgcn_mfma_f32_32x32x16_bf16(pa3, PK(l3, h3), od, 0, 0, 0);
#undef PK
}
__device__ __forceinline__ void pv_d0(f32x16* o, int vb, bf16x8 pa0, bf16x8 pa1, bf16x8 pa2, bf16x8 pa3) {
  pv_one<0>(o[0], vb, pa0, pa1, pa2, pa3); pv_one<1>(o[1], vb, pa0, pa1, pa2, pa3); pv_one<2>(o[2], vb, pa0, pa1, pa2, pa3); pv_one<3>(o[3], vb, pa0, pa1, pa2, pa3);
}

template <int LD>
__device__ __forceinline__ void attn_body(const bf16* __restrict__ Qb, const bf16* __restrict__ Kh, const bf16* __restrict__ Vh, bf16* __restrict__ Ob,
                                          int NT, char* lds) {
  const int tid = opaque_tid(), wid = tid >> 6, lane = tid & 63, r32 = lane & 31, hi = lane >> 5;
  bf16* V_lds = (bf16*)lds; bf16* K_lds = (bf16*)(lds + 2 * SHM_V);
  float* ws = (float*)(lds + 2 * SHM_V + 2 * SHM_K) + wid * 64; float* li_l = ws; float* al_l = ws + 32;
  float m_reg = -1e30f, l_reg = 0; f32x16 o[4] = {}; bf16x8 qr[8];
  const bf16* Qw = Qb + (long)(wid * QBLK + r32) * LD + hi * 8;
#pragma unroll
  for (int d0 = 0; d0 < 8; ++d0) qr[d0] = *reinterpret_cast<const bf16x8*>(Qw + d0 * 16);
  const int sr = tid >> 4, sc = (tid & 15) * 8, vst0 = v_st(sr, sc), vst1 = v_st(32 + sr, sc);
  const int vb0 = (int)(uintptr_t)V_lds + v_rd_base(lane);
  struct { bf16x8 vs0, vs1, ks0, ks1; } sr_[2];
#define TROW(j) (64 * (j))
#define SLOAD(i, k0) do { const long _k = (k0); sr_[i].vs0 = *reinterpret_cast<const bf16x8*>(&Vh[(_k + sr) * LD + sc]); sr_[i].vs1 = *reinterpret_cast<const bf16x8*>(&Vh[(_k + 32 + sr) * LD + sc]); \
    sr_[i].ks0 = *reinterpret_cast<const bf16x8*>(&Kh[(_k + sr) * LD + sc]); sr_[i].ks1 = *reinterpret_cast<const bf16x8*>(&Kh[(_k + 32 + sr) * LD + sc]); } while (0)
#define SWRITE(b, i) do { *(bf16x8*)((char*)V_lds + (b) * SHM_V + vst0) = sr_[i].vs0;          \
    *(bf16x8*)((char*)V_lds + (b) * SHM_V + vst1) = sr_[i].vs1; int kc = sc * 2;               \
    *(bf16x8*)((char*)K_lds + (b) * SHM_K + KSWZ(sr, kc)) = sr_[i].ks0;                       \
    *(bf16x8*)((char*)K_lds + (b) * SHM_K + KSWZ(32 + sr, kc)) = sr_[i].ks1; } while (0)
#define SWAIT() asm volatile("s_waitcnt vmcnt(4)" ::: "memory")
#define RESC(a) do { if (__any((a) < 1.f)) { if (hi == 0) al_l[r32] = (a); asm volatile("s_waitcnt lgkmcnt(0)" ::: "memory"); \
    _Pragma("unroll") for (int d = 0; d < 4; ++d) _Pragma("unroll") for (int r = 0; r < 16; ++r) o[d][r] *= al_l[crow(r, hi)]; } } while (0)
  f32x16 pA0, pA1, pB0, pB1; float mnA, mnB, alA, alB; bf16x8 pa0, pa1, pa2, pa3;
  constexpr int SE = 0, SO = 1;
  SLOAD(SE, TROW(0)); asm volatile("s_waitcnt vmcnt(0)" ::: "memory"); SWRITE(0, SE); __syncthreads();
  qkt(pA0, pA1, K_lds, qr, r32, hi); partialSM(pA0, pA1, m_reg, mnA, alA);
  SLOAD(SO, TROW(1)); if (2 < NT) SLOAD(SE, TROW(2));
  SWAIT(); SWRITE(1, SO); __syncthreads();
  for (int j = 1; j + 1 < NT; j += 2) {
    SBAR(); qkt(pB0, pB1, (bf16*)((char*)K_lds + SHM_K), qr, r32, hi);
    finishSM(pA0, pA1, alA, l_reg, pa0, pa1, pa2, pa3); SBAR();
    SLOAD(SO, TROW(j + 2)); SBAR();
    pv_d0(o, vb0, pa0, pa1, pa2, pa3); partialSM(pB0, pB1, m_reg, mnB, alB);
    __syncthreads(); SWAIT(); SWRITE(0, SE);
    RESC(alB); __syncthreads();
    SBAR(); qkt(pA0, pA1, K_lds, qr, r32, hi);
    finishSM(pB0, pB1, alB, l_reg, pa0, pa1, pa2, pa3); SBAR();
    if (j + 3 < NT) SLOAD(SE, TROW(j + 3)); SBAR();
    pv_d0(o, vb0 + (int)SHM_V, pa0, pa1, pa2, pa3); partialSM(pA0, pA1, m_reg, mnA, alA);
    __syncthreads(); SWAIT(); SWRITE(1, SO);
    RESC(alA); __syncthreads();
  }
  SBAR(); qkt(pB0, pB1, (bf16*)((char*)K_lds + SHM_K), qr, r32, hi);
  finishSM(pA0, pA1, alA, l_reg, pa0, pa1, pa2, pa3); SBAR();
  pv_d0(o, vb0, pa0, pa1, pa2, pa3); partialSM(pB0, pB1, m_reg, mnB, alB);
  __syncthreads(); RESC(alB);
  finishSM(pB0, pB1, alB, l_reg, pa0, pa1, pa2, pa3); SBAR();
  pv_d0(o, vb0 + (int)SHM_V, pa0, pa1, pa2, pa3);
  if (hi == 0) li_l[r32] = l_reg; asm volatile("s_waitcnt lgkmcnt(0)" ::: "memory");
  float rli[16];
#pragma unroll
  for (int r = 0; r < 16; ++r) rli[r] = __builtin_amdgcn_rcpf(li_l[crow(r, hi)]);
  bf16* Ow = Ob + (long)(wid * QBLK) * DM;
#pragma unroll
  for (int r = 0; r < 16; ++r) { const int orow = crow(r, hi);
#pragma unroll
    for (int d0 = 0; d0 < 4; ++d0) Ow[(long)orow * DM + d0 * 32 + r32] = (bf16)f2bf(o[d0][r] * rli[r]); }
  __syncthreads();
#undef TROW
#undef SLOAD
#undef SWRITE
#undef SWAIT
#undef RESC
}
__device__ __forceinline__ void attn_na_body(const bf16* __restrict__ Qb, const bf16* __restrict__ Kh, const bf16* __restrict__ Vh, bf16* __restrict__ Ob,
                                             const int kr_lo, const int qrow0, const float* bl, const int NT, char* lds) {
  constexpr int LD = 6144;
  const int tid = opaque_tid(), wid = tid >> 6, lane = tid & 63, r32 = lane & 31, hi = lane >> 5;
  bf16* V_lds = (bf16*)lds; bf16* K_lds = (bf16*)(lds + 2 * SHM_V);
  float* ws = (float*)(lds + 2 * SHM_V + 2 * SHM_K) + wid * 64; float* li_l = ws; float* al_l = ws + 32;
  float m_reg = -1e30f, l_reg = 0; f32x16 o[4] = {}; bf16x8 qr[8];
  const bf16* Qw = Qb + (long)(wid * QBLK + r32) * LD + hi * 8;
#pragma unroll
  for (int d0 = 0; d0 < 8; ++d0) qr[d0] = *reinterpret_cast<const bf16x8*>(Qw + d0 * 16);
  const int sr = tid >> 4, sc = (tid & 15) * 8, vst0 = v_st(sr, sc), vst1 = v_st(32 + sr, sc);
  const int vb0 = (int)(uintptr_t)V_lds + v_rd_base(lane);
  const int widu = __builtin_amdgcn_readfirstlane(wid);
  const int qrow = qrow0 + (widu >> 1), qcol = (wid & 1) * 32 + r32;
  int r0 = qrow - 4; r0 = r0 < 0 ? 0 : (r0 > 56 ? 56 : r0);
  int c0 = qcol - 8; c0 = c0 < 0 ? 0 : (c0 > 48 ? 48 : c0);
  bf16x8 vs0, vs1, ks0, ks1;
#define NA_TROW(j) ((j) < 4 ? 64 * (j) : 256 + 64 * (kr_lo + (j) - 4))
#define NA_SLOAD(k0) do { const long _k = (k0); vs0 = *reinterpret_cast<const bf16x8*>(&Vh[(_k + sr) * LD + sc]); vs1 = *reinterpret_cast<const bf16x8*>(&Vh[(_k + 32 + sr) * LD + sc]); \
    ks0 = *reinterpret_cast<const bf16x8*>(&Kh[(_k + sr) * LD + sc]); ks1 = *reinterpret_cast<const bf16x8*>(&Kh[(_k + 32 + sr) * LD + sc]); } while (0)
  NA_SLOAD(NA_TROW(0));
  for (int j = 0; j < NT; ++j) {
    __syncthreads();
    *(bf16x8*)((char*)V_lds + vst0) = vs0; *(bf16x8*)((char*)V_lds + vst1) = vs1;
    *(bf16x8*)((char*)K_lds + KSWZ(sr, sc * 2)) = ks0; *(bf16x8*)((char*)K_lds + KSWZ(32 + sr, sc * 2)) = ks1;
    if (j + 1 < NT) NA_SLOAD(NA_TROW(j + 1));
    __syncthreads();
    const int kr = kr_lo + j - 4;
    const bool rowok = (j < 4) || ((unsigned)(kr - r0) < 8u);
    if (rowok) {
      f32x16 p0, p1; float mn, al; bf16x8 pa0, pa1, pa2, pa3;
      qkt(p0, p1, K_lds, qr, r32, hi);
      if (j >= 4) {
        const int bbase = (kr - qrow + 7) * 31 + 15 - qcol;
#pragma unroll
        for (int r = 0; r < 16; ++r) {
          const int kc0 = crow(r, hi), kc1 = 32 + kc0;
          const bool ok0 = (unsigned)(kc0 - c0) < 16u, ok1 = (unsigned)(kc1 - c0) < 16u;
          const float b0 = ok0 ? bl[bbase + kc0] : 0.f, b1 = ok1 ? bl[bbase + kc1] : 0.f;
          p0[r] = ok0 ? p0[r] + b0 : -1e30f; p1[r] = ok1 ? p1[r] + b1 : -1e30f;
        }
      }
      partialSM(p0, p1, m_reg, mn, al);
      if (__any(al < 1.f)) { if (hi == 0) al_l[r32] = al; asm volatile("s_waitcnt lgkmcnt(0)" ::: "memory");
#pragma unroll
        for (int d = 0; d < 4; ++d)
#pragma unroll
          for (int r = 0; r < 16; ++r) o[d][r] *= al_l[crow(r, hi)]; }
      finishSM(p0, p1, al, l_reg, pa0, pa1, pa2, pa3); SBAR();
      pv_d0(o, vb0, pa0, pa1, pa2, pa3);
    }
  }
  if (hi == 0) li_l[r32] = l_reg; asm volatile("s_waitcnt lgkmcnt(0)" ::: "memory");
  float rli[16];
#pragma unroll
  for (int r = 0; r < 16; ++r) rli[r] = __builtin_amdgcn_rcpf(li_l[crow(r, hi)]);
  bf16* Ow = Ob + (long)(wid * QBLK) * DM;
#pragma unroll
  for (int r = 0; r < 16; ++r) { const int orow = crow(r, hi);
#pragma unroll
    for (int d0 = 0; d0 < 4; ++d0) Ow[(long)orow * DM + d0 * 32 + r32] = (bf16)f2bf(o[d0][r] * rli[r]); }
  __syncthreads();
#undef NA_TROW
#undef NA_SLOAD
}
}


constexpr size_t MiB = 1u << 20;
constexpr size_t WS_CTL = 0, CTL_ZERO_BYTES = 1 * MiB;
constexpr size_t WS_MODV = 1 * MiB;
constexpr size_t WS_MODP = 2 * MiB;
constexpr size_t WS_X    = 22 * MiB;
constexpr size_t WS_H    = 92 * MiB;
constexpr size_t WS_QKV  = 128 * MiB;
constexpr size_t WS_O    = 232 * MiB;
constexpr size_t WS_PQ   = 268 * MiB;
constexpr size_t WS_IDX  = 304 * MiB;
constexpr size_t WS_GATE = 310 * MiB;
constexpr size_t WS_AWQKV = 316 * MiB;
constexpr size_t WS_AWO   = 340 * MiB;
constexpr size_t WS_BWQKV = 356 * MiB;
constexpr size_t WS_BWO   = 380 * MiB;
constexpr size_t WS_PW    = 388 * MiB;
constexpr size_t WS_PWQ   = 390 * MiB;
constexpr size_t WS_SK    = 422 * MiB;
constexpr size_t WS_SU    = 423 * MiB, WS_SV = WS_SU + 512 * 1024;
constexpr size_t WS_U     = 424 * MiB;
constexpr size_t WS_V     = 552 * MiB;
constexpr size_t WS_END   = 680 * MiB;

constexpr int LDS_BYTES = 147456;
constexpr int MISC_OFF = 131072 + 320;
constexpr int NPHASE = 2 + 4 * 9 + 1;

struct Args {
    const float *x, *c, *ctx, *c_ctx, *mod_w, *mod_b, *norm_w, *final_norm_w, *a_wqkv, *a_q_gain, *a_k_gain, *a_wo, *b_wqkv, *b_rpb, *b_wo, *pool_w, *pool_scale,
                *peer_wq, *peer_sub_keys, *peer_u, *peer_v;
    float* out; unsigned char* ws; int ph_lo, ph_hi;
};

__device__ __forceinline__ void p0_transpose_item(const float* W, int K, int N, bf16* WT, LAS float* scr, int item, int lane) {
    const int nblk = N / 32, kb = item / nblk, nb = item % nblk, k0 = 64 * kb, n0 = 32 * nb;
#pragma unroll 8
    for (int i = 0; i < 32; ++i) { const int kk = 2 * i + (lane >> 5); scr[kk * 33 + (lane & 31)] = W[(size_t)(k0 + kk) * N + n0 + (lane & 31)]; }
    asm volatile("s_waitcnt lgkmcnt(0)" ::: "memory");
    const int c = lane & 7;
#pragma unroll
    for (int j = 0; j < 4; ++j) { const int n = (lane >> 3) + 8 * j; const LAS float* s = scr + (8 * c) * 33 + n;
        u32x4 o; o.x = pk2(s[0 * 33], s[1 * 33]); o.y = pk2(s[2 * 33], s[3 * 33]); o.z = pk2(s[4 * 33], s[5 * 33]); o.w = pk2(s[6 * 33], s[7 * 33]);
        *(u32x4*)(WT + (size_t)(n0 + n) * K + k0 + 8 * c) = o; }
    asm volatile("s_waitcnt lgkmcnt(0)" ::: "memory");
}

__device__ __forceinline__ void norm_mod_row(const float* xrow, const float* w, const float* shift, const float* scale, bf16* orow, int lane) {
    const f32x4* xr = (const f32x4*)xrow + lane;
    f32x4 v[8]; float ss = 0.f;
#pragma unroll
    for (int j = 0; j < 8; ++j) { v[j] = xr[64 * j]; ss += (v[j].x * v[j].x + v[j].y * v[j].y) + (v[j].z * v[j].z + v[j].w * v[j].w); }
    const float rstd = 1.f / sqrtf(wave_sum(ss) * (1.f / DM) + EPS);
    u32x2* o8 = (u32x2*)orow + lane;
#pragma unroll
    for (int j = 0; j < 8; ++j) { const int c = (lane + 64 * j) * 4;
        const f32x4 wv = *(const f32x4*)(w + c), sh = *(const f32x4*)(shift + c), sc = *(const f32x4*)(scale + c);
        const f32x4 h = (v[j] * rstd * wv) * (sc + 1.f) + sh;
        u32x2 pk; pk.x = pk2(h.x, h.y); pk.y = pk2(h.z, h.w); o8[64 * j] = pk; }
}

__device__ __forceinline__ float gelu_tanh(float x) {
    const float z = 0.7978845608028654f * (x + 0.044715f * x * x * x);
    const float e = __expf(2.f * z);
    const float t = 1.f - 2.f / (1.f + e);
    return 0.5f * x * (1.f + t);
}

__device__ __forceinline__ unsigned mono(float f) { const unsigned u = __float_as_uint(f); return u ^ ((unsigned)((int)u >> 31) | 0x80000000u); }
__device__ __forceinline__ float unmono(unsigned m) { const unsigned u = (m & 0x80000000u) ? (m ^ 0x80000000u) : ~m; return __uint_as_float(u); }
#define INS16(L, x) do { unsigned _x = (x); _Pragma("unroll") for (int _j = 0; _j < 16; ++_j) { const unsigned _t = L[_j] > _x ? L[_j] : _x; _x = L[_j] > _x ? _x : L[_j]; L[_j] = _t; } } while (0)

__global__ void __launch_bounds__(512, 2) fwd_kernel(Args a) {
    extern __shared__ __attribute__((aligned(16))) unsigned char lds[];
    LAS unsigned char* L3 = (LAS unsigned char*)lds;
    volatile LAS unsigned* MISC = (volatile LAS unsigned*)(L3 + MISC_OFF);
    const int G = gridDim.x; const int bx = blockIdx.x; const int vcu = (G % 8 == 0) ? (bx % 8) * (G / 8) + bx / 8 : bx;
    const int NGW = G * 8;
    if (threadIdx.x < 32) MISC[threadIdx.x] = 0u;
    __syncthreads();
    XcdBarrier bar; bar.bar = (unsigned*)(a.ws + WS_CTL) + 4096; bar.x = 0; bar.st = nullptr;
#if ONE_LAUNCH
    bar = xcd_barrier_post((unsigned*)(a.ws + WS_CTL) + 4096, MISC + 8);
#endif
    const int lo = a.ph_lo, hi_ph = a.ph_hi;
#define IN(k) (lo <= (k) && (k) < hi_ph)
#if ONE_LAUNCH
#define SEAM(k) do { if (IN(k) && IN((k) + 1)) xcd_barrier(bar); } while (0)
#else
#define SEAM(k) do { } while (0)
#endif
#define WS_LAUNDER() unsigned char* wsl = a.ws; asm volatile("" : "+s"(wsl)); const int tid = opaque_tid(), lane = tid & 63, wave = __builtin_amdgcn_readfirstlane(tid >> 6), gw = vcu * 8 + wave; (void)lane; (void)gw
#define modv  ((float*)(wsl + WS_MODV))
#define modp  ((float*)(wsl + WS_MODP))
#define X     ((float*)(wsl + WS_X))
#define H     ((bf16*)(wsl + WS_H))
#define QKV   ((bf16*)(wsl + WS_QKV))
#define OB    ((bf16*)(wsl + WS_O))
#define PQ    ((bf16*)(wsl + WS_PQ))
#define IDX   ((int*)(wsl + WS_IDX))
#define GATE  ((float*)(wsl + WS_GATE))
#define AWQKV ((bf16*)(wsl + WS_AWQKV))
#define AWO   ((bf16*)(wsl + WS_AWO))
#define BWQKV ((bf16*)(wsl + WS_BWQKV))
#define BWO   ((bf16*)(wsl + WS_BWO))
#define PW    ((bf16*)(wsl + WS_PW))
#define PWQ   ((bf16*)(wsl + WS_PWQ))
#define SK    ((bf16*)(wsl + WS_SK))
#define U8    ((unsigned char*)(wsl + WS_U))
#define V8    ((unsigned char*)(wsl + WS_V))
#define SU    ((float*)(wsl + WS_SU))
#define SV    ((float*)(wsl + WS_SV))
    if (PHM(0) && IN(0)) { WS_LAUNDER();
        float* sm = (float*)lds;
        for (int it = bx; it < 4 * 6 * 32; it += G) {
            const int Lr = it / 192, r = it % 192, cc = r / 32, kc = r % 32;
            __syncthreads();
            if (tid < 192) { const int v = tid >> 6, k = kc * 64 + (tid & 63); const float cv = (v < 2) ? a.c[v * DM + k] : a.c_ctx[k]; sm[tid] = cv / (1.f + __expf(-cv)); }
            __syncthreads();
            const float* W = a.mod_w + ((size_t)Lr * DM + kc * 64) * NMOD + cc * 2048 + tid * 4;
            f32x4 a0 = {0.f, 0.f, 0.f, 0.f}, a1 = a0, a2 = a0;
#pragma unroll 8
            for (int k = 0; k < 64; ++k) { const f32x4 w = *(const f32x4*)(W + (size_t)k * NMOD); a0 += w * sm[k]; a1 += w * sm[64 + k]; a2 += w * sm[128 + k]; }
            float* P = modp + (((size_t)Lr * 32 + kc) * 3) * NMOD + cc * 2048 + tid * 4;
            *(f32x4*)P = a0; *(f32x4*)(P + NMOD) = a1; *(f32x4*)(P + 2 * NMOD) = a2;
        }
        __syncthreads();
        {
            LAS float* scr = (LAS float*)(L3 + wave * 16384);
            constexpr int I_AQ = 32 * 96, I_AO = 32 * 64, I_BQ = 32 * 192, I_BO = 32 * 64, I_PW = 8 * 16, I_WQ = 32 * 64;
            constexpr int NIT = 2 * I_AQ + 2 * I_AO + I_BQ + I_BO + 4 * I_PW + 4 * I_WQ;
            for (int it = gw; it < NIT; it += NGW) {
                int r = it;
                if (r < 2 * I_AQ) { const int j = r / I_AQ; p0_transpose_item(a.a_wqkv + (size_t)j * DM * 3072, DM, 3072, AWQKV + (size_t)j * 3072 * DM, scr, r % I_AQ, lane); continue; } r -= 2 * I_AQ;
                if (r < 2 * I_AO) { const int j = r / I_AO; p0_transpose_item(a.a_wo + (size_t)j * DM * DM, DM, DM, AWO + (size_t)j * DM * DM, scr, r % I_AO, lane); continue; } r -= 2 * I_AO;
                if (r < I_BQ) { p0_transpose_item(a.b_wqkv, DM, 6144, BWQKV, scr, r, lane); continue; } r -= I_BQ;
                if (r < I_BO) { p0_transpose_item(a.b_wo, DM, DM, BWO, scr, r, lane); continue; } r -= I_BO;
                if (r < 4 * I_PW) { const int j = r / I_PW; p0_transpose_item(a.pool_w + (size_t)j * 512 * 512, 512, 512, PW + (size_t)j * 512 * 512, scr, r % I_PW, lane); continue; } r -= 4 * I_PW;
                { const int j = r / I_WQ; p0_transpose_item(a.peer_wq + (size_t)j * DM * DM, DM, DM, PWQ + (size_t)j * DM * DM, scr, r % I_WQ, lane); }
            }
        }
        {
            for (int rr = gw; rr < 2 * 4 * NEXP; rr += NGW) {
                const bool isu = rr < 4 * NEXP; const int r = isu ? rr : rr - 4 * NEXP;
                const f32x4* src = (const f32x4*)((isu ? a.peer_u : a.peer_v) + (size_t)r * DM) + lane;
                f32x4 v[8]; float am = 0.f;
#pragma unroll
                for (int j = 0; j < 8; ++j) { v[j] = __builtin_nontemporal_load(src + 64 * j);
                    am = fmaxf(am, fmaxf(fmaxf(fabsf(v[j].x), fabsf(v[j].y)), fmaxf(fabsf(v[j].z), fabsf(v[j].w)))); }
#pragma unroll
                for (int o = 1; o < 64; o <<= 1) am = fmaxf(am, __shfl_xor(am, o));
                am = fmaxf(am, 1e-30f); const float inv = 127.f / am; const int off = isu ? 0 : 128;
                unsigned* dst = (unsigned*)((isu ? U8 : V8) + (size_t)r * DM) + lane;
#pragma unroll
                for (int j = 0; j < 8; ++j) {
                    const int q0 = (int)__builtin_rintf(v[j].x * inv) + off, q1 = (int)__builtin_rintf(v[j].y * inv) + off, q2 = (int)__builtin_rintf(v[j].z * inv) + off, q3 = (int)__builtin_rintf(v[j].w * inv) + off;
                    dst[64 * j] = (unsigned)(q0 & 255) | ((unsigned)(q1 & 255) << 8) | ((unsigned)(q2 & 255) << 16) | ((unsigned)(q3 & 255) << 24); }
                if (lane == 0) (isu ? SU : SV)[r] = am * (1.f / 127.f);
            }
            const size_t gt = (size_t)bx * 512 + tid, nth = (size_t)G * 512;
            const size_t nk8 = (size_t)4 * 2 * 128 * 128 / 8;
            for (size_t i = gt; i < nk8; i += nth) {
                const f32x4* sp = (const f32x4*)(a.peer_sub_keys + i * 8); const f32x4 x0 = sp[0], x1 = sp[1];
                u32x4 o; o.x = pk2(x0.x, x0.y); o.y = pk2(x0.z, x0.w); o.z = pk2(x1.x, x1.y); o.w = pk2(x1.z, x1.w);
                *(u32x4*)(SK + i * 8) = o;
            }
        }
        for (int row = gw; row < MR; row += NGW) {
            const int b = row / RPB, r = row % RPB;
            const f32x4* src = (const f32x4*)(r < CTX ? a.ctx + ((size_t)b * CTX + r) * DM : a.x + ((size_t)b * SEQ + (r - CTX)) * DM) + lane;
            f32x4* dst = (f32x4*)(X + (size_t)row * DM) + lane;
#pragma unroll
            for (int j = 0; j < 8; ++j) dst[64 * j] = src[64 * j];
        }
    }
    SEAM(0);
    if (PHM(1) && IN(1)) { WS_LAUNDER();
        for (int i = bx * 512 + tid; i < 4 * 3 * NMOD; i += G * 512) {
            const int Lr = i / (3 * NMOD), r = i % (3 * NMOD), n = r % NMOD;
            float s = a.mod_b[Lr * NMOD + n];
            for (int kc = 0; kc < 32; ++kc) s += modp[((size_t)Lr * 32 + kc) * 3 * NMOD + r];
            modv[i] = s;
        }
    }
    SEAM(1);

    for (int Lr = 0; Lr < 4; ++Lr) {
        const int kind = Lr % 3, jj = Lr / 3, pb = 2 + Lr * 9;
#define modl (modv + (size_t)Lr * 3 * NMOD)
        if (MIXON(Lr) && PHM(2) && IN(pb + 0)) { WS_LAUNDER();
            const float* w = a.norm_w + (size_t)(Lr * 2 + 0) * DM;
            for (int row = gw; row < MR; row += NGW) { const int b = row / RPB, r = row % RPB, v = r < CTX ? 2 : b; const float* mv = modl + (size_t)v * NMOD;
                norm_mod_row(X + (size_t)row * DM, w, mv + 0 * DM, mv + 1 * DM, H + (size_t)row * DM, lane); }
        }
        SEAM(pb + 0);
        if (MIXON(Lr) && PHM(3) && IN(pb + 1)) { WS_LAUNDER();
            if (kind != 2) { const int N = kind == 0 ? 3072 : 6144; pg8::Gemm g{H, kind == 0 ? AWQKV + (size_t)jj * 3072 * DM : BWQKV, MR, N, DM};
                pg8::FlexOrder S; S.init(MR, N, G, bx, 0); pg8::EpiBf16 E{QKV, N};
                pg8::gemm_phase<pg8::EpiBf16, pg8::FlexOrder>(L3, g, S, E); }
            else {
                for (int row = gw; row < MR; row += NGW) {
                    const int r = row % RPB; const int isl = r >= CTX; const int t = isl ? r - CTX : r, Ls = isl ? SEQ : CTX; const int row0 = row - t;
#pragma unroll
                    for (int g = 0; g < 4; ++g) {
                        const int w = 2 << g; int lo_ = t - w / 2; lo_ = lo_ < 0 ? 0 : lo_; int hi_ = t + w - w / 2; hi_ = hi_ > Ls ? Ls : hi_;
                        float s[8] = {0.f, 0.f, 0.f, 0.f, 0.f, 0.f, 0.f, 0.f};
                        for (int q = lo_; q < hi_; ++q) { const u32x4 hv = *(const u32x4*)(H + (size_t)(row0 + q) * DM + g * 512 + lane * 8);
                            s[0] += bflo(hv.x); s[1] += bfhi(hv.x); s[2] += bflo(hv.y); s[3] += bfhi(hv.y); s[4] += bflo(hv.z); s[5] += bfhi(hv.z); s[6] += bflo(hv.w); s[7] += bfhi(hv.w); }
                        const u32x4 hs = *(const u32x4*)(H + (size_t)row * DM + g * 512 + lane * 8); const float ic = 1.f / (float)(hi_ - lo_);
                        u32x4 o; o.x = pk2(s[0] * ic - bflo(hs.x), s[1] * ic - bfhi(hs.x)); o.y = pk2(s[2] * ic - bflo(hs.y), s[3] * ic - bfhi(hs.y));
                        o.z = pk2(s[4] * ic - bflo(hs.z), s[5] * ic - bfhi(hs.z)); o.w = pk2(s[6] * ic - bflo(hs.w), s[7] * ic - bfhi(hs.w));
                        *(u32x4*)(OB + ((size_t)g * MR + row) * 512 + lane * 8) = o;
                    }
                }
            }
        }
        SEAM(pb + 1);
        if (MIXON(Lr) && PHM(4) && IN(pb + 2) && kind == 0) { WS_LAUNDER();
            const float* qg = a.a_q_gain + jj * 128; const float* kg = a.a_k_gain + jj * 128;
            const int i = lane & 31, base = (lane >> 5) * 64;
            const float inv = exp2f(-(float)(2 * i) * (1.f / 64.f) * 13.287712379549449f);
            const float g1q = qg[base + i], g2q = qg[base + i + 32], g1k = kg[base + i], g2k = kg[base + i + 32];
            for (int row = gw; row < MR; row += NGW) {
                const int r = row % RPB; const bool isl = r >= CTX; const int t = r - CTX;
                float cs = 1.f, sn = 0.f;
                if (isl) { const float pos = (float)((lane < 32) ? (t >> 6) : (t & 63)); const float ang = pos * inv; cs = cosf(ang); sn = sinf(ang); }
                bf16* p = QKV + (size_t)row * 3072;
                for (int s = 0; s < 20; ++s) {
                    bf16* ph = p + s * 128 + base + i;
                    const float x1 = bf2f(ph[0]), x2 = bf2f(ph[32]);
                    const float rstd = 1.f / sqrtf(wave_sum(x1 * x1 + x2 * x2) * (1.f / 128.f) + EPS);
                    const float y1 = x1 * rstd * (s < 16 ? g1q : g1k), y2 = x2 * rstd * (s < 16 ? g2q : g2k);
                    ph[0] = (bf16)f2bf(y1 * cs - y2 * sn); ph[32] = (bf16)f2bf(y2 * cs + y1 * sn);
                }
            }
        }
        if (kind == 0) SEAM(pb + 2);
        if (MIXON(Lr) && PHM(5) && IN(pb + 3) && kind == 0) { WS_LAUNDER();
            for (int it = vcu; it < 512 + 32; it += G) {
                const bool isl = it < 512; const int q = isl ? it : it - 512;
                const int qb = isl ? (q & 15) : 0, h = isl ? ((q >> 4) & 15) : (q & 15), b = isl ? (q >> 8) : (q >> 4), kvh = h >> 2;
                const bf16* base = QKV + (size_t)b * RPB * 3072; const int qrow0 = isl ? CTX + qb * 256 : 0;
                att::attn_body<3072>(base + (size_t)qrow0 * 3072 + h * 128, base + 2048 + kvh * 128, base + 2560 + kvh * 128, OB + ((size_t)b * RPB + qrow0) * DM + h * 128, isl ? 68 : 4, (char*)lds);
            }
        }
        if (MIXON(Lr) && PHM(12) && IN(pb + 3) && kind == 1) { WS_LAUNDER();
            float* bl = (float*)((char*)lds + att::SHM_ATTN);
            for (int it = vcu; it < 512 + 32; it += G) {
                const bool isl = it < 512; const int q = isl ? it : it - 512;
                const int qb = isl ? (q & 15) : 0, h = isl ? ((q >> 4) & 15) : (q & 15), b = isl ? (q >> 8) : (q >> 4);
                int kr_lo = qb * 4 - 4; kr_lo = kr_lo < 0 ? 0 : (kr_lo > 52 ? 52 : kr_lo);
                { const float* rp = a.b_rpb + (size_t)h * 465; for (int z = tid; z < 465; z += 512) bl[z] = rp[z] * (1.f / att::SCALE); __syncthreads(); }
                const bf16* base = QKV + (size_t)b * RPB * 6144; const int qrow0 = isl ? CTX + qb * 256 : 0;
                att::attn_na_body(base + (size_t)qrow0 * 6144 + h * 128, base + 2048 + h * 128, base + 4096 + h * 128, OB + ((size_t)b * RPB + qrow0) * DM + h * 128, kr_lo, qb * 4, bl, isl ? 16 : 4, (char*)lds);
            }
        }
        if (kind != 2) SEAM(pb + 3);
        if (MIXON(Lr) && PHM(6) && IN(pb + 4)) { WS_LAUNDER();
            const bool grp = kind == 2;
            pg8::Gemm g{OB, grp ? PW : (kind == 0 ? AWO + (size_t)jj * DM * DM : BWO), grp ? 4 * MR : MR, DM, grp ? 512 : DM};
            pg8::FlexOrder S; S.init(MR, DM, G, bx, grp ? 1 : 0); pg8::EpiResid E{X, modl, 2 * DM, grp ? a.pool_scale : nullptr, grp ? 34 : (1 << 20)};
            pg8::gemm_phase<pg8::EpiResid, pg8::FlexOrder>(L3, g, S, E);
        }
        SEAM(pb + 4);
        if (PEERON(Lr) && PHM(7) && IN(pb + 5)) { WS_LAUNDER();
            const float* w = a.norm_w + (size_t)(Lr * 2 + 1) * DM;
            for (int row = gw; row < MR; row += NGW) { const int b = row / RPB, r = row % RPB, v = r < CTX ? 2 : b; const float* mv = modl + (size_t)v * NMOD;
                norm_mod_row(X + (size_t)row * DM, w, mv + 3 * DM, mv + 4 * DM, H + (size_t)row * DM, lane); }
        }
        SEAM(pb + 5);
        if (PEERON(Lr) && PHM(8) && IN(pb + 6)) { WS_LAUNDER();
#if NAIVE_PQ
            { const float* wq = a.peer_wq + (size_t)Lr * DM * DM;
              for (size_t o = (size_t)bx * 512 + tid; o < (size_t)MR * DM; o += (size_t)G * 512) { const int row = (int)(o / DM), n = (int)(o % DM); float s = 0.f;
                  for (int k = 0; k < DM; ++k) s += bf2f(H[(size_t)row * DM + k]) * wq[(size_t)k * DM + n];
                  PQ[o] = (bf16)f2bf(s); } }
#else
            pg8::Gemm g{H, PWQ + (size_t)Lr * DM * DM, MR, DM, DM}; pg8::FlexOrder S; S.init(MR, DM, G, bx, 0); pg8::EpiBf16 E{PQ, DM};
            pg8::gemm_phase<pg8::EpiBf16, pg8::FlexOrder>(L3, g, S, E);
#endif
        }
        SEAM(pb + 6);

#if NAIVE_ROUTE
        if (PEERON(Lr) && PHM(9) && IN(pb + 7)) { WS_LAUNDER();
            for (int task = gw; task < MR * 8; task += NGW) {
                const int tok = task >> 3, h = task & 7;
                const bf16* qrow = PQ + (size_t)tok * DM + h * 256;
                const bf16* sk = SK + (size_t)Lr * 2 * 128 * 128;
                float s1a = 0.f, s1b = 0.f, s2a = 0.f, s2b = 0.f;
                for (int d = 0; d < 128; ++d) { const float q1 = bf2f(qrow[d]), q2 = bf2f(qrow[128 + d]);
                    s1a += q1 * bf2f(sk[(size_t)lane * 128 + d]); s1b += q1 * bf2f(sk[(size_t)(64 + lane) * 128 + d]);
                    s2a += q2 * bf2f(sk[(size_t)(128 + lane) * 128 + d]); s2b += q2 * bf2f(sk[(size_t)(192 + lane) * 128 + d]); }
                float v1 = 0.f, v2 = 0.f; int i1 = 0, i2 = 0;
                for (int q = 0; q < 16; ++q) {
                    { float bv = s1a > s1b ? s1a : s1b; int bi = s1a > s1b ? lane : lane + 64;
                      for (int o = 1; o < 64; o <<= 1) { const float ov = __shfl_xor(bv, o); const int oi = __shfl_xor(bi, o); if (ov > bv || (ov == bv && oi < bi)) { bv = ov; bi = oi; } }
                      if (lane == q) { v1 = bv; i1 = bi; } if (bi == lane) s1a = -3e38f; if (bi == lane + 64) s1b = -3e38f; }
                    { float bv = s2a > s2b ? s2a : s2b; int bi = s2a > s2b ? lane : lane + 64;
                      for (int o = 1; o < 64; o <<= 1) { const float ov = __shfl_xor(bv, o); const int oi = __shfl_xor(bi, o); if (ov > bv || (ov == bv && oi < bi)) { bv = ov; bi = oi; } }
                      if (lane == q) { v2 = bv; i2 = bi; } if (bi == lane) s2a = -3e38f; if (bi == lane + 64) s2b = -3e38f; }
                }
                float cv[4]; int ce[4];
#pragma unroll
                for (int z = 0; z < 4; ++z) { const int c = lane + 64 * z, ca = c >> 4, cb = c & 15; cv[z] = __shfl(v1, ca) + __shfl(v2, cb); ce[z] = __shfl(i1, ca) * 128 + __shfl(i2, cb); }
                float sv = 0.f; int se = 0;
                for (int q = 0; q < 16; ++q) {
                    float bv = cv[0]; int bz = 0;
#pragma unroll
                    for (int z = 1; z < 4; ++z) if (cv[z] > bv) { bv = cv[z]; bz = z; }
                    int bi = lane + 64 * bz; int be = bz == 0 ? ce[0] : (bz == 1 ? ce[1] : (bz == 2 ? ce[2] : ce[3]));
                    for (int o = 1; o < 64; o <<= 1) { const float ov = __shfl_xor(bv, o); const int oi = __shfl_xor(bi, o); const int oe = __shfl_xor(be, o); if (ov > bv || (ov == bv && oi < bi)) { bv = ov; bi = oi; be = oe; } }
                    if (lane == q) { sv = bv; se = be; }
#pragma unroll
                    for (int z = 0; z < 4; ++z) if (bi == lane + 64 * z) cv[z] = -3e38f;
                }
                const float mx = __shfl(sv, 0); float ev = lane < 16 ? __expf(sv - mx) : 0.f; const float su = wave_sum(ev);
                if (lane < 16) { IDX[(size_t)tok * 128 + h * 16 + lane] = se; GATE[(size_t)tok * 128 + h * 16 + lane] = ev / su; }
            }
        }
#else
        if (PEERON(Lr) && PHM(9) && IN(pb + 7)) { WS_LAUNDER();
            const int j32 = lane & 31, hi = lane >> 5;
            for (int task = gw; task < (MR / 32) * 8; task += NGW) {
                const int grp = task >> 3, h = task & 7, tok = grp * 32 + j32;
                const bf16* qrow = PQ + (size_t)tok * DM + h * 256;
                const bf16* sk = SK + (size_t)Lr * 2 * 128 * 128;
                f32x16 p1[4], p2[4];
#pragma unroll
                for (int kt = 0; kt < 4; ++kt) { p1[kt] = f32x16{}; p2[kt] = f32x16{}; }
#pragma unroll 1
                for (int ks = 0; ks < 8; ++ks) {
                    const bf16x8 q1 = *(const bf16x8*)(qrow + ks * 16 + hi * 8), q2 = *(const bf16x8*)(qrow + 128 + ks * 16 + hi * 8);
#pragma unroll
                    for (int kt = 0; kt < 4; ++kt) {
                        const bf16x8 k1 = *(const bf16x8*)(sk + (size_t)(kt * 32 + j32) * 128 + ks * 16 + hi * 8);
                        const bf16x8 k2 = *(const bf16x8*)(sk + (size_t)(128 + kt * 32 + j32) * 128 + ks * 16 + hi * 8);
                        p1[kt] = __builtin_amdgcn_mfma_f32_32x32x16_bf16(k1, q1, p1[kt], 0, 0, 0);
                        p2[kt] = __builtin_amdgcn_mfma_f32_32x32x16_bf16(k2, q2, p2[kt], 0, 0, 0);
                    }
                }
                unsigned Lt[16];
#pragma unroll
                for (int q = 0; q < 16; ++q) Lt[q] = 0u;
#pragma unroll
                for (int kt = 0; kt < 4; ++kt)
#pragma unroll
                    for (int r = 0; r < 16; ++r) {
                        auto rr = __builtin_amdgcn_permlane32_swap(__float_as_uint(p1[kt][r]), __float_as_uint(p2[kt][r]), false, false);
                        const unsigned ka = (mono(__uint_as_float(rr[0])) & 0xFFFFFF80u) | (unsigned)(kt * 32 + att::crow(r, 0));
                        const unsigned kb = (mono(__uint_as_float(rr[1])) & 0xFFFFFF80u) | (unsigned)(kt * 32 + att::crow(r, 1));
                        INS16(Lt, ka); INS16(Lt, kb);
                    }
                unsigned L1[16], L2[16]; float v1[16], v2[16];
#pragma unroll
                for (int q = 0; q < 16; ++q) { auto rr = __builtin_amdgcn_permlane32_swap(Lt[q], Lt[q], false, false); L1[q] = rr[0]; L2[q] = rr[1];
                    v1[q] = unmono(L1[q] & 0xFFFFFF80u); v2[q] = unmono(L2[q] & 0xFFFFFF80u); }
                unsigned Cd[16];
#pragma unroll
                for (int q = 0; q < 16; ++q) Cd[q] = 0u;
#pragma unroll
                for (int ia = 0; ia < 16; ++ia)
#pragma unroll
                    for (int ib = 0; ib < 16; ++ib) if ((ia + 1) * (ib + 1) <= 16) { const unsigned kx = (mono(v1[ia] + v2[ib]) & 0xFFFFFF00u) | (unsigned)(ia * 16 + ib); INS16(Cd, kx); }
                int eid[16];
#pragma unroll
                for (int q = 0; q < 16; ++q) {
                    const unsigned ia = (Cd[q] >> 4) & 15u, ib = Cd[q] & 15u;
                    unsigned e1 = L1[0], e2 = L2[0];
#pragma unroll
                    for (int z = 1; z < 16; ++z) { e1 = (ia == (unsigned)z) ? L1[z] : e1; e2 = (ib == (unsigned)z) ? L2[z] : e2; }
                    eid[q] = (int)((e1 & 127u) * 128u + (e2 & 127u));
                }
                {
                    const float mx = unmono(Cd[0] & 0xFFFFFF00u); float ev[16], su = 0.f;
#pragma unroll
                    for (int q = 0; q < 16; ++q) { ev[q] = __expf(unmono(Cd[q] & 0xFFFFFF00u) - mx); su += ev[q]; }
                    const float inv = 1.f / su;
                    if (hi == 0) {
                        int* ip = IDX + (size_t)tok * 128 + h * 16; float* gp = GATE + (size_t)tok * 128 + h * 16;
#pragma unroll
                        for (int q = 0; q < 16; ++q) { ip[q] = eid[q]; gp[q] = ev[q] * inv; }
                    }
                }
            }
        }
#endif
        SEAM(pb + 7);
#if NAIVE_EXPERT
        if (PEERON(Lr) && PHM(10) && IN(pb + 8)) { WS_LAUNDER();
            float* fs = (float*)lds; float* cfs = fs + 2048;
            for (int row = vcu; row < MR; row += G) {
                const int b = row / RPB, r = row % RPB, v = r < CTX ? 2 : b; const float* g5 = modl + (size_t)v * NMOD + 5 * DM;
                for (int c = tid; c < DM; c += 512) fs[c] = bf2f(H[(size_t)row * DM + c]);
                __syncthreads();
                for (int k = wave; k < 128; k += 8) { const int e = IDX[(size_t)row * 128 + k]; const float* u = a.peer_u + ((size_t)Lr * NEXP + e) * DM; float d = 0.f;
                    for (int c = lane; c < DM; c += 64) d += fs[c] * u[c];
                    d = wave_sum(d); if (lane == 0) cfs[k] = gelu_tanh(d) * GATE[(size_t)row * 128 + k]; }
                __syncthreads();
                f32x4 o = {0.f, 0.f, 0.f, 0.f};
                for (int k = 0; k < 128; ++k) { const int e = IDX[(size_t)row * 128 + k]; const f32x4 vv = *(const f32x4*)(a.peer_v + ((size_t)Lr * NEXP + e) * DM + tid * 4); o += vv * cfs[k]; }
                f32x4* p = (f32x4*)(X + (size_t)row * DM + tid * 4); const f32x4 gv = *(const f32x4*)(g5 + tid * 4); *p = *p + gv * o;
                __syncthreads();
            }
        }
#else
        if (PEERON(Lr) && PHM(10) && IN(pb + 8)) { WS_LAUNDER();
            const unsigned char* Ul = U8 + (size_t)Lr * NEXP * DM; const unsigned char* Vl = V8 + (size_t)Lr * NEXP * DM;
            const float* sul = SU + (size_t)Lr * NEXP; const float* svl = SV + (size_t)Lr * NEXP;
            const int myx = ((lane & 1) << 2) | (lane & 2) | ((lane >> 2) & 1);
            for (int row = gw; row < MR; row += NGW) {
                const int b = row / RPB, r = row % RPB, v = r < CTX ? 2 : b; const float* g5 = modl + (size_t)v * NMOD + 5 * DM;
                float xf[32];
                { const u32x4* hp = (const u32x4*)(H + (size_t)row * DM); const u32x4 h0 = hp[lane * 2], h1 = hp[lane * 2 + 1], h2 = hp[128 + lane * 2], h3 = hp[128 + lane * 2 + 1];
                  const unsigned hw[16] = {h0.x, h0.y, h0.z, h0.w, h1.x, h1.y, h1.z, h1.w, h2.x, h2.y, h2.z, h2.w, h3.x, h3.y, h3.z, h3.w};
#pragma unroll
                  for (int q = 0; q < 16; ++q) { xf[2 * q] = bflo(hw[q]); xf[2 * q + 1] = bfhi(hw[q]); } }
                float am = 0.f;
#pragma unroll
                for (int q = 0; q < 32; ++q) am = fmaxf(am, fabsf(xf[q]));
#pragma unroll
                for (int o = 1; o < 64; o <<= 1) am = fmaxf(am, __shfl_xor(am, o));
                am = fmaxf(am, 1e-30f); const float xinv = 127.f / am, sx = am * (1.f / 127.f);
                int xq[8];
#pragma unroll
                for (int q = 0; q < 8; ++q) { const int q0 = (int)__builtin_rintf(xf[4 * q] * xinv), q1 = (int)__builtin_rintf(xf[4 * q + 1] * xinv), q2 = (int)__builtin_rintf(xf[4 * q + 2] * xinv), q3 = (int)__builtin_rintf(xf[4 * q + 3] * xinv);
                    xq[q] = (int)((unsigned)(q0 & 255) | ((unsigned)(q1 & 255) << 8) | ((unsigned)(q2 & 255) << 16) | ((unsigned)(q3 & 255) << 24)); }
                const int ia = IDX[(size_t)row * 128 + lane], ib = IDX[(size_t)row * 128 + 64 + lane];
                const float ga = GATE[(size_t)row * 128 + lane], gb = GATE[(size_t)row * 128 + 64 + lane];
                float acc[32]; float csum = 0.f;
#pragma unroll
                for (int q = 0; q < 32; ++q) acc[q] = 0.f;
#pragma unroll 1
                for (int k0 = 0; k0 < 128; k0 += 8) {
                    const int isrc = k0 < 64 ? ia : ib; const float gsrc = k0 < 64 ? ga : gb; const int kb = k0 & 63;
                    int e[8]; u32x4 uw[8][2], vw[8][2];
#pragma unroll
                    for (int j = 0; j < 8; ++j) { e[j] = __builtin_amdgcn_readlane(isrc, kb + j);
                        const u32x4* ur = (const u32x4*)(Ul + (size_t)e[j] * DM); uw[j][0] = ur[lane]; uw[j][1] = ur[64 + lane]; }
#pragma unroll
                    for (int j = 0; j < 8; ++j) { const u32x4* vr = (const u32x4*)(Vl + (size_t)e[j] * DM); vw[j][0] = vr[lane]; vw[j][1] = vr[64 + lane]; }
                    const int eo = __shfl(isrc, kb + myx); const float go = __shfl(gsrc, kb + myx); const float suo = sul[eo], svo = svl[eo];
                    int p[8];
#pragma unroll
                    for (int j = 0; j < 8; ++j) { int d = 0;
                        d = __builtin_amdgcn_sdot4((int)uw[j][0].x, xq[0], d, false); d = __builtin_amdgcn_sdot4((int)uw[j][0].y, xq[1], d, false);
                        d = __builtin_amdgcn_sdot4((int)uw[j][0].z, xq[2], d, false); d = __builtin_amdgcn_sdot4((int)uw[j][0].w, xq[3], d, false);
                        d = __builtin_amdgcn_sdot4((int)uw[j][1].x, xq[4], d, false); d = __builtin_amdgcn_sdot4((int)uw[j][1].y, xq[5], d, false);
                        d = __builtin_amdgcn_sdot4((int)uw[j][1].z, xq[6], d, false); d = __builtin_amdgcn_sdot4((int)uw[j][1].w, xq[7], d, false);
                        p[j] = d; }
                    int q4[4], q2[2], q1;
#pragma unroll
                    for (int j = 0; j < 4; ++j) { const int snd = (lane & 1) ? p[j] : p[j + 4], kp = (lane & 1) ? p[j + 4] : p[j]; q4[j] = kp + __shfl_xor(snd, 1); }
#pragma unroll
                    for (int j = 0; j < 2; ++j) { const int snd = (lane & 2) ? q4[j] : q4[j + 2], kp = (lane & 2) ? q4[j + 2] : q4[j]; q2[j] = kp + __shfl_xor(snd, 2); }
                    { const int snd = (lane & 4) ? q2[0] : q2[1], kp = (lane & 4) ? q2[1] : q2[0]; q1 = kp + __shfl_xor(snd, 4); }
                    q1 += __shfl_xor(q1, 8); q1 += __shfl_xor(q1, 16); q1 += __shfl_xor(q1, 32);
                    const float cown = gelu_tanh((float)q1 * suo * sx) * go * svo;
#pragma unroll
                    for (int j = 0; j < 8; ++j) {
                        const int src = ((j & 1) << 2) | (j & 2) | ((j >> 2) & 1);
                        const float cj = __uint_as_float(__builtin_amdgcn_readlane(__float_as_uint(cown), src));
                        csum += cj;
                        const unsigned w[8] = {vw[j][0].x, vw[j][0].y, vw[j][0].z, vw[j][0].w, vw[j][1].x, vw[j][1].y, vw[j][1].z, vw[j][1].w};
#pragma unroll
                        for (int q = 0; q < 8; ++q) {
                            acc[4 * q + 0] = fmaf(cj, (float)(w[q] & 255u), acc[4 * q + 0]); acc[4 * q + 1] = fmaf(cj, (float)((w[q] >> 8) & 255u), acc[4 * q + 1]);
                            acc[4 * q + 2] = fmaf(cj, (float)((w[q] >> 16) & 255u), acc[4 * q + 2]); acc[4 * q + 3] = fmaf(cj, (float)(w[q] >> 24), acc[4 * q + 3]); }
                    }
                }
                const float coff = 128.f * csum;
                float* xr = X + (size_t)row * DM;
#pragma unroll
                for (int hf = 0; hf < 2; ++hf)
#pragma unroll
                    for (int q = 0; q < 4; ++q) { const int col = hf * 1024 + lane * 16 + q * 4; f32x4* pp = (f32x4*)(xr + col); const f32x4 gv = *(const f32x4*)(g5 + col);
                        f32x4 o = *pp; const int ab = hf * 16 + q * 4;
                        o.x += gv.x * (acc[ab + 0] - coff); o.y += gv.y * (acc[ab + 1] - coff); o.z += gv.z * (acc[ab + 2] - coff); o.w += gv.w * (acc[ab + 3] - coff); *pp = o; }
            }
        }
#endif
        SEAM(pb + 8);
    }
    if (PHM(11) && IN(NPHASE - 1)) { WS_LAUNDER();
        for (int rr = gw; rr < NB * SEQ; rr += NGW) {
            const int b = rr / SEQ, t = rr % SEQ; const f32x4* xr = (const f32x4*)(X + ((size_t)b * RPB + CTX + t) * DM) + lane;
            f32x4 v[8]; float ss = 0.f;
#pragma unroll
            for (int j = 0; j < 8; ++j) { v[j] = xr[64 * j]; ss += (v[j].x * v[j].x + v[j].y * v[j].y) + (v[j].z * v[j].z + v[j].w * v[j].w); }
            const float rstd = 1.f / sqrtf(wave_sum(ss) * (1.f / DM) + EPS);
            f32x4* o = (f32x4*)(a.out + (size_t)rr * DM) + lane;
#pragma unroll
            for (int j = 0; j < 8; ++j) { const f32x4 wv = *((const f32x4*)a.final_norm_w + lane + 64 * j); o[64 * j] = v[j] * rstd * wv; }
        }
    }
#undef IN
#undef SEAM
}

extern "C" void kernel_launch(void* const* d_in, const int* in_sizes, int n_in, void* d_out, int out_size, void* d_ws, size_t ws_size, hipStream_t stream) {
    static int grid = 0;
    if (grid == 0) {
        if (n_in != 21 || out_size != NB * SEQ * DM || ws_size < WS_END) { fprintf(stderr, "kernel_launch: unexpected shapes (n_in %d out %d ws %zu)\n", n_in, out_size, ws_size); grid = -1; return; }
        int dev = 0, cus = 0, per_cu = 0;
        if (hipGetDevice(&dev) != hipSuccess || hipDeviceGetAttribute(&cus, hipDeviceAttributeMultiprocessorCount, dev) != hipSuccess) { grid = -1; return; }
        if (hipFuncSetAttribute((const void*)fwd_kernel, hipFuncAttributeMaxDynamicSharedMemorySize, LDS_BYTES) != hipSuccess) { fprintf(stderr, "kernel_launch: hipFuncSetAttribute failed\n"); grid = -1; return; }
        if (hipOccupancyMaxActiveBlocksPerMultiprocessor(&per_cu, (const void*)fwd_kernel, 512, LDS_BYTES) != hipSuccess || per_cu < 1) { fprintf(stderr, "kernel_launch: occupancy query reports %d\n", per_cu); (void)hipGetLastError(); grid = -1; return; }
        grid = cus;
    }
    if (grid < 0) return;
    (void)hipMemsetAsync((char*)d_ws + WS_CTL, 0, CTL_ZERO_BYTES, stream);
    Args a{};
    const float** f = (const float**)&a;
    for (int i = 0; i < 21; ++i) f[i] = (const float*)d_in[i];
    a.out = (float*)d_out; a.ws = (unsigned char*)d_ws;
#if ONE_LAUNCH
    a.ph_lo = 0; a.ph_hi = NPHASE;
    hipLaunchKernelGGL(fwd_kernel, dim3(grid), dim3(512), LDS_BYTES, stream, a);
#else
    for (int p = 0; p < NPHASE; ++p) {
        if (p >= 2 && p < NPHASE - 1) { const int L = (p - 2) / 9, k = (p - 2) % 9, kind = L % 3; if ((k == 2 && kind != 0) || (k == 3 && kind == 2)) continue; }
        a.ph_lo = p; a.ph_hi = p + 1;
        hipLaunchKernelGGL(fwd_kernel, dim3(grid), dim3(512), LDS_BYTES, stream, a);
    }
#endif
}
```

```cpp
#include <hip/hip_runtime.h>
#include <cstdio>
#include <cstdint>

#ifndef ONE_LAUNCH
#define ONE_LAUNCH 1
#endif
#ifndef RSZ_A
#define RSZ_A 512
#endif
#ifndef RSZ_B
#define RSZ_B 512
#endif
#ifndef TMASK
#define TMASK 0
#endif
#ifndef TSCALE
#define TSCALE 500.f
#endif
#define TMON(b) ((TMASK >> (b)) & 1)
#ifndef PHMASK
#define PHMASK 0xFFFF
#endif
#define PHM(b) ((PHMASK >> (b)) & 1)
#ifndef MIXMASK
#define MIXMASK 15
#endif
#ifndef PEERMASK
#define PEERMASK 15
#endif
#define MIXON(L) ((MIXMASK >> (L)) & 1)
#define PEERON(L) ((PEERMASK >> (L)) & 1)

constexpr int DM = 2048, NB = 2, SEQ = 4096, CTX = 256, RPB = CTX + SEQ  , MR = NB * RPB  ;
constexpr int NMOD = 6 * DM;
constexpr int NEXP = 16384;
constexpr float EPS = 1e-6f;

#define LAS __attribute__((address_space(3)))
#define GAS __attribute__((address_space(1)))
typedef unsigned short bf16;
typedef short bf16x8 __attribute__((ext_vector_type(8)));
typedef short s16x4 __attribute__((ext_vector_type(4)));
typedef float f32x4 __attribute__((ext_vector_type(4)));
typedef float f32x2 __attribute__((ext_vector_type(2)));
typedef float f32x16 __attribute__((ext_vector_type(16)));
typedef unsigned u32x4 __attribute__((ext_vector_type(4)));
typedef unsigned u32x2 __attribute__((ext_vector_type(2)));
typedef __bf16 bf2v __attribute__((ext_vector_type(2)));

__device__ __forceinline__ unsigned f2bf(float f) { unsigned u = __builtin_bit_cast(unsigned, f); return (u + 0x7fffu + ((u >> 16) & 1u)) >> 16; }
__device__ __forceinline__ unsigned f8x4(float a, float b, float c, float d) { int w = 0; w = __builtin_amdgcn_cvt_pk_fp8_f32(a, b, w, false); w = __builtin_amdgcn_cvt_pk_fp8_f32(c, d, w, true); return (unsigned)w; }
constexpr int F8_ASHIFT = 2, F8_WSHIFT = 7; constexpr float F8_ASCALE = 4.f, F8_WSCALE = 128.f;
__device__ __forceinline__ unsigned pk2(float lo, float hi) { unsigned r; asm volatile("v_cvt_pk_bf16_f32 %0, %1, %2" : "=v"(r) : "v"(lo), "v"(hi)); return r; }
__device__ __forceinline__ float dot2bf(unsigned a, unsigned b, float acc) { const unsigned a_ = a, b_ = b; return __builtin_amdgcn_fdot2_f32_bf16(__builtin_bit_cast(bf2v, a_), __builtin_bit_cast(bf2v, b_), acc, false); }
__device__ __forceinline__ int shx_i(int v, int k) {
    switch (k) {
        case 1:  return __builtin_amdgcn_ds_swizzle(v, (1 << 10) | 0x1F);
        case 2:  return __builtin_amdgcn_ds_swizzle(v, (2 << 10) | 0x1F);
        case 4:  return __builtin_amdgcn_ds_swizzle(v, (4 << 10) | 0x1F);
        case 8:  return __builtin_amdgcn_ds_swizzle(v, (8 << 10) | 0x1F);
        case 16: return __builtin_amdgcn_ds_swizzle(v, (16 << 10) | 0x1F);
        default: { auto rr = __builtin_amdgcn_permlane32_swap((unsigned)v, (unsigned)v, false, false); int r;
                   asm("v_cndmask_b32_e64 %0, %1, %2, %3" : "=v"(r) : "v"(rr[1]), "v"(rr[0]), "s"(0xFFFFFFFF00000000ull)); return r; }
    }
}
__device__ __forceinline__ float shx(float v, int k) { return __builtin_bit_cast(float, shx_i(__builtin_bit_cast(int, v), k)); }
__device__ __forceinline__ int shx(int v, int k) { return shx_i(v, k); }
__device__ __forceinline__ unsigned shx(unsigned v, int k) { return (unsigned)shx_i((int)v, k); }
__device__ __forceinline__ float bflo(unsigned w) { return __builtin_bit_cast(float, w << 16); }
__device__ __forceinline__ float bfhi(unsigned w) { return __builtin_bit_cast(float, w & 0xffff0000u); }
__device__ __forceinline__ f32x4 bf4(u32x2 w) { return (f32x4){bflo(w.x), bfhi(w.x), bflo(w.y), bfhi(w.y)}; }
__device__ __forceinline__ float bf2f(bf16 b) { return __builtin_bit_cast(float, ((unsigned)b) << 16); }
constexpr int TID_TABLE_OFF = 131072 + 320 + 256;
__device__ __forceinline__ unsigned hw_slot() { return (unsigned)__builtin_amdgcn_s_getreg((5 << 11) | 4) & 63u; }
__device__ __forceinline__ int opaque_tid() {
    extern __shared__ __attribute__((aligned(16))) unsigned char lds_tid_[];
    const int w = ((volatile __attribute__((address_space(3))) unsigned char*)lds_tid_)[TID_TABLE_OFF + hw_slot()];
    int t = w * 64 + (int)__builtin_amdgcn_mbcnt_hi(~0u, __builtin_amdgcn_mbcnt_lo(~0u, 0u)); asm volatile("" : "+v"(t)); return t; }
__device__ __forceinline__ float wave_sum(float v) {
#pragma unroll
    for (int o = 1; o < 64; o <<= 1) v += shx(v, o);
    return v;
}

template <int J> __device__ __forceinline__ int lane_xor(int x, int lane) {
    if constexpr (J == 1) return __builtin_amdgcn_mov_dpp(x, 0xB1, 0xf, 0xf, true);
    else if constexpr (J == 2) return __builtin_amdgcn_mov_dpp(x, 0x4E, 0xf, 0xf, true);
    else if constexpr (J == 4) { const int up = __builtin_amdgcn_mov_dpp(x, 0x104, 0xf, 0xf, true), dn = __builtin_amdgcn_mov_dpp(x, 0x114, 0xf, 0xf, true); return (lane & 4) ? dn : up; }
    else if constexpr (J == 8) return __builtin_amdgcn_mov_dpp(x, 0x128, 0xf, 0xf, true);
    else if constexpr (J == 16) { auto r = __builtin_amdgcn_permlane16_swap((unsigned)x, (unsigned)x, false, false); return (int)((lane & 16) ? r[0] : r[1]); }
    else { auto r = __builtin_amdgcn_permlane32_swap((unsigned)x, (unsigned)x, false, false); return (int)((lane & 32) ? r[0] : r[1]); }
}
__device__ __forceinline__ void sincos_rot(float x, float& sn, float& cs) {
    const float n = __builtin_rintf(x * 0.63661977236758134f);
    float r = fmaf(-n, 1.5703125f, x); r = fmaf(-n, 4.837512969970703125e-4f, r); r = fmaf(-n, 7.54978995489188e-8f, r);
    const float r2 = r * r;
    const float sp = r + r * r2 * fmaf(r2, fmaf(r2, fmaf(r2, 2.7557314297e-6f, -1.9841270114e-4f), 8.3333337680e-3f), -1.6666667163e-1f);
    const float cp = fmaf(r2, fmaf(r2, fmaf(r2, fmaf(r2, 2.4801587642e-5f, -1.3888889225e-3f), 4.1666667908e-2f), -0.5f), 1.f);
    const int q = (int)n & 3;
    const float s0 = (q & 1) ? cp : sp, c0 = (q & 1) ? sp : cp;
    sn = (q & 2) ? -s0 : s0; cs = ((q + 1) & 2) ? -c0 : c0;
}

#define XB_TMO      128
#define XB_XCNT(j)  (256  + 64 * (j))
#define XB_XSUB(j)  (1280 + 64 * (j))
#define XB_XGEN(j)  (2304 + 64 * (j))
#define XB_TOP      3328
#define XB_TOPGEN   3392
#define XCD_BAR_WORDS 3456
#define XB_SPIN_CAP (1u << 18)

__device__ __forceinline__ unsigned xb_ld(unsigned* p)              { return __hip_atomic_load(p, __ATOMIC_RELAXED, __HIP_MEMORY_SCOPE_AGENT); }
__device__ __forceinline__ unsigned xb_add(unsigned* p, unsigned v) { return __hip_atomic_fetch_add(p, v, __ATOMIC_RELAXED, __HIP_MEMORY_SCOPE_AGENT); }
__device__ __forceinline__ unsigned xb_xcc_id() { return (unsigned)__builtin_amdgcn_s_getreg((3 << 11) | 20) & 0xFu; }
#define XB_SPIN(cond, bar) do { unsigned _sp = 0; while (cond) { __builtin_amdgcn_s_sleep(1); \
    if ((++_sp & 255u) == 0u) { if (xb_ld(&(bar)[XB_TMO])) break; if (_sp > XB_SPIN_CAP) { atomicAdd(&(bar)[XB_TMO], 1u); break; } } } } while (0)

struct XcdBarrier { unsigned* bar; unsigned x; volatile LAS unsigned* st; };

__device__ __forceinline__ XcdBarrier xcd_barrier_post(unsigned* bar, volatile LAS unsigned* st) {
    XcdBarrier b; b.bar = bar; b.x = xb_xcc_id(); b.st = st;
    if (threadIdx.x == 0) (void)xb_add(&bar[XB_XCNT(b.x)], 1u);
    return b;
}
__device__ __forceinline__ void xcd_barrier_complete(unsigned* bar, unsigned x, unsigned& nloc, unsigned& nx) {
    const unsigned G = gridDim.x * gridDim.y * gridDim.z;
    unsigned sum, cnt, mine, sp = 0u;
    for (;;) {
        sum = 0u; cnt = 0u; mine = 0u;
#pragma unroll
        for (unsigned j = 0; j < 16; ++j) { const unsigned c = xb_ld(&bar[XB_XCNT(j)]); sum += c; cnt += (c > 0u) ? 1u : 0u; mine = (j == x) ? c : mine; }
        if (sum == G) break;
        __builtin_amdgcn_s_sleep(1);
        if ((++sp & 255u) == 0u) { if (xb_ld(&bar[XB_TMO])) break; if (sp > XB_SPIN_CAP) { atomicAdd(&bar[XB_TMO], 1u); break; } }
    }
    nloc = mine > 0u ? mine : 1u; nx = cnt > 0u ? cnt : 1u;
}
__device__ __forceinline__ void xcd_barrier(const XcdBarrier& b) {
    asm volatile("s_waitcnt vmcnt(0)" ::: "memory");
    __syncthreads();
    if (threadIdx.x == 0) {
        unsigned* bar = b.bar;
        __builtin_amdgcn_s_waitcnt(0);
        unsigned nloc = b.st[0], nx = b.st[1];
        if (nloc == 0u) { xcd_barrier_complete(bar, b.x, nloc, nx); b.st[0] = nloc; b.st[1] = nx; }
        const unsigned old = xb_add(&bar[XB_XSUB(b.x)], 1u);
        const unsigned gen = old / nloc;
        if (old + 1u == (gen + 1u) * nloc) {
            __builtin_amdgcn_fence(__ATOMIC_RELEASE, "agent");
            asm volatile("s_waitcnt vmcnt(0)" ::: "memory");
            const unsigned og = xb_add(&bar[XB_TOP], 1u);
            const unsigned tg = og / nx;
            if (og + 1u == (tg + 1u) * nx) xb_add(&bar[XB_TOPGEN], 1u);
            else XB_SPIN(xb_ld(&bar[XB_TOPGEN]) == tg, bar);
            __builtin_amdgcn_fence(__ATOMIC_ACQUIRE, "agent");
            xb_add(&bar[XB_XGEN(b.x)], 1u);
            asm volatile("s_waitcnt vmcnt(0)" ::: "memory");
        } else {
            XB_SPIN(xb_ld(&bar[XB_XGEN(b.x)]) == gen, bar);
            __builtin_amdgcn_fence(__ATOMIC_ACQUIRE, "agent");
            asm volatile("s_waitcnt vmcnt(0)" ::: "memory");
        }
    }
    __syncthreads();
}

namespace pg8 {
constexpr int BM = 256, BK = 64, HALF = 128, HTB = HALF * BK * 2, STAGE_BYTES = 8 * HTB, NXCD = 8, WGM = 8;
__host__ __device__ __forceinline__ int lds_byte(int r, int c) { const int st = (r >> 4) * 2 + (c >> 5), rr = r & 15, cc = c & 31, ob = rr * 64 + cc * 2; return st * 1024 + (ob ^ (((ob >> 9) & 1) << 5)); }
__host__ __device__ __forceinline__ void stage_rc(int b, int& R, int& C) { const int st = b / 1024, sb = b % 1024, swz = sb ^ (((sb >> 9) & 1) << 5); R = (st >> 1) * 16 + swz / 64; C = (st & 1) * 32 + (swz % 64) / 2; }
__host__ __device__ __forceinline__ int perm32(int rho) { const int n = rho >> 4, i = rho & 15; return 8 * (i >> 2) + 4 * n + (i & 3); }

struct Unit { int pm, pn; };
struct Gemm { const bf16* A; const bf16* Bt; int M, N, K; };

struct StaticOrder {
    int nM, nN, nwg, G, c;
    __host__ __device__ void init(int M, int N, int G_, int c_) { nM = M / BM; nN = N / BM; nwg = nM * nN; G = G_; c = c_; }
    __host__ __device__ bool next(int i, Unit& u) const {
        const long L = (long)i * G + c; if (L >= nwg) return false;
        int wgid = (int)L; { const int q = nwg / NXCD, r = nwg % NXCD, xcd = wgid % NXCD, off = wgid / NXCD; wgid = (xcd < r ? xcd * (q + 1) : r * (q + 1) + (xcd - r) * q) + off; }
        const int nig = WGM * nN, gid = wgid / nig, fm = gid * WGM, gsz = (nM - fm) < WGM ? (nM - fm) : WGM;
        u.pm = fm + ((wgid % nig) % gsz); u.pn = (wgid % nig) / gsz; return true;
    }
    __device__ __forceinline__ void a_ready(const Unit&) const {}
    __device__ __forceinline__ void done(const Unit&) const {}
};
struct FlexOrder {
    int nM, nN, nwg, G, c, grouped;
    __device__ void init(int M, int N, int G_, int c_, int grouped_) { nM = grouped_ == 2 ? 32 : M / BM; nN = N / BM; nwg = grouped_ == 1 ? 272 : (grouped_ == 3 ? 256 : nM * nN); G = G_; c = c_; grouped = grouped_; }
    __device__ bool next(int i, Unit& u) const {
        const long L = (long)i * G + c; if (L >= nwg) return false;
        if (grouped == 1) { const int g = (int)L / 68, r = (int)L % 68; u.pm = g * 34 + (r >> 1); u.pn = g * 2 + (r & 1); return true; }
        if (grouped == 3) { const int g = (int)L / 64, r = (int)L % 64, pl = r >> 1; u.pm = g * 34 + pl + 1 + (pl >= 16 ? 1 : 0); u.pn = g * 2 + (r & 1); return true; }
        int wgid = (int)L; { const int q = nwg / NXCD, r = nwg % NXCD, xcd = wgid % NXCD, off = wgid / NXCD; wgid = (xcd < r ? xcd * (q + 1) : r * (q + 1) + (xcd - r) * q) + off; }
        const int nig = WGM * nN, gid = wgid / nig, fm = gid * WGM, gsz = (nM - fm) < WGM ? (nM - fm) : WGM;
        u.pm = fm + ((wgid % nig) % gsz); u.pn = (wgid % nig) / gsz; if (grouped == 2) u.pm += 1 + (u.pm >= 16 ? 1 : 0); return true;
    }
    __device__ __forceinline__ void a_ready(const Unit&) const {}
    __device__ __forceinline__ void done(const Unit&) const {}
};

struct EpiBf16 {
    static constexpr bool PERM = true, AFTER_DRAIN = false;
    bf16* O; int ldc;
    __device__ __forceinline__ void operator()(const f32x4 (&acc)[2][2][4][2], const Unit& u, int wr, int wc, int fr, int fq) const {
        const int row0 = u.pm * BM + wr * 64 + fr; const int col0 = u.pn * BM + wc * 32 + 8 * fq;
#pragma unroll
        for (int ai = 0; ai < 2; ++ai)
#pragma unroll
            for (int m = 0; m < 4; ++m) { bf16* rowp = O + (size_t)(row0 + ai * HALF + m * 16) * ldc + col0;
#pragma unroll
                for (int bj = 0; bj < 2; ++bj) { const f32x4 v0 = acc[ai][bj][m][0], v1 = acc[ai][bj][m][1];
                    u32x4 w; w.x = pk2(v0[0], v0[1]); w.y = pk2(v0[2], v0[3]); w.z = pk2(v1[0], v1[1]); w.w = pk2(v1[2], v1[3]);
                    *(u32x4*)(rowp + bj * HALF) = w; } }
    }
};
struct EpiResid {
    static constexpr bool PERM = true, AFTER_DRAIN = false;
    bf16* X; const float* modl; int gate_off; const float* ls; int pm_mod;
    signed char* XQ; float* ssq; const float* w2; const float* sxb; const float* x_in; const float* ctx_in;
    __device__ __forceinline__ void operator()(const f32x4 (&acc)[2][2][4][2], const Unit& u, int wr, int wc, int fr, int fq) const {
        const int pm = u.pm % pm_mod; const int bb = pm / 17, isctx = (pm % 17) == 0; const int v = isctx ? 2 : bb;
        const float* gate = modl + (size_t)v * NMOD + gate_off; const float* m4 = modl + (size_t)v * NMOD + 4 * DM;
        const int row0 = pm * BM + wr * 64 + fr, col0 = u.pn * BM + wc * 32 + 8 * fq;
        const float* srcf = x_in ? (isctx ? ctx_in + (size_t)bb * CTX * DM : x_in + ((size_t)bb * SEQ + (pm % 17 - 1) * 256) * DM) : nullptr;
        f32x4 gv[2][2], gs[2][2];
#pragma unroll
        for (int bj = 0; bj < 2; ++bj)
#pragma unroll
            for (int n = 0; n < 2; ++n) { const int c = col0 + bj * HALF + n * 4; gv[bj][n] = *(const f32x4*)(gate + c); if (ls) gv[bj][n] = gv[bj][n] * *(const f32x4*)(ls + c);
                gs[bj][n] = *(const f32x4*)(w2 + c) * (*(const f32x4*)(m4 + c) + 1.f); }
#pragma unroll
        for (int ai = 0; ai < 2; ++ai)
#pragma unroll
          for (int mp = 0; mp < 2; ++mp) {
            u32x4 xin[4][2]; float qiv[4];
#pragma unroll
            for (int m = 2 * mp; m < 2 * mp + 2; ++m) { const int row = row0 + ai * HALF + m * 16; qiv[m] = sxb[row];
                if (!srcf) { const bf16* rp = X + (size_t)row * DM + col0; xin[m][0] = *(const u32x4*)rp; xin[m][1] = *(const u32x4*)(rp + HALF); } }
#pragma unroll
            for (int m = 2 * mp; m < 2 * mp + 2; ++m) { const int row = row0 + ai * HALF + m * 16; bf16* rowp = X + (size_t)row * DM + col0; signed char* rowb = XQ + (size_t)row * DM + col0; float ss = 0.f;
                const unsigned soff = (unsigned)((row - pm * BM) * DM + col0);
                const float qi = 1.f / qiv[m];
#pragma unroll
                for (int bj = 0; bj < 2; ++bj) { u32x4* p = (u32x4*)(rowp + bj * HALF); f32x4 r0, r1;
                    if (srcf) { const f32x4* ps = (const f32x4*)(srcf + soff + bj * HALF); r0 = ps[0]; r1 = ps[1]; }
                    else { const u32x4 w = xin[m][bj]; r0 = bf4((u32x2){w.x, w.y}); r1 = bf4((u32x2){w.z, w.w}); }
                    const f32x4 x0 = r0 + acc[ai][bj][m][0] * gv[bj][0], x1 = r1 + acc[ai][bj][m][1] * gv[bj][1];
                    { u32x4 w; w.x = pk2(x0.x, x0.y); w.y = pk2(x0.z, x0.w); w.z = pk2(x1.x, x1.y); w.w = pk2(x1.z, x1.w); *p = w; }
                    ss += ((x0.x * x0.x + x0.y * x0.y) + (x0.z * x0.z + x0.w * x0.w)) + ((x1.x * x1.x + x1.y * x1.y) + (x1.z * x1.z + x1.w * x1.w));
                    const f32x4 h0 = x0 * gs[bj][0] * qi, h1 = x1 * gs[bj][1] * qi; int q[8] = {(int)__builtin_rintf(h0.x), (int)__builtin_rintf(h0.y), (int)__builtin_rintf(h0.z), (int)__builtin_rintf(h0.w), (int)__builtin_rintf(h1.x), (int)__builtin_rintf(h1.y), (int)__builtin_rintf(h1.z), (int)__builtin_rintf(h1.w)};
#pragma unroll
                    for (int e = 0; e < 8; ++e) q[e] = q[e] < -127 ? -127 : (q[e] > 127 ? 127 : q[e]);
                    u32x2 w; w.x = (unsigned)(q[0] & 255) | ((unsigned)(q[1] & 255) << 8) | ((unsigned)(q[2] & 255) << 16) | ((unsigned)(q[3] & 255) << 24);
                    w.y = (unsigned)(q[4] & 255) | ((unsigned)(q[5] & 255) << 8) | ((unsigned)(q[6] & 255) << 16) | ((unsigned)(q[7] & 255) << 24); *(u32x2*)(rowb + bj * HALF) = w; }
                ss += shx(ss, 16); ss += shx(ss, 32);
                if (fq == 0) ssq[(size_t)row * 32 + u.pn * 4 + wc] = ss; }
        }
    }
};
struct EpiBf16Q {
    static constexpr bool PERM = true, AFTER_DRAIN = false;
    bf16* O; int ldc; const float* sa; const unsigned* cmax;
    __device__ __forceinline__ void operator()(const f32x4 (&acc)[2][2][4][2], const Unit& u, int wr, int wc, int fr, int fq) const {
        const int row0 = u.pm * BM + wr * 64 + fr; const int col0 = u.pn * BM + wc * 32 + 8 * fq;
#pragma unroll
        for (int ai = 0; ai < 2; ++ai)
#pragma unroll
            for (int m = 0; m < 4; ++m) { const int row = row0 + ai * HALF + m * 16; bf16* rowp = O + (size_t)row * ldc + col0;
#pragma unroll
                for (int bj = 0; bj < 2; ++bj) { const f32x4 v0 = acc[ai][bj][m][0], v1 = acc[ai][bj][m][1];
                    u32x4 w; w.x = pk2(v0[0], v0[1]); w.y = pk2(v0[2], v0[3]); w.z = pk2(v1[0], v1[1]); w.w = pk2(v1[2], v1[3]);
                    *(u32x4*)(rowp + bj * HALF) = w; } }
    }
};
struct EpiPQ {
    static constexpr bool PERM = true, AFTER_DRAIN = false;
    bf16* O; const float* cvl; const LAS float* rs; const unsigned* cmax;
    __device__ __forceinline__ void operator()(const f32x4 (&acc)[2][2][4][2], const Unit& u, int wr, int wc, int fr, int fq) const {
        const int bb = u.pm / 17, isctx = (u.pm % 17) == 0; const float* cv = cvl + (size_t)(isctx ? 2 : bb) * DM;
        const int lrow0 = wr * 64 + fr; const int col0 = u.pn * BM + wc * 32 + 8 * fq;
        f32x4 c0[2], c1[2], s0[2], s1[2];
#pragma unroll
        for (int bj = 0; bj < 2; ++bj) { c0[bj] = *(const f32x4*)(cv + col0 + bj * HALF); c1[bj] = *(const f32x4*)(cv + col0 + bj * HALF + 4);
            const u32x4 a_ = *(const u32x4*)(cmax + col0 + bj * HALF), b_ = *(const u32x4*)(cmax + col0 + bj * HALF + 4);
            s0[bj] = (f32x4){__uint_as_float(a_.x), __uint_as_float(a_.y), __uint_as_float(a_.z), __uint_as_float(a_.w)} * (1.f / 127.f);
            s1[bj] = (f32x4){__uint_as_float(b_.x), __uint_as_float(b_.y), __uint_as_float(b_.z), __uint_as_float(b_.w)} * (1.f / 127.f); }
#pragma unroll
        for (int ai = 0; ai < 2; ++ai)
#pragma unroll
            for (int m = 0; m < 4; ++m) { const int lr = lrow0 + ai * HALF + m * 16; const float r = rs[lr]; bf16* rowp = O + (size_t)(u.pm * BM + lr) * DM + col0;
#pragma unroll
                for (int bj = 0; bj < 2; ++bj) { const f32x4 v0 = acc[ai][bj][m][0] * (s0[bj] * r) + c0[bj], v1 = acc[ai][bj][m][1] * (s1[bj] * r) + c1[bj];
                    u32x4 w; w.x = pk2(v0[0], v0[1]); w.y = pk2(v0[2], v0[3]); w.z = pk2(v1[0], v1[1]); w.w = pk2(v1[2], v1[3]);
                    *(u32x4*)(rowp + bj * HALF) = w; } }
    }
};

typedef int i32x4 __attribute__((ext_vector_type(4)));
typedef int i32x8 __attribute__((ext_vector_type(8)));
template <class Epi, class Sched, bool I8 = false, bool F8 = false>
__device__ __forceinline__ void gemm_phase(LAS unsigned char* lds, const Gemm g, const Sched& S, const Epi& E) {
    const int tid = opaque_tid(), wid = __builtin_amdgcn_readfirstlane(tid >> 6), lane = tid & 63, wr = wid >> 2, wc = wid & 3, fr = lane & 15, fq = lane >> 4;
    const int K = I8 ? g.K / 2 : g.K  , nt = K / BK;
    unsigned voffA[2], voffB[2];
#pragma unroll
    for (int i = 0; i < 2; ++i) { int R, C; stage_rc(tid * 16 + i * 8192, R, C); const int Rb = Epi::PERM ? ((R & ~31) + perm32(R & 31)) : R;
        voffA[i] = (unsigned)(R * K + C) * 2u; voffB[i] = (unsigned)(Rb * K + C) * 2u; }
    const size_t kstep = (size_t)(BK * 2);
    const size_t hstep = (size_t)HALF * K * 2;
    const size_t tstep = 2 * hstep;
    const unsigned ldsw = (unsigned)wid * 1024u;
    const int aoff = lds_byte(wr * 64 + fr, fq * 8), boff = lds_byte(wc * 32 + fr, fq * 8);
#define PG8_SA(b, h) (((b) * 2 + (h)) * HTB)
#define PG8_SB(b, h) ((4 + (b) * 2 + (h)) * HTB)
#define PG8_STAGE(bufoff, gbase, voff) do { _Pragma("unroll") for (int _i = 0; _i < 2; ++_i) \
        __builtin_amdgcn_global_load_lds((const unsigned*)((const char*)(gbase) + (voff)[_i]), (LAS unsigned*)(lds + (bufoff) + ldsw + _i * 8192), 16, 0, 0); } while (0)
#define PG8_LDA(dst, b, h) do { _Pragma("unroll") for (int m = 0; m < 4; ++m) { if constexpr (F8) { dst##8[m].lo = *(const LAS i32x4*)(lds + PG8_SA(b, h) + aoff + m * 2048); dst##8[m].hi = *(const LAS i32x4*)(lds + PG8_SA(b, h) + aoff + m * 2048 + 1024); } \
        else { _Pragma("unroll") for (int k = 0; k < 2; ++k) dst[m][k] = *(const LAS bf16x8*)(lds + PG8_SA(b, h) + aoff + m * 2048 + k * 1024); } } } while (0)
#define PG8_LDB(dst, b, h) do { _Pragma("unroll") for (int n = 0; n < 2; ++n) { if constexpr (F8) { dst##8[n].lo = *(const LAS i32x4*)(lds + PG8_SB(b, h) + boff + n * 2048); dst##8[n].hi = *(const LAS i32x4*)(lds + PG8_SB(b, h) + boff + n * 2048 + 1024); } \
        else { _Pragma("unroll") for (int k = 0; k < 2; ++k) dst[n][k] = *(const LAS bf16x8*)(lds + PG8_SB(b, h) + boff + n * 2048 + k * 1024); } } } while (0)
#define PG8_MMA(ai, bj, At, Bt) do { __builtin_amdgcn_s_setprio(1); _Pragma("unroll") for (int m = 0; m < 4; ++m) _Pragma("unroll") for (int n = 0; n < 2; ++n) { \
        if constexpr (F8) asm volatile("v_mfma_scale_f32_16x16x128_f8f6f4 %0, %1, %2, %0, %3, %4 op_sel_hi:[0,0,0]" : "+v"(acc[ai][bj][m][n]) : "v"(Bt##8[n]), "v"(At##8[m]), "v"(f8sw), "v"(f8sa)); \
        else _Pragma("unroll") for (int k = 0; k < 2; ++k) { \
        if constexpr (I8) acci[ai][bj][m][n] = __builtin_amdgcn_mfma_i32_16x16x64_i8(__builtin_bit_cast(i32x4, Bt[n][k]), __builtin_bit_cast(i32x4, At[m][k]), acci[ai][bj][m][n], 0, 0, 0); \
        else acc[ai][bj][m][n] = __builtin_amdgcn_mfma_f32_16x16x32_bf16(Bt[n][k], At[m][k], acc[ai][bj][m][n], 0, 0, 0); } } __builtin_amdgcn_s_setprio(0); } while (0)
#define PG8_WAIT_V(n) asm volatile("s_waitcnt vmcnt(" #n ")" ::: "memory")
#define PG8_WAIT_L(n) asm volatile("s_waitcnt lgkmcnt(" #n ")" ::: "memory")
#define PG8_BAR __builtin_amdgcn_s_barrier()
#define PG8_SCHED __builtin_amdgcn_sched_barrier(0)
    Unit cur, nxt; int ui = 0;
    if (!S.next(0, cur)) return;
    f32x4 acc[2][2][4][2]; i32x4 acci[2][2][4][2];
#pragma unroll
    for (int a = 0; a < 2; ++a)
#pragma unroll
        for (int b = 0; b < 2; ++b)
#pragma unroll
            for (int m = 0; m < 4; ++m)
#pragma unroll
                for (int n = 0; n < 2; ++n) { acc[a][b][m][n] = (f32x4){0.f, 0.f, 0.f, 0.f}; acci[a][b][m][n] = (i32x4){0, 0, 0, 0}; if constexpr (F8) asm volatile("" : "+v"(acc[a][b][m][n])); }
    bf16x8 At[4][2], B0[2][2], B1[2][2]; i32x8 At8[4], B08[2], B18[2];
    int f8sw = 127 - F8_WSHIFT, f8sa = 127 - F8_ASHIFT; (void)f8sw; (void)f8sa;
    const char* cA = (const char*)g.A + (size_t)cur.pm * tstep; const char* cB = (const char*)g.Bt + (size_t)cur.pn * tstep;
    S.a_ready(cur);
    PG8_STAGE(PG8_SB(0, 0), cB, voffB); PG8_STAGE(PG8_SA(0, 0), cA, voffA); PG8_STAGE(PG8_SB(0, 1), cB + hstep, voffB); PG8_STAGE(PG8_SA(0, 1), cA + hstep, voffA);
    if (wr == 1) PG8_BAR;
    PG8_WAIT_V(4); PG8_BAR;
    PG8_STAGE(PG8_SB(1, 0), cB + kstep, voffB); PG8_STAGE(PG8_SA(1, 0), cA + kstep, voffA); PG8_STAGE(PG8_SB(1, 1), cB + hstep + kstep, voffB);
    PG8_WAIT_V(6); PG8_BAR;
    for (;;) {
        const bool has_next = S.next(ui + 1, nxt);
        const char* nA = has_next ? (const char*)g.A + (size_t)nxt.pm * tstep : cA; const char* nB = has_next ? (const char*)g.Bt + (size_t)nxt.pn * tstep : cB;
        for (int t = 0; t < nt; t += 2) {
            const bool last = (t == nt - 2);
            const char* a1 = cA + (size_t)(t + 1) * kstep;
            const char* a2 = last ? nA : cA + (size_t)(t + 2) * kstep; const char* b2 = last ? nB : cB + (size_t)(t + 2) * kstep;
            const char* a3 = a2 + kstep; const char* b3 = b2 + kstep;
            if (last && has_next) S.a_ready(nxt);
            PG8_LDB(B0, 0, 0); PG8_SCHED; PG8_LDA(At, 0, 0); PG8_STAGE(PG8_SA(1, 1), a1 + hstep, voffA);
            PG8_WAIT_L(8); PG8_BAR; PG8_WAIT_L(0); PG8_MMA(0, 0, At, B0); PG8_BAR; PG8_SCHED;
            PG8_LDB(B1, 0, 1); PG8_STAGE(PG8_SB(0, 0), b2, voffB);
            PG8_BAR; PG8_WAIT_L(0); PG8_MMA(0, 1, At, B1); PG8_BAR;
            PG8_LDA(At, 0, 1); PG8_STAGE(PG8_SA(0, 0), a2, voffA);
            PG8_BAR; PG8_WAIT_L(0); PG8_MMA(1, 0, At, B0); PG8_BAR; PG8_SCHED;
            PG8_STAGE(PG8_SB(0, 1), b2 + hstep, voffB);
            PG8_WAIT_V(6); PG8_BAR; PG8_MMA(1, 1, At, B1); PG8_BAR;
            PG8_LDB(B0, 1, 0); PG8_SCHED; PG8_LDA(At, 1, 0); PG8_STAGE(PG8_SA(0, 1), a2 + hstep, voffA);
            PG8_WAIT_L(8); PG8_BAR; PG8_WAIT_L(0); PG8_MMA(0, 0, At, B0); PG8_BAR; PG8_SCHED;
            PG8_LDB(B1, 1, 1); PG8_STAGE(PG8_SB(1, 0), b3, voffB);
            PG8_BAR; PG8_WAIT_L(0); PG8_MMA(0, 1, At, B1); PG8_BAR;
            PG8_LDA(At, 1, 1); PG8_STAGE(PG8_SA(1, 0), a3, voffA);
            PG8_BAR; PG8_WAIT_L(0); PG8_MMA(1, 0, At, B0); PG8_BAR; PG8_SCHED;
            PG8_STAGE(PG8_SB(1, 1), b3 + hstep, voffB);
            PG8_WAIT_V(6); PG8_BAR; PG8_MMA(1, 1, At, B1); PG8_BAR;
        }
        if constexpr (F8) asm volatile("s_nop 15\n\ts_nop 15" ::: "memory");
        if constexpr (I8 && !F8) {
#pragma unroll
            for (int a = 0; a < 2; ++a)
#pragma unroll
                for (int b = 0; b < 2; ++b)
#pragma unroll
                    for (int m = 0; m < 4; ++m)
#pragma unroll
                        for (int n = 0; n < 2; ++n) acc[a][b][m][n] = __builtin_convertvector(acci[a][b][m][n], f32x4);
        }
        E(acc, cur, wr, wc, fr, fq); S.done(cur);
        if (!has_next) break;
#pragma unroll
        for (int a = 0; a < 2; ++a)
#pragma unroll
            for (int b = 0; b < 2; ++b)
#pragma unroll
                for (int m = 0; m < 4; ++m)
#pragma unroll
                    for (int n = 0; n < 2; ++n) { acc[a][b][m][n] = (f32x4){0.f, 0.f, 0.f, 0.f}; acci[a][b][m][n] = (i32x4){0, 0, 0, 0}; if constexpr (F8) asm volatile("" : "+v"(acc[a][b][m][n])); }
        cur = nxt; cA = nA; cB = nB; ++ui;
    }
    PG8_WAIT_V(0);
    if (wr == 0) PG8_BAR;
    PG8_BAR;
#undef PG8_SA
#undef PG8_SB
#undef PG8_STAGE
#undef PG8_LDA
#undef PG8_LDB
#undef PG8_MMA
#undef PG8_WAIT_V
#undef PG8_WAIT_L
#undef PG8_BAR
#undef PG8_SCHED
}
}

namespace att {
constexpr int D = 128, NW = 8, QBLK = 32, KVBLK = 64;
constexpr float SCALE = 0.088388347648318440f;
constexpr float THR = 8.f;
constexpr size_t SHM_V = KVBLK * D * 2, SHM_K = KVBLK * D * 2, SHM_ATTN = 2 * SHM_V + 2 * SHM_K + NW * 64 * 4;
#define KSWZ(row, colB) ((row) * 256 + ((colB) ^ (((row) & 7) << 4)))
#define SBAR() __builtin_amdgcn_sched_barrier(0)
__device__ __forceinline__ int crow(int r, int hi) { return (r & 3) + 8 * (r >> 2) + 4 * hi; }

__device__ __forceinline__ void partialSM(f32x16& p0, f32x16& p1, float& m_reg, float& mn, float& alpha) {
  constexpr float C = SCALE * 1.4426950408889634f;
  float pmax = p0[0];
#pragma unroll
  for (int r = 1; r < 16; ++r) pmax = fmaxf(pmax, p0[r]);
#pragma unroll
  for (int r = 0; r < 16; ++r) pmax = fmaxf(pmax, p1[r]);
  { auto rr = __builtin_amdgcn_permlane32_swap(__float_as_uint(pmax), __float_as_uint(pmax), false, false);
    pmax = fmaxf(__uint_as_float(rr[0]), __uint_as_float(rr[1])); }
  if (__builtin_expect(__all(pmax - m_reg <= THR / SCALE), 1)) { mn = m_reg; alpha = 1.f; }
  else { mn = fmaxf(m_reg, pmax); alpha = __builtin_amdgcn_exp2f((m_reg - mn) * C); m_reg = mn; }
  float mnC = -mn * C;
#pragma unroll
  for (int r = 0; r < 16; ++r) p0[r] = fmaf(p0[r], C, mnC);
#pragma unroll
  for (int r = 0; r < 16; ++r) p1[r] = fmaf(p1[r], C, mnC);
#pragma unroll
  for (int r = 0; r < 16; ++r) p0[r] = __builtin_amdgcn_exp2f(p0[r]);
}
__device__ __forceinline__ void finishSM(f32x16& p0, f32x16& p1, float alpha, float& l_reg, bf16x8& pa0, bf16x8& pa1, bf16x8& pa2, bf16x8& pa3) {
#pragma unroll
  for (int r = 0; r < 16; ++r) p1[r] = __builtin_amdgcn_exp2f(p1[r]);
  float ps = 0;
#pragma unroll
  for (int r = 0; r < 16; ++r) ps += p0[r];
#pragma unroll
  for (int r = 0; r < 16; ++r) ps += p1[r];
  { auto rr = __builtin_amdgcn_permlane32_swap(__float_as_uint(ps), __float_as_uint(ps), false, false);
    ps = __uint_as_float(rr[0]) + __uint_as_float(rr[1]); }
  l_reg = l_reg * alpha + ps;
#define PK4(P, BASE, OUT) do { unsigned a0 = pk2(P[BASE + 0], P[BASE + 1]), a1 = pk2(P[BASE + 2], P[BASE + 3]);   \
    unsigned b0 = pk2(P[BASE + 4], P[BASE + 5]), b1 = pk2(P[BASE + 6], P[BASE + 7]);                              \
    auto r0 = __builtin_amdgcn_permlane32_swap(a0, b0, false, false); auto r1 = __builtin_amdgcn_permlane32_swap(a1, b1, false, false); \
    u32x4 w = {r0[0], r1[0], r0[1], r1[1]}; OUT = *reinterpret_cast<bf16x8*>(&w); } while (0)
  PK4(p0, 0, pa0); PK4(p0, 8, pa1); PK4(p1, 0, pa2); PK4(p1, 8, pa3);
#undef PK4
}
__device__ __forceinline__ void qkt(f32x16& p0, f32x16& p1, const bf16* Ks, const bf16x8* qr, int r32, int hi) {
  p0 = f32x16{}; p1 = f32x16{};
#pragma unroll
  for (int d0 = 0; d0 < 8; ++d0) { int cb = (d0 * 16 + hi * 8) * 2;
    bf16x8 b0 = *reinterpret_cast<const bf16x8*>((const char*)Ks + KSWZ(r32, cb));
    bf16x8 b1 = *reinterpret_cast<const bf16x8*>((const char*)Ks + KSWZ(32 + r32, cb));
    p0 = __builtin_amdgcn_mfma_f32_32x32x16_bf16(b0, qr[d0], p0, 0, 0, 0);
    p1 = __builtin_amdgcn_mfma_f32_32x32x16_bf16(b1, qr[d0], p1, 0, 0, 0); }
}
typedef int ai32x4 __attribute__((ext_vector_type(4)));
typedef int ai32x8 __attribute__((ext_vector_type(8)));
#define K8ADDR(row, chunk) ((row) * 128 + ((((chunk) ^ ((row) & 7))) << 4))
__device__ __forceinline__ void qkt8(f32x16& p0, f32x16& p1, const f32x16& mC, const char* Ks, const ai32x8* q8, int r32, int hi) {
  p0 = mC; p1 = mC;
#pragma unroll
  for (int s = 0; s < 2; ++s) { const int c = s * 4 + hi * 2; ai32x8 k0, k1;
    k0.lo = *reinterpret_cast<const ai32x4*>(Ks + K8ADDR(r32, c)); k0.hi = *reinterpret_cast<const ai32x4*>(Ks + K8ADDR(r32, c + 1));
    k1.lo = *reinterpret_cast<const ai32x4*>(Ks + 4096 + K8ADDR(r32, c)); k1.hi = *reinterpret_cast<const ai32x4*>(Ks + 4096 + K8ADDR(r32, c + 1));
    p0 = __builtin_amdgcn_mfma_scale_f32_32x32x64_f8f6f4(k0, q8[s], p0, 0, 0, 0, 127, 0, 127);
    p1 = __builtin_amdgcn_mfma_scale_f32_32x32x64_f8f6f4(k1, q8[s], p1, 0, 0, 0, 127, 0, 127); SBAR(); }
}
constexpr float THR8 = 2.5f;
#define V8ADDR(row, chunk) ((row) * 64 + ((((chunk) ^ (((row) >> 2) & 3))) << 4))
__device__ __forceinline__ void partialSM8(f32x16& p0, f32x16& p1, f32x16& mC, float& alpha, const bool force) {
  constexpr float TP = THR8 * 1.4426950408889634f;
  float pmax = p0[0];
#pragma unroll
  for (int r = 1; r < 16; ++r) pmax = fmaxf(pmax, p0[r]);
#pragma unroll
  for (int r = 0; r < 16; ++r) pmax = fmaxf(pmax, p1[r]);
  { auto rr = __builtin_amdgcn_permlane32_swap(__float_as_uint(pmax), __float_as_uint(pmax), false, false);
    pmax = fmaxf(__uint_as_float(rr[0]), __uint_as_float(rr[1])); }
  const float draw = pmax - 5.f;
  if (!force && __builtin_expect(__all(draw <= TP), 1)) alpha = 1.f;
  else { const float delta = force ? draw : fmaxf(draw, 0.f); alpha = force ? 1.f : __builtin_amdgcn_exp2f(-delta);
#pragma unroll
    for (int r = 0; r < 16; ++r) { p0[r] -= delta; p1[r] -= delta; mC[r] -= delta; } }
#pragma unroll
  for (int r = 0; r < 16; ++r) p0[r] = __builtin_amdgcn_exp2f(p0[r]);
}
__device__ __forceinline__ void finishSM8(f32x16& p0, f32x16& p1, ai32x8& pf) {
#pragma unroll
  for (int r = 0; r < 16; ++r) p1[r] = __builtin_amdgcn_exp2f(p1[r]);
#pragma unroll
  for (int i = 0; i < 4; ++i) { pf[i] = (int)f8x4(p0[4 * i], p0[4 * i + 1], p0[4 * i + 2], p0[4 * i + 3]); pf[4 + i] = (int)f8x4(p1[4 * i], p1[4 * i + 1], p1[4 * i + 2], p1[4 * i + 3]); }
}
__device__ __forceinline__ void pv8(f32x16* o, f32x16& lacc, const ai32x8 ones, const char* Vs, const ai32x8 pf, int r32, int hi) {
  lacc = __builtin_amdgcn_mfma_scale_f32_32x32x64_f8f6f4(pf, ones, lacc, 0, 0, 0, 122, 0, 127);
#pragma unroll
  for (int d0 = 0; d0 < 4; ++d0) { const int row = d0 * 32 + r32; ai32x8 v;
    v.lo = *reinterpret_cast<const ai32x4*>(Vs + V8ADDR(row, 2 * hi)); v.hi = *reinterpret_cast<const ai32x4*>(Vs + V8ADDR(row, 2 * hi + 1));
    o[d0] = __builtin_amdgcn_mfma_scale_f32_32x32x64_f8f6f4(pf, v, o[d0], 0, 0, 0, 122, 0, 127); SBAR(); }
}
__device__ __forceinline__ int v_st(int k, int c) { const int kk = (k & ~0xC) | ((k & 4) << 1) | ((k & 8) >> 1); return ((kk >> 3) * 4 + (c >> 5)) * 512 + ((kk & 7) * 32 + (c & 31)) * 2; }
__device__ __forceinline__ int v_rd_base(int lane) { return ((lane & 3) << 3) | (((lane >> 2) & 3) << 6) | (((lane >> 4) & 1) << 5) | (((lane >> 5) & 1) << 8); }
constexpr int v_rd_off(int d0, int ks, int half) { return d0 * 512 + ks * 4096 + half * 2048; }
template <int OFF> __device__ __forceinline__ s16x4 tr_read(int vb) {
  s16x4 r; asm volatile("ds_read_b64_tr_b16 %0, %1 offset:%2" : "=&v"(r) : "v"(vb), "i"(OFF) : "memory"); return r;
}
template <int D0> __device__ __forceinline__ void pv_one(f32x16& od, int vb, bf16x8 pa0, bf16x8 pa1, bf16x8 pa2, bf16x8 pa3) {
  const s16x4 l0 = tr_read<v_rd_off(D0, 0, 0)>(vb), h0 = tr_read<v_rd_off(D0, 0, 1)>(vb), l1 = tr_read<v_rd_off(D0, 1, 0)>(vb), h1 = tr_read<v_rd_off(D0, 1, 1)>(vb);
  const s16x4 l2 = tr_read<v_rd_off(D0, 2, 0)>(vb), h2 = tr_read<v_rd_off(D0, 2, 1)>(vb), l3 = tr_read<v_rd_off(D0, 3, 0)>(vb), h3 = tr_read<v_rd_off(D0, 3, 1)>(vb);
  asm volatile("s_waitcnt lgkmcnt(0)" ::: "memory"); SBAR();
#define PK(L, H) (bf16x8){L[0], L[1], L[2], L[3], H[0], H[1], H[2], H[3]}
  od = __builtin_amdgcn_mfma_f32_32x32x16_bf16(pa0, PK(l0, h0), od, 0, 0, 0);
  od = __builtin_amdgcn_mfma_f32_32x32x16_bf16(pa1, PK(l1, h1), od, 0, 0, 0);
  od = __builtin_amdgcn_mfma_f32_32x32x16_bf16(pa2, PK(l2, h2), od, 0, 0, 0);
  od = __builtin_amdgcn_mfma_f32_32x32x16_bf16(pa3, PK(l3, h3), od, 0, 0, 0);
#undef PK
}
__device__ __forceinline__ void pv_d0(f32x16* o, int vb, bf16x8 pa0, bf16x8 pa1, bf16x8 pa2, bf16x8 pa3) {
  pv_one<0>(o[0], vb, pa0, pa1, pa2, pa3); pv_one<1>(o[1], vb, pa0, pa1, pa2, pa3); pv_one<2>(o[2], vb, pa0, pa1, pa2, pa3); pv_one<3>(o[3], vb, pa0, pa1, pa2, pa3);
}

template <int LD>
__device__ __forceinline__ void attn_body(const bf16* __restrict__ Qb, const unsigned char* __restrict__ K8h  , const unsigned char* __restrict__ V8h  , unsigned char* __restrict__ Ob,
                                          int NT, const float* __restrict__ qgain, int t0, char* lds) {
  const int tid = opaque_tid(), wid = tid >> 6, lane = tid & 63, r32 = lane & 31, hi = lane >> 5;
  bf16* V_lds = (bf16*)lds; bf16* K_lds = (bf16*)(lds + 2 * SHM_V);
  float* ws = (float*)(lds + 2 * SHM_V + 2 * SHM_K) + wid * 64; float* li_l = ws; float* al_l = ws + 32;
  f32x16 o[4] = {}, lacc = {}, mC; bf16x8 qr[8];
#pragma unroll
  for (int r = 0; r < 16; ++r) mC[r] = 5.f;
  ai32x8 ones; { int one4 = 0x38383838; asm volatile("" : "+v"(one4));
#pragma unroll
    for (int i = 0; i < 8; ++i) ones[i] = one4; }
  const bf16* Qw = Qb + (long)(wid * QBLK + r32) * LD + hi * 8;
#pragma unroll
  for (int d0 = 0; d0 < 8; ++d0) qr[d0] = *reinterpret_cast<const bf16x8*>(Qw + d0 * 16);
  if (qgain) {
    float ss = 0.f;
#pragma unroll
    for (int d0 = 0; d0 < 8; ++d0) { const u32x4 w = *reinterpret_cast<const u32x4*>(&qr[d0]); const unsigned ww[4] = {w.x, w.y, w.z, w.w};
#pragma unroll
      for (int j = 0; j < 4; ++j) { const float a_ = bflo(ww[j]), b_ = bfhi(ww[j]); ss += a_ * a_ + b_ * b_; } }
    { auto rr = __builtin_amdgcn_permlane32_swap(__float_as_uint(ss), __float_as_uint(ss), false, false); ss = __uint_as_float(rr[0]) + __uint_as_float(rr[1]); }
    const float rstd = 1.f / sqrtf(ss * (1.f / 128.f) + EPS);
    const int t = t0 + wid * QBLK + r32; const float prow = (float)(t >> 6), pcol = (float)(t & 63);
#pragma unroll
    for (int grp = 0; grp < 4; ++grp) {
      const int dA = (grp >> 1) * 4 + (grp & 1), dB = dA + 2, dd = grp & 1; const float pos = (grp >> 1) ? pcol : prow;
      const u32x4 wa = *reinterpret_cast<const u32x4*>(&qr[dA]), wb = *reinterpret_cast<const u32x4*>(&qr[dB]);
      const unsigned wwa[4] = {wa.x, wa.y, wa.z, wa.w}, wwb[4] = {wb.x, wb.y, wb.z, wb.w};
      const f32x4 ga0 = *(const f32x4*)(qgain + dA * 16 + hi * 8), ga1 = *(const f32x4*)(qgain + dA * 16 + hi * 8 + 4), gb0 = *(const f32x4*)(qgain + dB * 16 + hi * 8), gb1 = *(const f32x4*)(qgain + dB * 16 + hi * 8 + 4);
      const float gA[8] = {ga0.x, ga0.y, ga0.z, ga0.w, ga1.x, ga1.y, ga1.z, ga1.w}, gB[8] = {gb0.x, gb0.y, gb0.z, gb0.w, gb1.x, gb1.y, gb1.z, gb1.w};
      float oa[8], ob[8];
#pragma unroll
      for (int j = 0; j < 8; ++j) {
        const float y1 = ((j & 1) ? bfhi(wwa[j >> 1]) : bflo(wwa[j >> 1])) * rstd * gA[j], y2 = ((j & 1) ? bfhi(wwb[j >> 1]) : bflo(wwb[j >> 1])) * rstd * gB[j];
        float sn = 0.f, cs = 1.f;
        if (t0 >= 0) { const int i = dd * 16 + hi * 8 + j; const float inv = exp2f(-(float)(2 * i) * (1.f / 64.f) * 13.287712379549449f); sincos_rot(pos * inv, sn, cs); }
        oa[j] = y1 * cs - y2 * sn; ob[j] = y2 * cs + y1 * sn;
      }
      u32x4 w; w.x = pk2(oa[0], oa[1]); w.y = pk2(oa[2], oa[3]); w.z = pk2(oa[4], oa[5]); w.w = pk2(oa[6], oa[7]); qr[dA] = *reinterpret_cast<bf16x8*>(&w);
      w.x = pk2(ob[0], ob[1]); w.y = pk2(ob[2], ob[3]); w.z = pk2(ob[4], ob[5]); w.w = pk2(ob[6], ob[7]); qr[dB] = *reinterpret_cast<bf16x8*>(&w);
    }
  }
  ai32x8 q8[2];
#pragma unroll
  for (int s = 0; s < 2; ++s)
#pragma unroll
    for (int i = 0; i < 4; ++i) { const u32x4 w = *reinterpret_cast<const u32x4*>(&qr[4 * s + i]);
      constexpr float QC = SCALE * 1.4426950408889634f;
      q8[s][2 * i] = (int)f8x4(bflo(w.x) * QC, bfhi(w.x) * QC, bflo(w.y) * QC, bfhi(w.y) * QC); q8[s][2 * i + 1] = (int)f8x4(bflo(w.z) * QC, bfhi(w.z) * QC, bflo(w.w) * QC, bfhi(w.w) * QC); }
  const int widu = __builtin_amdgcn_readfirstlane(wid);
  const unsigned char* K8t = K8h + (long)(tid >> 3) * 512 + (((tid & 7) ^ ((tid >> 3) & 7)) << 4);
  const unsigned char* V8t = V8h + tid * 16;
  LAS unsigned char* Ld = (LAS unsigned char*)lds + widu * 1024;
#define DLOAD(t) do { const int t_ = (t); LAS unsigned char* d_ = Ld + (t_ & 3) * 16384;                                                   \
    __builtin_amdgcn_global_load_lds((const unsigned*)(V8t + (long)t_ * 8192), (LAS unsigned*)d_, 16, 0, 0);                             \
    __builtin_amdgcn_global_load_lds((const unsigned*)(K8t + (long)t_ * 64 * 512), (LAS unsigned*)(d_ + 8192), 16, 0, 0); } while (0)
#define DWAIT(more) do { if (more) asm volatile("s_waitcnt vmcnt(2)" ::: "memory"); else asm volatile("s_waitcnt vmcnt(0)" ::: "memory"); } while (0)
#define TBUF(t) ((const char*)lds + ((t) & 3) * 16384)
#define RESC(a) do { if (__any((a) < 1.f)) { if (hi == 0) al_l[r32] = (a); asm volatile("s_waitcnt lgkmcnt(0)" ::: "memory"); \
    _Pragma("unroll") for (int r = 0; r < 16; ++r) { const float al_ = al_l[crow(r, hi)]; lacc[r] *= al_; _Pragma("unroll") for (int d = 0; d < 4; ++d) o[d][r] *= al_; } } } while (0)
  f32x16 pA0, pA1, pB0, pB1; float alA, alB; ai32x8 pf;
  DLOAD(0); DLOAD(1);
  DWAIT(true); __syncthreads();
  qkt8(pA0, pA1, mC, TBUF(0) + 8192, q8, r32, hi); partialSM8(pA0, pA1, mC, alA, true);
  if (2 < NT) DLOAD(2);
  DWAIT(2 < NT); __syncthreads();
  for (int j = 1; j + 1 < NT; j += 2) {
    SBAR(); qkt8(pB0, pB1, mC, TBUF(j) + 8192, q8, r32, hi);
    finishSM8(pA0, pA1, pf); SBAR();
    pv8(o, lacc, ones, TBUF(j - 1), pf, r32, hi); partialSM8(pB0, pB1, mC, alB, false);
    DLOAD(j + 2); DWAIT(true);
    RESC(alB); __syncthreads();
    SBAR(); qkt8(pA0, pA1, mC, TBUF(j + 1) + 8192, q8, r32, hi);
    finishSM8(pB0, pB1, pf); SBAR();
    pv8(o, lacc, ones, TBUF(j), pf, r32, hi); partialSM8(pA0, pA1, mC, alA, false);
    if (j + 3 < NT) DLOAD(j + 3);
    DWAIT(j + 3 < NT);
    RESC(alA); __syncthreads();
  }
  SBAR(); qkt8(pB0, pB1, mC, TBUF(NT - 1) + 8192, q8, r32, hi);
  finishSM8(pA0, pA1, pf); SBAR();
  pv8(o, lacc, ones, TBUF(NT - 2), pf, r32, hi); partialSM8(pB0, pB1, mC, alB, false);
  RESC(alB);
  finishSM8(pB0, pB1, pf); SBAR();
  pv8(o, lacc, ones, TBUF(NT - 1), pf, r32, hi);
  float rli[16];
#pragma unroll
  for (int r = 0; r < 16; ++r) rli[r] = __builtin_amdgcn_rcpf(lacc[r]);
  unsigned char* Ow = Ob + (long)(wid * QBLK) * DM;
#pragma unroll
  for (int r = 0; r < 16; ++r) { const int orow = crow(r, hi); const float sc_ = rli[r] * F8_ASCALE;
    const unsigned w = f8x4(o[0][r] * sc_, o[1][r] * sc_, o[2][r] * sc_, o[3][r] * sc_);
#pragma unroll
    for (int d0 = 0; d0 < 4; ++d0) Ow[(long)orow * DM + d0 * 32 + r32] = (unsigned char)(w >> (8 * d0)); }
  __syncthreads();
#undef DLOAD
#undef DWAIT
#undef TBUF
#undef RESC
}
__device__ __forceinline__ void attn_na_body(const bf16* __restrict__ Qb, const bf16* __restrict__ Kh, const bf16* __restrict__ Vh, unsigned char* __restrict__ Ob,
                                             const int kr_lo, const int qrow0, const float* bl, const int NT, char* lds) {
  constexpr int LD = 6144;
  const int tid = opaque_tid(), wid = tid >> 6, lane = tid & 63, r32 = lane & 31, hi = lane >> 5;
  bf16* V_lds = (bf16*)lds; bf16* K_lds = (bf16*)(lds + 2 * SHM_V);
  float* ws = (float*)(lds + 2 * SHM_V + 2 * SHM_K) + wid * 64; float* li_l = ws; float* al_l = ws + 32;
  float m_reg = -1e30f, l_reg = 0; f32x16 o[4] = {}; bf16x8 qr[8];
  const bf16* Qw = Qb + (long)(wid * QBLK + r32) * LD + hi * 8;
#pragma unroll
  for (int d0 = 0; d0 < 8; ++d0) qr[d0] = *reinterpret_cast<const bf16x8*>(Qw + d0 * 16);
  const int sr = tid >> 4, sc = (tid & 15) * 8, vst0 = v_st(sr, sc), vst1 = v_st(32 + sr, sc);
  const int vb0 = (int)(uintptr_t)V_lds + v_rd_base(lane);
  const int widu = __builtin_amdgcn_readfirstlane(wid);
  const int qrow = qrow0 + (widu >> 1), qcol = (wid & 1) * 32 + r32;
  int r0 = qrow - 4; r0 = r0 < 0 ? 0 : (r0 > 56 ? 56 : r0);
  int c0 = qcol - 8; c0 = c0 < 0 ? 0 : (c0 > 48 ? 48 : c0);
  bf16x8 vs0, vs1, ks0, ks1;
#define NA_TROW(j) ((j) < 4 ? 64 * (j) : 256 + 64 * (kr_lo + (j) - 4))
#define NA_SLOAD(k0) do { const long _k = (k0); vs0 = *reinterpret_cast<const bf16x8*>(&Vh[(_k + sr) * LD + sc]); vs1 = *reinterpret_cast<const bf16x8*>(&Vh[(_k + 32 + sr) * LD + sc]); \
    ks0 = *reinterpret_cast<const bf16x8*>(&Kh[(_k + sr) * LD + sc]); ks1 = *reinterpret_cast<const bf16x8*>(&Kh[(_k + 32 + sr) * LD + sc]); } while (0)
  NA_SLOAD(NA_TROW(0));
  for (int j = 0; j < NT; ++j) {
    __syncthreads();
    *(bf16x8*)((char*)V_lds + vst0) = vs0; *(bf16x8*)((char*)V_lds + vst1) = vs1;
    *(bf16x8*)((char*)K_lds + KSWZ(sr, sc * 2)) = ks0; *(bf16x8*)((char*)K_lds + KSWZ(32 + sr, sc * 2)) = ks1;
    if (j + 1 < NT) NA_SLOAD(NA_TROW(j + 1));
    __syncthreads();
    const int kr = kr_lo + j - 4;
    const bool rowok = (j < 4) || ((unsigned)(kr - r0) < 8u);
    if (rowok) {
      f32x16 p0, p1; float mn, al; bf16x8 pa0, pa1, pa2, pa3;
      qkt(p0, p1, K_lds, qr, r32, hi);
      if (j >= 4) {
        const int bbase = (kr - qrow + 7) * 31 + 15 - qcol;
#pragma unroll
        for (int r = 0; r < 16; ++r) {
          const int kc0 = crow(r, hi), kc1 = 32 + kc0;
          const bool ok0 = (unsigned)(kc0 - c0) < 16u, ok1 = (unsigned)(kc1 - c0) < 16u;
          const float b0 = ok0 ? bl[bbase + kc0] : 0.f, b1 = ok1 ? bl[bbase + kc1] : 0.f;
          p0[r] = ok0 ? p0[r] + b0 : -1e30f; p1[r] = ok1 ? p1[r] + b1 : -1e30f;
        }
      }
      partialSM(p0, p1, m_reg, mn, al);
      if (__any(al < 1.f)) { if (hi == 0) al_l[r32] = al; asm volatile("s_waitcnt lgkmcnt(0)" ::: "memory");
#pragma unroll
        for (int d = 0; d < 4; ++d)
#pragma unroll
          for (int r = 0; r < 16; ++r) o[d][r] *= al_l[crow(r, hi)]; }
      finishSM(p0, p1, al, l_reg, pa0, pa1, pa2, pa3); SBAR();
      pv_d0(o, vb0, pa0, pa1, pa2, pa3);
    }
  }
  if (hi == 0) li_l[r32] = l_reg; asm volatile("s_waitcnt lgkmcnt(0)" ::: "memory");
  float rli[16];
#pragma unroll
  for (int r = 0; r < 16; ++r) rli[r] = __builtin_amdgcn_rcpf(li_l[crow(r, hi)]);
  unsigned char* Ow = Ob + (long)(wid * QBLK) * DM;
#pragma unroll
  for (int r = 0; r < 16; ++r) { const int orow = crow(r, hi); const float sc_ = rli[r] * F8_ASCALE;
    const unsigned w = f8x4(o[0][r] * sc_, o[1][r] * sc_, o[2][r] * sc_, o[3][r] * sc_);
#pragma unroll
    for (int d0 = 0; d0 < 4; ++d0) Ow[(long)orow * DM + d0 * 32 + r32] = (unsigned char)(w >> (8 * d0)); }
  __syncthreads();
#undef NA_TROW
#undef NA_SLOAD
}
}


struct CtxGemm { const void* A; int lda; size_t a_gstride; const void* Bt; size_t b_gstride; int K; int ncb, cb0, ngroups; int out_gcol; };
struct CtxEpi {
    bf16* O; int ldc;
    const float* sa; const unsigned* cmax; const float* ssq_in; const float* sxb_in; const float* cvec;
    bf16* xres; const float* gate; const float* ls; signed char* XQ; float* ssq; const float* w2; const float* m4; const float* sxb; const float* xsrc;
};
template <int RESID, bool I8, bool F8 = false>
__device__ __forceinline__ void ctx_gemm(const CtxGemm cg, int t0, int tstride, char* lds, const CtxEpi ce) {
    const int tid = opaque_tid(), wid = __builtin_amdgcn_readfirstlane(tid >> 6), lane = tid & 63, j32 = lane & 31, hi = lane >> 5;
    const int ntile = cg.ngroups * 8 * cg.ncb; const int ksl = cg.K / 8;
    constexpr int ES = I8 ? 1 : 2, KS = I8 ? 32 : 16;
    float* P = (float*)lds;
    if (t0 < 0) return;
    for (int t = t0; t < ntile; t += tstride) {
        const int g = t / (8 * cg.ncb), rr = t % (8 * cg.ncb), rb = rr / cg.ncb, cb = rr % cg.ncb;
        const int r0 = (rb >> 2) * RPB + (rb & 3) * 64, c0 = (cg.cb0 + cb) * 64;
        const char* Ap = (const char*)cg.A + ((size_t)g * cg.a_gstride + (size_t)(r0 + j32) * cg.lda + wid * ksl) * ES + hi * 16;
        const char* Bp = (const char*)cg.Bt + ((size_t)g * cg.b_gstride + (size_t)(c0 + j32) * cg.K + wid * ksl) * ES + hi * 16;
        const size_t a32 = (size_t)32 * cg.lda * ES, b32 = (size_t)32 * cg.K * ES;
        f32x16 acc[2][2]; typedef int i32x16 __attribute__((ext_vector_type(16))); i32x16 acci[2][2];
#pragma unroll
        for (int m = 0; m < 2; ++m)
#pragma unroll
            for (int n = 0; n < 2; ++n) { acc[m][n] = f32x16{}; acci[m][n] = i32x16{}; }
#pragma unroll 8
        for (int ks = 0; ks < ksl / KS; ++ks) {
            const bf16x8 a0 = *(const bf16x8*)(Ap + ks * 32), a1 = *(const bf16x8*)(Ap + a32 + ks * 32);
            const bf16x8 b0 = *(const bf16x8*)(Bp + ks * 32), b1 = *(const bf16x8*)(Bp + b32 + ks * 32);
            if constexpr (F8) {
                typedef long l64x2 __attribute__((ext_vector_type(2)));
                const l64x2 la0 = __builtin_bit_cast(l64x2, a0), la1 = __builtin_bit_cast(l64x2, a1), lb0 = __builtin_bit_cast(l64x2, b0), lb1 = __builtin_bit_cast(l64x2, b1);
#pragma unroll
                for (int z = 0; z < 2; ++z) {
                    acc[0][0] = __builtin_amdgcn_mfma_f32_32x32x16_fp8_fp8(la0[z], lb0[z], acc[0][0], 0, 0, 0); acc[0][1] = __builtin_amdgcn_mfma_f32_32x32x16_fp8_fp8(la0[z], lb1[z], acc[0][1], 0, 0, 0);
                    acc[1][0] = __builtin_amdgcn_mfma_f32_32x32x16_fp8_fp8(la1[z], lb0[z], acc[1][0], 0, 0, 0); acc[1][1] = __builtin_amdgcn_mfma_f32_32x32x16_fp8_fp8(la1[z], lb1[z], acc[1][1], 0, 0, 0); }
            } else if constexpr (I8) {
                const pg8::i32x4 ia0 = __builtin_bit_cast(pg8::i32x4, a0), ia1 = __builtin_bit_cast(pg8::i32x4, a1), ib0 = __builtin_bit_cast(pg8::i32x4, b0), ib1 = __builtin_bit_cast(pg8::i32x4, b1);
                acci[0][0] = __builtin_amdgcn_mfma_i32_32x32x32_i8(ia0, ib0, acci[0][0], 0, 0, 0); acci[0][1] = __builtin_amdgcn_mfma_i32_32x32x32_i8(ia0, ib1, acci[0][1], 0, 0, 0);
                acci[1][0] = __builtin_amdgcn_mfma_i32_32x32x32_i8(ia1, ib0, acci[1][0], 0, 0, 0); acci[1][1] = __builtin_amdgcn_mfma_i32_32x32x32_i8(ia1, ib1, acci[1][1], 0, 0, 0);
            } else {
                acc[0][0] = __builtin_amdgcn_mfma_f32_32x32x16_bf16(a0, b0, acc[0][0], 0, 0, 0); acc[0][1] = __builtin_amdgcn_mfma_f32_32x32x16_bf16(a0, b1, acc[0][1], 0, 0, 0);
                acc[1][0] = __builtin_amdgcn_mfma_f32_32x32x16_bf16(a1, b0, acc[1][0], 0, 0, 0); acc[1][1] = __builtin_amdgcn_mfma_f32_32x32x16_bf16(a1, b1, acc[1][1], 0, 0, 0);
            }
        }
#pragma unroll
        for (int m = 0; m < 2; ++m)
#pragma unroll
            for (int n = 0; n < 2; ++n)
#pragma unroll
                for (int r = 0; r < 16; ++r) P[(wid * 64 + m * 32 + att::crow(r, hi)) * 64 + n * 32 + j32] = (I8 && !F8) ? (float)acci[m][n][r] : acc[m][n][r];
        __syncthreads();
        { const int row = tid >> 3, c8 = (tid & 7) * 8; f32x4 s0 = {0.f, 0.f, 0.f, 0.f}, s1 = s0;
#pragma unroll
          for (int w = 0; w < 8; ++w) { const f32x4* pp = (const f32x4*)(P + (w * 64 + row) * 64 + c8); s0 += pp[0]; s1 += pp[1]; }
          const int orow = r0 + row, ocol = g * cg.out_gcol + c0 + c8;
          if (F8) { s0 = s0 * (1.f / (F8_ASCALE * F8_WSCALE)); s1 = s1 * (1.f / (F8_ASCALE * F8_WSCALE)); }
          if (RESID) { bf16* xp = ce.xres + (size_t)orow * DM + ocol; f32x4 g0 = *(const f32x4*)(ce.gate + ocol), g1 = *(const f32x4*)(ce.gate + ocol + 4);
              if (ce.ls) { g0 = g0 * *(const f32x4*)(ce.ls + ocol); g1 = g1 * *(const f32x4*)(ce.ls + ocol + 4); }
              f32x4 r0, r1;
              if (ce.xsrc) { const float* xs = ce.xsrc + ((size_t)((rb >> 2) * CTX + (rb & 3) * 64 + row) * DM + ocol); r0 = *(const f32x4*)xs; r1 = *(const f32x4*)(xs + 4); }
              else { const u32x4 w = *(const u32x4*)xp; r0 = bf4((u32x2){w.x, w.y}); r1 = bf4((u32x2){w.z, w.w}); }
              const f32x4 x0 = r0 + s0 * g0, x1 = r1 + s1 * g1;
              { u32x4 w; w.x = pk2(x0.x, x0.y); w.y = pk2(x0.z, x0.w); w.z = pk2(x1.x, x1.y); w.w = pk2(x1.z, x1.w); *(u32x4*)xp = w; }
              const float qi = 1.f / ce.sxb[orow];
              const f32x4 h0 = x0 * (*(const f32x4*)(ce.w2 + ocol) * (*(const f32x4*)(ce.m4 + ocol) + 1.f)) * qi, h1 = x1 * (*(const f32x4*)(ce.w2 + ocol + 4) * (*(const f32x4*)(ce.m4 + ocol + 4) + 1.f)) * qi;
              int q[8] = {(int)__builtin_rintf(h0.x), (int)__builtin_rintf(h0.y), (int)__builtin_rintf(h0.z), (int)__builtin_rintf(h0.w), (int)__builtin_rintf(h1.x), (int)__builtin_rintf(h1.y), (int)__builtin_rintf(h1.z), (int)__builtin_rintf(h1.w)};
#pragma unroll
              for (int e = 0; e < 8; ++e) q[e] = q[e] < -127 ? -127 : (q[e] > 127 ? 127 : q[e]);
              u32x2 w; w.x = (unsigned)(q[0] & 255) | ((unsigned)(q[1] & 255) << 8) | ((unsigned)(q[2] & 255) << 16) | ((unsigned)(q[3] & 255) << 24);
              w.y = (unsigned)(q[4] & 255) | ((unsigned)(q[5] & 255) << 8) | ((unsigned)(q[6] & 255) << 16) | ((unsigned)(q[7] & 255) << 24); *(u32x2*)(ce.XQ + (size_t)orow * DM + ocol) = w;
              float ss = ((x0.x * x0.x + x0.y * x0.y) + (x0.z * x0.z + x0.w * x0.w)) + ((x1.x * x1.x + x1.y * x1.y) + (x1.z * x1.z + x1.w * x1.w));
              ss += shx(ss, 1); ss += shx(ss, 2); ss += shx(ss, 4);
              if ((tid & 7) == 0) ce.ssq[(size_t)orow * 32 + g * cg.ncb + cb] = ss; }
          else { if (I8 && !F8) { float r = ce.sa ? ce.sa[orow] : 1.f;
                  if (ce.ssq_in) { float q = ce.ssq_in[(size_t)orow * 32 + (tid & 7) * 4] + ce.ssq_in[(size_t)orow * 32 + (tid & 7) * 4 + 1] + ce.ssq_in[(size_t)orow * 32 + (tid & 7) * 4 + 2] + ce.ssq_in[(size_t)orow * 32 + (tid & 7) * 4 + 3];
                      q += shx(q, 1); q += shx(q, 2); q += shx(q, 4); r = ce.sxb_in[orow] / sqrtf(q * (1.f / DM) + EPS); }
                  const u32x4 a_ = *(const u32x4*)(ce.cmax + ocol), b_ = *(const u32x4*)(ce.cmax + ocol + 4); r *= (1.f / 127.f);
                  s0 = s0 * ((f32x4){__uint_as_float(a_.x), __uint_as_float(a_.y), __uint_as_float(a_.z), __uint_as_float(a_.w)} * r);
                  s1 = s1 * ((f32x4){__uint_as_float(b_.x), __uint_as_float(b_.y), __uint_as_float(b_.z), __uint_as_float(b_.w)} * r);
                  if (ce.cvec) { s0 = s0 + *(const f32x4*)(ce.cvec + ocol); s1 = s1 + *(const f32x4*)(ce.cvec + ocol + 4); } }
              u32x4 w; w.x = pk2(s0.x, s0.y); w.y = pk2(s0.z, s0.w); w.z = pk2(s1.x, s1.y); w.w = pk2(s1.z, s1.w); *(u32x4*)(ce.O + (size_t)orow * ce.ldc + ocol) = w; } }
        __syncthreads();
    }
}

constexpr size_t MiB = 1u << 20;
constexpr size_t WS_CTL = 0, CTL_ZERO_BYTES = 1 * MiB;
constexpr size_t WS_MODV = 1 * MiB;
constexpr size_t WS_MODP = 2 * MiB;
constexpr size_t WS_X    = 22 * MiB;
constexpr size_t WS_H    = 92 * MiB;
constexpr size_t WS_QKV  = 128 * MiB;
constexpr size_t WS_O    = 232 * MiB;
constexpr size_t WS_PQ   = 268 * MiB;
constexpr size_t WS_IDX  = 304 * MiB;
constexpr size_t WS_GATE = 310 * MiB;
constexpr size_t WS_AWQKV = 316 * MiB;
constexpr size_t WS_AWO   = 340 * MiB;
constexpr size_t WS_BWQKV = 356 * MiB;
constexpr size_t WS_BWO   = 380 * MiB;
constexpr size_t WS_PW    = 388 * MiB;
constexpr size_t WS_PWQ   = 390 * MiB;
constexpr size_t WS_SK    = 422 * MiB;
constexpr size_t WS_SU    = 423 * MiB, WS_SV = WS_SU + 512 * 1024;
constexpr size_t WS_SSQ   = 314 * MiB + 512 * 1024;
constexpr size_t WS_SA    = WS_MODV + 768 * 1024;
constexpr size_t WS_CMAX  = 64 * 1024;
constexpr size_t WS_CVEC  = WS_MODV + 640 * 1024;
constexpr size_t WS_U     = 424 * MiB;
constexpr size_t WS_V     = 552 * MiB;
constexpr size_t WS_END   = 680 * MiB;

constexpr int LDS_BYTES = 147456;
constexpr int MISC_OFF = 131072 + 320;
constexpr int NPHASE = 2 + 4 * 9 + 1;

struct Args {
    const float *x, *c, *ctx, *c_ctx, *mod_w, *mod_b, *norm_w, *final_norm_w, *a_wqkv, *a_q_gain, *a_k_gain, *a_wo, *b_wqkv, *b_rpb, *b_wo, *pool_w, *pool_scale,
                *peer_wq, *peer_sub_keys, *peer_u, *peer_v;
    float* out; unsigned char* ws; int ph_lo, ph_hi;
};

__device__ __forceinline__ void p0_transpose_item(const float* W, int K, int N, bf16* WT, LAS float* scr, int item, int lane) {
    const int nblk = N / 32, kb = item / nblk, nb = item % nblk, k0 = 64 * kb, n0 = 32 * nb;
#pragma unroll
    for (int i = 0; i < 32; ++i) { const int kk = 2 * i + (lane >> 5); scr[kk * 33 + (lane & 31)] = W[(size_t)(k0 + kk) * N + n0 + (lane & 31)]; }
    asm volatile("s_waitcnt lgkmcnt(0)" ::: "memory");
    const int c = lane & 7;
#pragma unroll
    for (int j = 0; j < 4; ++j) { const int n = (lane >> 3) + 8 * j; const LAS float* s = scr + (8 * c) * 33 + n;
        u32x4 o; o.x = pk2(s[0 * 33], s[1 * 33]); o.y = pk2(s[2 * 33], s[3 * 33]); o.z = pk2(s[4 * 33], s[5 * 33]); o.w = pk2(s[6 * 33], s[7 * 33]);
        *(u32x4*)(WT + (size_t)(n0 + n) * K + k0 + 8 * c) = o; }
    asm volatile("s_waitcnt lgkmcnt(0)" ::: "memory");
}

__device__ __forceinline__ void p0_transpose_f8_item(const float* W, int K, int N, unsigned char* WT, LAS float* scr, int item, int lane) {
    const int nblk = N / 32, kb = item / nblk, nb = item % nblk, k0 = 64 * kb, n0 = 32 * nb;
#pragma unroll
    for (int i = 0; i < 32; ++i) { const int kk = 2 * i + (lane >> 5); scr[kk * 33 + (lane & 31)] = W[(size_t)(k0 + kk) * N + n0 + (lane & 31)]; }
    asm volatile("s_waitcnt lgkmcnt(0)" ::: "memory");
    const int c = lane & 7;
#pragma unroll
    for (int j = 0; j < 4; ++j) { const int n = (lane >> 3) + 8 * j; const LAS float* s = scr + (8 * c) * 33 + n;
        u32x2 o; o.x = f8x4(s[0 * 33] * F8_WSCALE, s[1 * 33] * F8_WSCALE, s[2 * 33] * F8_WSCALE, s[3 * 33] * F8_WSCALE); o.y = f8x4(s[4 * 33] * F8_WSCALE, s[5 * 33] * F8_WSCALE, s[6 * 33] * F8_WSCALE, s[7 * 33] * F8_WSCALE);
        *(u32x2*)(WT + (size_t)(n0 + n) * K + k0 + 8 * c) = o; }
    asm volatile("s_waitcnt lgkmcnt(0)" ::: "memory");
}

__device__ __forceinline__ void p0_colmax_item(const float* W, int N, unsigned* cmax, int item, int lane) {
    const int nblk = N / 32, kb = item / nblk, nb = item % nblk, k0 = 64 * kb, n0 = 32 * nb; float m = 0.f;
#pragma unroll
    for (int i = 0; i < 32; ++i) { const int kk = 2 * i + (lane >> 5); m = fmaxf(m, fabsf(W[(size_t)(k0 + kk) * N + n0 + (lane & 31)])); }
    m = fmaxf(m, shx(m, 32));
    if (lane < 32) atomicMax(cmax + n0 + lane, __float_as_uint(m));
}
__device__ __forceinline__ void p1_transpose_q_item(const float* W, int K, int N, signed char* WT, const unsigned* cmax, LAS float* scr, int item, int lane) {
    const int nblk = N / 32, kb = item / nblk, nb = item % nblk, k0 = 64 * kb, n0 = 32 * nb;
#pragma unroll
    for (int i = 0; i < 32; ++i) { const int kk = 2 * i + (lane >> 5); scr[kk * 33 + (lane & 31)] = W[(size_t)(k0 + kk) * N + n0 + (lane & 31)]; }
    asm volatile("s_waitcnt lgkmcnt(0)" ::: "memory");
    const int c = lane & 7;
#pragma unroll
    for (int j = 0; j < 4; ++j) { const int n = (lane >> 3) + 8 * j; const LAS float* sp = scr + (8 * c) * 33 + n; const float inv = 127.f / fmaxf(__uint_as_float(cmax[n0 + n]), 1e-30f);
        int q[8];
#pragma unroll
        for (int e = 0; e < 8; ++e) q[e] = (int)__builtin_rintf(sp[e * 33] * inv);
        u32x2 o; o.x = (unsigned)(q[0] & 255) | ((unsigned)(q[1] & 255) << 8) | ((unsigned)(q[2] & 255) << 16) | ((unsigned)(q[3] & 255) << 24);
        o.y = (unsigned)(q[4] & 255) | ((unsigned)(q[5] & 255) << 8) | ((unsigned)(q[6] & 255) << 16) | ((unsigned)(q[7] & 255) << 24);
        *(u32x2*)(WT + (size_t)(n0 + n) * K + k0 + 8 * c) = o; }
    asm volatile("s_waitcnt lgkmcnt(0)" ::: "memory");
}

template <bool XB16 = false, bool PRE = false>
__device__ __forceinline__ void norm_mod_row_q(const void* xrow  , const float* w, const float* shift, const float* scale, signed char* orow, float* sa, const float* w2, const float* m4, float* sxb, int lane) {
    f32x4 v[8]; float ss = 0.f;
#pragma unroll
    for (int j = 0; j < 8; ++j) { v[j] = PRE ? bf4(((const u32x2*)xrow)[j]) : (XB16 ? bf4(((const u32x2*)xrow)[lane + 64 * j]) : ((const f32x4*)xrow)[lane + 64 * j]); ss += (v[j].x * v[j].x + v[j].y * v[j].y) + (v[j].z * v[j].z + v[j].w * v[j].w); }
    const float rstd = 1.f / sqrtf(wave_sum(ss) * (1.f / DM) + EPS);
    float am = 0.f, am2 = 0.f;
#pragma unroll
    for (int j = 0; j < 8; ++j) { const int c = (lane + 64 * j) * 4;
        const f32x4 wv = *(const f32x4*)(w + c), sh = *(const f32x4*)(shift + c), sc = *(const f32x4*)(scale + c);
        if (sxb) { const f32x4 g2 = v[j] * (*(const f32x4*)(w2 + c) * (*(const f32x4*)(m4 + c) + 1.f)); am2 = fmaxf(am2, fmaxf(fmaxf(fabsf(g2.x), fabsf(g2.y)), fmaxf(fabsf(g2.z), fabsf(g2.w)))); }
        v[j] = (v[j] * rstd * wv) * (sc + 1.f) + sh; }
#pragma unroll
    for (int o = 1; o < 64; o <<= 1) am2 = fmaxf(am2, shx(am2, o));
    unsigned* o4 = (unsigned*)orow + lane;
#pragma unroll
    for (int j = 0; j < 8; ++j) o4[64 * j] = f8x4(v[j].x * F8_ASCALE, v[j].y * F8_ASCALE, v[j].z * F8_ASCALE, v[j].w * F8_ASCALE);
    (void)am; (void)sa;
    if (lane == 0 && sxb) *sxb = fmaxf(am2, 1e-30f) * (1.25f / 127.f);
}

__device__ __forceinline__ float gelu_tanh(float x) {
    const float z = 0.7978845608028654f * (x + 0.044715f * x * x * x);
    const float e = __expf(2.f * z);
    const float t = 1.f - 2.f / (1.f + e);
    return 0.5f * x * (1.f + t);
}

__device__ __forceinline__ unsigned mono(float f) { const unsigned u = __float_as_uint(f); return u ^ ((unsigned)((int)u >> 31) | 0x80000000u); }
__device__ __forceinline__ float unmono(unsigned m) { const unsigned u = (m & 0x80000000u) ? (m ^ 0x80000000u) : ~m; return __uint_as_float(u); }
#define CEX(a, b) do { const unsigned _h = (a) > (b) ? (a) : (b), _l = (a) > (b) ? (b) : (a); (a) = _h; (b) = _l; } while (0)
__device__ __forceinline__ void bmerge16_desc(unsigned (&t)[16]) {
#pragma unroll
    for (int d = 8; d >= 1; d >>= 1)
#pragma unroll
        for (int i = 0; i < 16; ++i) if ((i & d) == 0) CEX(t[i], t[i + d]);
}
__device__ __forceinline__ void sort16_desc(unsigned (&t)[16]) {
#pragma unroll
    for (int k = 2; k <= 16; k <<= 1)
#pragma unroll
        for (int j = k >> 1; j >= 1; j >>= 1)
#pragma unroll
            for (int i = 0; i < 16; ++i) { const int p = i ^ j; if (p > i) { if ((i & k) == 0) CEX(t[i], t[p]); else CEX(t[p], t[i]); } }
}
__device__ __forceinline__ void merge_top16(unsigned (&a)[16], const unsigned (&b)[16]) {
#pragma unroll
    for (int i = 0; i < 16; ++i) a[i] = a[i] > b[15 - i] ? a[i] : b[15 - i];
    bmerge16_desc(a);
}
#define INS16(L, x) do { unsigned _x = (x); _Pragma("unroll") for (int _j = 0; _j < 16; ++_j) { const unsigned _t = L[_j] > _x ? L[_j] : _x; _x = L[_j] > _x ? _x : L[_j]; L[_j] = _t; } } while (0)

typedef const __attribute__((address_space(4))) Args CArgs;
__global__ void __launch_bounds__(512, 2) fwd_kernel(Args a_kern) {
    CArgs& a = *(CArgs*)__builtin_amdgcn_kernarg_segment_ptr();
    extern __shared__ __attribute__((aligned(16))) unsigned char lds[];
    LAS unsigned char* L3 = (LAS unsigned char*)lds;
    volatile LAS unsigned* MISC = (volatile LAS unsigned*)(L3 + MISC_OFF);
    const int G = gridDim.x; const int bx = blockIdx.x; const int vcu = (G % 8 == 0) ? (bx % 8) * (G / 8) + bx / 8 : bx;
    const int NGW = G * 8;
    if (threadIdx.x < 32) MISC[threadIdx.x] = 0u;
    if ((threadIdx.x & 63) == 0) ((volatile LAS unsigned char*)L3)[TID_TABLE_OFF + hw_slot()] = (unsigned char)(threadIdx.x >> 6);
    __syncthreads();
    XcdBarrier bar; bar.bar = (unsigned*)(a.ws + WS_CTL) + 4096; bar.x = 0; bar.st = nullptr;
#if ONE_LAUNCH
    bar = xcd_barrier_post((unsigned*)(a.ws + WS_CTL) + 4096, MISC + 8);
#endif
    const int lo = a.ph_lo, hi_ph = a.ph_hi;
#define IN(k) (lo <= (k) && (k) < hi_ph)
#if ONE_LAUNCH
#define SEAM(k) do { if (IN(k) && IN((k) + 1)) xcd_barrier(bar); } while (0)
#else
#define SEAM(k) do { } while (0)
#endif
#define WS_LAUNDER() CArgs* ap_ = (CArgs*)__builtin_amdgcn_kernarg_segment_ptr(); asm volatile("" : "+s"(ap_)); CArgs& a = *ap_; GAS unsigned char* wsg_ = (GAS unsigned char*)a.ws; asm volatile("" : "+s"(wsg_)); unsigned char* wsl = (unsigned char*)wsg_;     const int tid = opaque_tid(), lane = tid & 63, wave = __builtin_amdgcn_readfirstlane(tid >> 6), gw = vcu * 8 + wave; (void)lane; (void)gw
#define modv  ((float*)(wsl + WS_MODV))
#define modp  ((float*)(wsl + WS_MODP))
#define X     ((bf16*)(wsl + WS_X))
#define H     ((bf16*)(wsl + WS_H))
#define QKV   ((bf16*)(wsl + WS_QKV))
#define OB    ((unsigned char*)(wsl + WS_O))
#define PQ    ((bf16*)(wsl + WS_PQ))
#define IDX   ((int*)(wsl + WS_IDX))
#define V8T   ((unsigned char*)(wsl + WS_IDX))
#define GATE  ((float*)(wsl + WS_GATE))
#define K8B   ((unsigned char*)(wsl + WS_GATE))
#define AWQKV ((bf16*)(wsl + WS_AWQKV))
#define AWO   ((unsigned char*)(wsl + WS_AWO))
#define BWQKV ((bf16*)(wsl + WS_BWQKV))
#define BWO   ((unsigned char*)(wsl + WS_BWO))
#define PW    ((unsigned char*)(wsl + WS_PW))
#define PWQ   ((bf16*)(wsl + WS_PWQ))
#define SK    ((bf16*)(wsl + WS_SK))
#define U8    ((unsigned char*)(wsl + WS_U))
#define V8    ((unsigned char*)(wsl + WS_V))
#define SU    ((float*)(wsl + WS_SU))
#define SV    ((float*)(wsl + WS_SV))
#define SSQ   ((float*)(wsl + WS_SSQ))
#define HQ    ((signed char*)(wsl + WS_H))
#define SA    ((float*)(wsl + WS_SA))
#define SXB   ((float*)(wsl + WS_SA) + MR)
#define CMAX  ((unsigned*)(wsl + WS_CMAX))
#define AWQKV8 ((signed char*)(wsl + WS_AWQKV))
#define BWQKV8 ((signed char*)(wsl + WS_BWQKV))
#define PWQ8  ((signed char*)(wsl + WS_PWQ))
#define CVEC  ((float*)(wsl + WS_CVEC))
    unsigned long long tacc = 0ull, tbeg = 0ull; (void)tbeg;
#define T0(b) do { if (TMON(b)) tbeg = __builtin_amdgcn_s_memrealtime(); } while (0)
#define T1(b) do { if (TMON(b)) tacc += __builtin_amdgcn_s_memrealtime() - tbeg; } while (0)
    T0(0);
    if (PHM(0) && IN(0)) { WS_LAUNDER();
        float* sm = (float*)lds;
        for (int it = bx; it < 4 * 6 * 32; it += G) {
            const int Lr = it / 192, r = it % 192, cc = r / 32, kc = r % 32;
            __syncthreads();
            if (tid < 192) { const int v = tid >> 6, k = kc * 64 + (tid & 63); const float cv = (v < 2) ? a.c[v * DM + k] : a.c_ctx[k]; sm[tid] = cv / (1.f + __expf(-cv)); }
            __syncthreads();
            const float* W = a.mod_w + ((size_t)Lr * DM + kc * 64) * NMOD + cc * 2048 + tid * 4;
            f32x4 a0 = {0.f, 0.f, 0.f, 0.f}, a1 = a0, a2 = a0;
#pragma unroll 8
            for (int k = 0; k < 64; ++k) { const f32x4 w = __builtin_nontemporal_load((const f32x4*)(W + (size_t)k * NMOD)); a0 += w * sm[k]; a1 += w * sm[64 + k]; a2 += w * sm[128 + k]; }
            float* P = modp + (((size_t)Lr * 32 + kc) * 3) * NMOD + cc * 2048 + tid * 4;
            *(f32x4*)P = a0; *(f32x4*)(P + NMOD) = a1; *(f32x4*)(P + 2 * NMOD) = a2;
        }
        __syncthreads();
        {
            for (int rr = gw; rr < 2 * 4 * NEXP; rr += 2 * NGW) {
                const int rB = rr + NGW; const bool hasB = rB < 2 * 4 * NEXP;
                const bool isuA = rr < 4 * NEXP, isuB = rB < 4 * NEXP; const int rA = isuA ? rr : rr - 4 * NEXP, rBq = hasB ? (isuB ? rB : rB - 4 * NEXP) : rA;
                const f32x4* srcA = (const f32x4*)((isuA ? a.peer_u : a.peer_v) + (size_t)rA * DM) + lane;
                const f32x4* srcB = (const f32x4*)(((hasB ? isuB : isuA) ? a.peer_u : a.peer_v) + (size_t)rBq * DM) + lane;
                f32x4 vA[8], vB[8]; float amA = 0.f, amB = 0.f;
#pragma unroll
                for (int j = 0; j < 8; ++j) { vA[j] = __builtin_nontemporal_load(srcA + 64 * j); vB[j] = __builtin_nontemporal_load(srcB + 64 * j); }
#pragma unroll
                for (int j = 0; j < 8; ++j) { amA = fmaxf(amA, fmaxf(fmaxf(fabsf(vA[j].x), fabsf(vA[j].y)), fmaxf(fabsf(vA[j].z), fabsf(vA[j].w))));
                    amB = fmaxf(amB, fmaxf(fmaxf(fabsf(vB[j].x), fabsf(vB[j].y)), fmaxf(fabsf(vB[j].z), fabsf(vB[j].w)))); }
#pragma unroll
                for (int o = 1; o < 64; o <<= 1) { amA = fmaxf(amA, shx(amA, o)); amB = fmaxf(amB, shx(amB, o)); }
#pragma unroll
                for (int half = 0; half < 2; ++half) {
                    if (half == 1 && !hasB) break;
                    const bool isu = half ? isuB : isuA; const int r = half ? rBq : rA; const float am = fmaxf(half ? amB : amA, 1e-30f);
                    const float inv = (isu ? 127.f : 440.f) / am;
                    unsigned* dst = (unsigned*)((isu ? U8 : V8) + (size_t)r * DM) + lane;
#pragma unroll
                    for (int j = 0; j < 8; ++j) { const f32x4 vv = half ? vB[j] : vA[j];
                        if (isu) { const int q0 = (int)__builtin_rintf(vv.x * inv), q1 = (int)__builtin_rintf(vv.y * inv), q2 = (int)__builtin_rintf(vv.z * inv), q3 = (int)__builtin_rintf(vv.w * inv);
                            dst[64 * j] = (unsigned)(q0 & 255) | ((unsigned)(q1 & 255) << 8) | ((unsigned)(q2 & 255) << 16) | ((unsigned)(q3 & 255) << 24); }
                        else { int w = 0; w = __builtin_amdgcn_cvt_pk_fp8_f32(vv.x * inv, vv.y * inv, w, false); w = __builtin_amdgcn_cvt_pk_fp8_f32(vv.z * inv, vv.w * inv, w, true); dst[64 * j] = (unsigned)w; } }
                    if (lane == 0) (isu ? SU : SV)[r] = am * (isu ? (1.f / 127.f) : (1.f / 440.f));
                }
            }
            const size_t gt = (size_t)bx * 512 + tid, nth = (size_t)G * 512;
            const size_t nk8 = (size_t)4 * 2 * 128 * 128 / 8;
            for (size_t i = gt; i < nk8; i += nth) {
                const f32x4* sp = (const f32x4*)(a.peer_sub_keys + i * 8); const f32x4 x0 = sp[0], x1 = sp[1];
                u32x4 o; o.x = pk2(x0.x, x0.y); o.y = pk2(x0.z, x0.w); o.z = pk2(x1.x, x1.y); o.w = pk2(x1.z, x1.w);
                *(u32x4*)(SK + i * 8) = o;
            }
        }
        {
            LAS float* scr = (LAS float*)(L3 + wave * 16384);
            constexpr int I_AQ = 32 * 96, I_AO = 32 * 64, I_BQ = 32 * 192, I_BO = 32 * 64, I_PW = 8 * 16, I_WQ = 32 * 64;
            constexpr int NIT = 2 * I_AO + I_BO + 4 * I_PW + 2 * I_AQ + I_BQ + 4 * I_WQ;
            for (int it = gw; it < NIT; it += NGW) {
                int r = it;
                if (r < 2 * I_AO) { const int j = r / I_AO; p0_transpose_f8_item(a.a_wo + (size_t)j * DM * DM, DM, DM, AWO + (size_t)j * DM * DM, scr, r % I_AO, lane); continue; } r -= 2 * I_AO;
                if (r < I_BO) { p0_transpose_f8_item(a.b_wo, DM, DM, BWO, scr, r, lane); continue; } r -= I_BO;
                if (r < 4 * I_PW) { const int j = r / I_PW; p0_transpose_f8_item(a.pool_w + (size_t)j * 512 * 512, 512, 512, PW + (size_t)j * 512 * 512, scr, r % I_PW, lane); continue; } r -= 4 * I_PW;
                if (r < 2 * I_AQ) { const int j = r / I_AQ; p0_transpose_f8_item(a.a_wqkv + (size_t)j * DM * 3072, DM, 3072, (unsigned char*)AWQKV8 + (size_t)j * 3072 * DM, scr, r % I_AQ, lane); continue; } r -= 2 * I_AQ;
                if (r < I_BQ) { p0_transpose_f8_item(a.b_wqkv, DM, 6144, (unsigned char*)BWQKV8, scr, r, lane); continue; } r -= I_BQ;
                { const int j = r / I_WQ; p0_colmax_item(a.peer_wq + (size_t)j * DM * DM, DM, CMAX + 12288 + j * DM, r % I_WQ, lane); }
            }
        }
    }
    SEAM(0); T1(0);
    T0(1);
    if (PHM(1) && IN(1)) { WS_LAUNDER();
        for (int i = bx * 512 + tid; i < 4 * 3 * NMOD; i += G * 512) {
            const int Lr = i / (3 * NMOD), r = i % (3 * NMOD), n = r % NMOD;
            float s = a.mod_b[Lr * NMOD + n];
            for (int kc = 0; kc < 32; ++kc) s += modp[((size_t)Lr * 32 + kc) * 3 * NMOD + r];
            modv[i] = s;
        }
        {
            LAS float* scr = (LAS float*)(L3 + wave * 16384);
            constexpr int I_WQ = 32 * 64; constexpr int NIT = 4 * I_WQ;
            for (int it = gw; it < NIT; it += NGW) {
                int r = it;
                { const int j = r / I_WQ; p1_transpose_q_item(a.peer_wq + (size_t)j * DM * DM, DM, DM, PWQ8 + (size_t)j * DM * DM, CMAX + 12288 + j * DM, scr, r % I_WQ, lane); }
            }
        }
    }
    SEAM(1); T1(1);

    for (int Lr = 0; Lr < 4; ++Lr) {
        const int kind = Lr % 3, jj = Lr / 3, pb = 2 + Lr * 9;
#define modl (modv + (size_t)Lr * 3 * NMOD)
        T0(2);
        if (Lr == 0 && MIXON(Lr) && PHM(2) && IN(pb + 0)) { WS_LAUNDER();
            const float* w = a.norm_w + (size_t)(Lr * 2 + 0) * DM;
            for (int row = gw; row < MR; row += NGW) { const int b = row / RPB, r = row % RPB, v = r < CTX ? 2 : b; const float* mv = modl + (size_t)v * NMOD;
                const float* srow = r < CTX ? a.ctx + ((size_t)b * CTX + r) * DM : a.x + ((size_t)b * SEQ + (r - CTX)) * DM;
                norm_mod_row_q(srow, w, mv + 0 * DM, mv + 1 * DM, HQ + (size_t)row * DM, SA + row, a.norm_w + (size_t)(Lr * 2 + 1) * DM, mv + 4 * DM, SXB + row, lane); }
            for (int task = gw; task < 4 * DM; task += NGW) {
                const int L4 = task / DM, n = task % DM; const u32x4* wr_ = (const u32x4*)(PWQ8 + ((size_t)L4 * DM + n) * DM) + lane; const float* m3b = modv + (size_t)L4 * 3 * NMOD + 3 * DM;
                float d0 = 0.f, d1 = 0.f, d2 = 0.f;
#pragma unroll
                for (int c = 0; c < 2; ++c) { const u32x4 wv = wr_[c * 64]; const unsigned ww[4] = {wv.x, wv.y, wv.z, wv.w}; const int k0 = c * 1024 + lane * 16;
#pragma unroll
                    for (int j = 0; j < 4; ++j)
#pragma unroll
                        for (int e = 0; e < 4; ++e) { const float wl = (float)(signed char)(ww[j] >> (8 * e)); const int k = k0 + 4 * j + e;
                            d0 += wl * m3b[k]; d1 += wl * m3b[NMOD + k]; d2 += wl * m3b[2 * NMOD + k]; } }
                { const float sbn = __uint_as_float(CMAX[12288 + L4 * DM + n]) * (1.f / 127.f); d0 = wave_sum(d0) * sbn; d1 = wave_sum(d1) * sbn; d2 = wave_sum(d2) * sbn; }
                if (lane == 0) { float* cv = CVEC + (size_t)L4 * 3 * DM + n; cv[0] = d0; cv[DM] = d1; cv[2 * DM] = d2; }
            }
        }
        if (Lr == 0) SEAM(pb + 0);
        T1(2);
        T0(3);
        if (MIXON(Lr) && PHM(3) && IN(pb + 1)) { WS_LAUNDER();
            if (kind != 2) { const int N = kind == 0 ? 3072 : 6144; const signed char* Wt = kind == 0 ? AWQKV8 + (size_t)jj * 3072 * DM : BWQKV8; const unsigned* cm = CMAX + (kind == 0 ? jj * 3072 : 6144);
                pg8::Gemm g{(const bf16*)HQ, (const bf16*)Wt, MR, N, DM};
                pg8::FlexOrder S; S.init(MR, N, G, bx, 2); pg8::EpiBf16Q E{QKV, N, SA, cm};
                pg8::gemm_phase<pg8::EpiBf16Q, pg8::FlexOrder, true, true>(L3, g, S, E);
                const CtxGemm cgm{HQ, DM, 0, Wt, 0, DM, Lr == 3 ? 16 : N / 64, Lr == 3 ? 32 : 0, 1, 0};
                const bool half = (N == 3072) && (G == 256);
                CtxEpi ce{}; ce.O = QKV; ce.ldc = N; ce.sa = SA; ce.cmax = cm;
                ctx_gemm<0, true, true>(cgm, half ? (bx >= 128 ? bx - 128 : -1) : vcu, half ? 128 : G, (char*)lds, ce); }
            else {
                for (int row = gw; row < MR; row += NGW) {
                    const int r = row % RPB; const int isl = r >= CTX; const int t = isl ? r - CTX : r, Ls = isl ? SEQ : CTX; const int row0 = row - t;
#pragma unroll
                    for (int g = 0; g < 4; ++g) {
                        const int w = 2 << g; int lo_ = t - w / 2; lo_ = lo_ < 0 ? 0 : lo_; int hi_ = t + w - w / 2; hi_ = hi_ > Ls ? Ls : hi_;
                        float s[8] = {0.f, 0.f, 0.f, 0.f, 0.f, 0.f, 0.f, 0.f};
                        for (int q = lo_; q < hi_; ++q) { const u32x2 hv = *(const u32x2*)(HQ + (size_t)(row0 + q) * DM + g * 512 + lane * 8);
                            const f32x2 a0 = __builtin_amdgcn_cvt_pk_f32_fp8((int)hv.x, false), a1 = __builtin_amdgcn_cvt_pk_f32_fp8((int)hv.x, true), a2 = __builtin_amdgcn_cvt_pk_f32_fp8((int)hv.y, false), a3 = __builtin_amdgcn_cvt_pk_f32_fp8((int)hv.y, true);
                            s[0] += a0.x; s[1] += a0.y; s[2] += a1.x; s[3] += a1.y; s[4] += a2.x; s[5] += a2.y; s[6] += a3.x; s[7] += a3.y; }
                        const u32x2 hs = *(const u32x2*)(HQ + (size_t)row * DM + g * 512 + lane * 8); const float ic = 1.f / (float)(hi_ - lo_); float hf[8];
                        { const f32x2 a0 = __builtin_amdgcn_cvt_pk_f32_fp8((int)hs.x, false), a1 = __builtin_amdgcn_cvt_pk_f32_fp8((int)hs.x, true), a2 = __builtin_amdgcn_cvt_pk_f32_fp8((int)hs.y, false), a3 = __builtin_amdgcn_cvt_pk_f32_fp8((int)hs.y, true);
                          hf[0] = a0.x; hf[1] = a0.y; hf[2] = a1.x; hf[3] = a1.y; hf[4] = a2.x; hf[5] = a2.y; hf[6] = a3.x; hf[7] = a3.y; }
                        u32x2 o; o.x = f8x4(s[0] * ic - hf[0], s[1] * ic - hf[1], s[2] * ic - hf[2], s[3] * ic - hf[3]);
                        o.y = f8x4(s[4] * ic - hf[4], s[5] * ic - hf[5], s[6] * ic - hf[6], s[7] * ic - hf[7]);
                        *(u32x2*)(OB + ((size_t)g * MR + row) * 512 + lane * 8) = o;
                    }
                }
            }
        }
        SEAM(pb + 1); T1(3);
        T0(4);
        if (MIXON(Lr) && PHM(4) && IN(pb + 2) && kind == 0) { WS_LAUNDER();
            const float* kg = a.a_k_gain + jj * 128;
            const int i = lane & 31, base = (lane >> 5) * 64;
            const float inv = exp2f(-(float)(2 * i) * (1.f / 64.f) * 13.287712379549449f);
            const float g1k = kg[base + i], g2k = kg[base + i + 32];
            for (int row0 = gw; row0 < MR; row0 += 5 * NGW) {
                float x1[5][4], x2[5][4];
#pragma unroll
                for (int n = 0; n < 5; ++n) { const int row = row0 + n * NGW; const bf16* p = QKV + (size_t)(row < MR ? row : row0) * 3072 + 2048;
#pragma unroll
                    for (int s = 0; s < 4; ++s) { const bf16* ph = p + s * 128 + base + i; x1[n][s] = bf2f(ph[0]); x2[n][s] = bf2f(ph[32]); } }
#pragma unroll
                for (int n = 0; n < 5; ++n) { const int row = row0 + n * NGW; if (row >= MR) break;
                    const int r = row % RPB; const bool isl = r >= CTX; const int t = r - CTX;
                    float cs = 1.f, sn = 0.f;
                    if (isl) { const float pos = (float)((lane < 32) ? (t >> 6) : (t & 63)); sincos_rot(pos * inv, sn, cs); }
                    float q2[4];
#pragma unroll
                    for (int s = 0; s < 4; ++s) q2[s] = x1[n][s] * x1[n][s] + x2[n][s] * x2[n][s];
#pragma unroll
                    for (int o = 1; o < 64; o <<= 1) {
#pragma unroll
                        for (int s = 0; s < 4; ++s) q2[s] += shx(q2[s], o); }
#pragma unroll
                    for (int s = 0; s < 4; ++s) { const float rstd = 1.f / sqrtf(q2[s] * (1.f / 128.f) + EPS);
                        const float y1 = x1[n][s] * rstd * g1k, y2 = x2[n][s] * rstd * g2k;
                        const int dA = base + i, dB = dA + 32; const unsigned w = f8x4(y1 * cs - y2 * sn, y2 * cs + y1 * sn, 0.f, 0.f);
                        unsigned char* kq = K8B + (size_t)row * 512 + s * 128;
                        kq[((dA >> 6) << 6) + (((dA >> 3) & 1) << 5) + (((dA >> 4) & 3) << 3) + (dA & 7)] = (unsigned char)w;
                        kq[((dB >> 6) << 6) + (((dB >> 3) & 1) << 5) + (((dB >> 4) & 3) << 3) + (dB & 7)] = (unsigned char)(w >> 8); } }
            }
            for (int it0 = gw; it0 < 136 * 4 * 8; it0 += 3 * NGW) {
                u32x4 w0[3], w1[3];
#pragma unroll
                for (int n = 0; n < 3; ++n) { const int it_ = it0 + n * NGW; const int it = it_ < 136 * 4 * 8 ? it_ : it0; const int dc = it & 7, kvh = (it >> 3) & 3, rt = it >> 5; const int row = rt * 64 + lane;
                    const u32x4* srcv = (const u32x4*)(QKV + (size_t)row * 3072 + 2560 + kvh * 128 + dc * 16); w0[n] = srcv[0]; w1[n] = srcv[1]; }
#pragma unroll
                for (int n = 0; n < 3; ++n) { const int it = it0 + n * NGW; if (it >= 136 * 4 * 8) break;
                    const int dc = it & 7, kvh = (it >> 3) & 3, rt = it >> 5;
                    const unsigned ww[8] = {w0[n].x, w0[n].y, w0[n].z, w0[n].w, w1[n].x, w1[n].y, w1[n].z, w1[n].w};
                    const int kk5 = lane & 31, p = ((kk5 >> 2) & 1) * 32 + (lane >> 5) * 16 + (kk5 & 3) + 4 * (kk5 >> 3);
                    unsigned char* img = V8T + ((size_t)((rt / 68) * 4 + kvh) * 68 + rt % 68) * 8192 + (p & 15);
#pragma unroll
                    for (int e = 0; e < 8; ++e) { const unsigned f = f8x4(bflo(ww[e]), bfhi(ww[e]), 0.f, 0.f); const int d = dc * 16 + 2 * e;
                        img[d * 64 + (((p >> 4) ^ ((d >> 2) & 3)) << 4)] = (unsigned char)f; img[(d + 1) * 64 + (((p >> 4) ^ (((d + 1) >> 2) & 3)) << 4)] = (unsigned char)(f >> 8); } }
            }
        }
        if (kind == 0) SEAM(pb + 2);
        T1(4);
        T0(5);
        if (MIXON(Lr) && PHM(5) && IN(pb + 3) && kind == 0) { WS_LAUNDER();
            for (int it = vcu; it < 512 + (Lr == 3 ? 0 : 32); it += G) {
                const bool isl = it < 512; const int q = isl ? it : it - 512;
                const int qb = isl ? (q & 15) : 0, h = isl ? ((q >> 4) & 15) : (q & 15), b = isl ? (q >> 8) : (q >> 4), kvh = h >> 2;
                const bf16* base = QKV + (size_t)b * RPB * 3072; const int qrow0 = isl ? CTX + qb * 256 : 0;
                att::attn_body<3072>(base + (size_t)qrow0 * 3072 + h * 128, K8B + (size_t)b * RPB * 512 + kvh * 128, V8T + (size_t)(b * 4 + kvh) * 68 * 8192, OB + ((size_t)b * RPB + qrow0) * DM + h * 128, isl ? 68 : 4, a.a_q_gain + jj * 128, isl ? qb * 256 : -1, (char*)lds);
            }
        }
        if (MIXON(Lr) && PHM(12) && IN(pb + 3) && kind == 1) { WS_LAUNDER();
            float* bl = (float*)((char*)lds + att::SHM_ATTN);
            for (int it = vcu; it < 512 + 32; it += G) {
                const bool isl = it < 512; const int q = isl ? it : it - 512;
                const int qb = isl ? (q & 15) : 0, h = isl ? ((q >> 4) & 15) : (q & 15), b = isl ? (q >> 8) : (q >> 4);
                int kr_lo = qb * 4 - 4; kr_lo = kr_lo < 0 ? 0 : (kr_lo > 52 ? 52 : kr_lo);
                { const float* rp = a.b_rpb + (size_t)h * 465; for (int z = tid; z < 465; z += 512) bl[z] = rp[z] * (1.f / att::SCALE); __syncthreads(); }
                const bf16* base = QKV + (size_t)b * RPB * 6144; const int qrow0 = isl ? CTX + qb * 256 : 0;
                att::attn_na_body(base + (size_t)qrow0 * 6144 + h * 128, base + 2048 + h * 128, base + 4096 + h * 128, OB + ((size_t)b * RPB + qrow0) * DM + h * 128, kr_lo, qb * 4, bl, isl ? 16 : 4, (char*)lds);
            }
        }
        if (kind != 2) SEAM(pb + 3);
        T1(5);
        T0(6);
        if (MIXON(Lr) && PHM(6) && IN(pb + 4)) { WS_LAUNDER();
            const bool grp = kind == 2;
            pg8::Gemm g{(const bf16*)OB, (const bf16*)(grp ? PW : (kind == 0 ? AWO + (size_t)jj * DM * DM : BWO)), grp ? 4 * MR : MR, DM, grp ? 512 : DM};
            pg8::FlexOrder S; S.init(MR, DM, G, bx, grp ? 3 : 2); pg8::EpiResid E{X, modl, 2 * DM, grp ? a.pool_scale : nullptr, grp ? 34 : (1 << 20), HQ, SSQ, a.norm_w + (size_t)(Lr * 2 + 1) * DM, SXB, Lr == 0 ? a.x : nullptr, a.ctx};
            pg8::gemm_phase<pg8::EpiResid, pg8::FlexOrder, true, true>(L3, g, S, E);
            if (Lr != 3) {
                const CtxGemm cgm{OB, grp ? 512 : DM, grp ? (size_t)MR * 512 : 0, g.Bt, grp ? (size_t)512 * 512 : 0, grp ? 512 : DM, grp ? 8 : 32, 0, grp ? 4 : 1, grp ? 512 : 0};
                CtxEpi ce{}; ce.xres = X; ce.gate = modl + (size_t)2 * NMOD + 2 * DM; ce.ls = grp ? a.pool_scale : nullptr; ce.XQ = HQ; ce.ssq = SSQ; ce.w2 = a.norm_w + (size_t)(Lr * 2 + 1) * DM; ce.m4 = modl + (size_t)2 * NMOD + 4 * DM; ce.sxb = SXB; ce.xsrc = Lr == 0 ? a.ctx : nullptr;
                ctx_gemm<1, true, true>(cgm, vcu, G, (char*)lds, ce); }
        }
        SEAM(pb + 4); T1(6);
        T0(7);
        T1(7);
        T0(8);
        if (PEERON(Lr) && PHM(8) && IN(pb + 6)) { WS_LAUNDER();
            const signed char* Wt = PWQ8 + (size_t)Lr * DM * DM; const unsigned* cm = CMAX + 12288 + Lr * DM;
            pg8::Gemm g{(const bf16*)HQ, (const bf16*)Wt, MR, DM, DM}; pg8::FlexOrder S; S.init(MR, DM, G, bx, 2);
            LAS float* rs = (LAS float*)(L3 + 133120);
            { pg8::Unit u0; if (S.next(0, u0) && tid < 256) { const int row = u0.pm * 256 + tid; const float* q = SSQ + (size_t)row * 32; float t = 0.f;
#pragma unroll
                  for (int z = 0; z < 32; ++z) t += q[z];
                  rs[tid] = SXB[row] / sqrtf(t * (1.f / DM) + EPS); }
              __syncthreads(); }
            pg8::EpiPQ E{PQ, CVEC + (size_t)Lr * 3 * DM, rs, cm};
            pg8::gemm_phase<pg8::EpiPQ, pg8::FlexOrder, true>(L3, g, S, E);
            if (Lr != 3) { const CtxGemm cgm{HQ, DM, 0, Wt, 0, DM, 32, 0, 1, 0};
                CtxEpi ce{}; ce.O = PQ; ce.ldc = DM; ce.cmax = cm; ce.ssq_in = SSQ; ce.sxb_in = SXB; ce.cvec = CVEC + (size_t)(Lr * 3 + 2) * DM;
                ctx_gemm<0, true>(cgm, vcu, G, (char*)lds, ce); }
        }
        SEAM(pb + 6); T1(8);
        T0(9);

        T1(9);
        T0(10);
        if (PEERON(Lr) && PHM(10) && IN(pb + 8)) { WS_LAUNDER();
            constexpr int NS = 5, RSZ = RSZ_A, RSZB = RSZ_B;
            const GAS unsigned char* Ul = (const GAS unsigned char*)(U8 + (size_t)Lr * NEXP * DM); const GAS unsigned char* Vl = (const GAS unsigned char*)(V8 + (size_t)Lr * NEXP * DM);
            const GAS float* sul = (const GAS float*)(SU + (size_t)Lr * NEXP); const GAS float* svl = (const GAS float*)(SV + (size_t)Lr * NEXP);
            const int myx = ((lane & 1) << 2) | (lane & 2) | ((lane >> 2) & 1);
            const bool last = Lr == 3;
            const int TPB = last ? 32 : 34;
            {
            const int j32 = lane & 31, hi = lane >> 5;
            { const bf16* skg = SK + (size_t)Lr * 2 * 128 * 128;
              for (int c = tid; c < 256 * 16; c += 512) { const int row = c >> 4, ch = c & 15; *(u32x4*)((char*)lds + row * 256 + ((ch ^ (row & 7)) << 4)) = *(const u32x4*)(skg + (size_t)row * 128 + ch * 8); }
              __syncthreads(); }
            int* IDXL = (int*)((char*)lds + 65536); float* GATEL = (float*)((char*)lds + 65536 + 34 * 128 * 4);
            for (int task = wave; task < (TPB * 8 + 31) / 32; task += 8) {
                const int pidx = task * 32 + j32; const bool pvalid = pidx < TPB * 8; const int pc = pvalid ? pidx : TPB * 8 - 1;
                const int tl = pc >> 3, h = pc & 7; const int tgq = vcu * TPB + tl; const int tok = last ? tgq + 256 * (1 + tgq / 4096) : tgq;
                const bf16* qrow = PQ + (size_t)tok * DM + h * 256;
                bf16x8 qv[16];
#pragma unroll
                for (int ks = 0; ks < 8; ++ks) { qv[ks] = *(const bf16x8*)(qrow + ks * 16 + hi * 8); qv[8 + ks] = *(const bf16x8*)(qrow + 128 + ks * 16 + hi * 8); }
                f32x16 p1[4], p2[4];
#pragma unroll
                for (int kt = 0; kt < 4; ++kt) { p1[kt] = f32x16{}; p2[kt] = f32x16{}; }
#pragma unroll
                for (int ks = 0; ks < 8; ++ks) {
                    const int chb = ks * 2 + hi;
#pragma unroll
                    for (int kt = 0; kt < 4; ++kt) {
                        const int r1 = kt * 32 + j32, r2 = 128 + kt * 32 + j32;
                        const bf16x8 k1 = *(const bf16x8*)((const char*)lds + r1 * 256 + ((chb ^ (r1 & 7)) << 4));
                        const bf16x8 k2 = *(const bf16x8*)((const char*)lds + r2 * 256 + ((chb ^ (r2 & 7)) << 4));
                        p1[kt] = __builtin_amdgcn_mfma_f32_32x32x16_bf16(k1, qv[ks], p1[kt], 0, 0, 0);
                        p2[kt] = __builtin_amdgcn_mfma_f32_32x32x16_bf16(k2, qv[8 + ks], p2[kt], 0, 0, 0);
                    }
                }
                unsigned Lt[16];
#pragma unroll
                for (int kt = 0; kt < 4; ++kt) {
                    unsigned ta[16], tb[16];
#pragma unroll
                    for (int r = 0; r < 16; ++r) {
                        auto rr = __builtin_amdgcn_permlane32_swap(__float_as_uint(p1[kt][r]), __float_as_uint(p2[kt][r]), false, false);
                        ta[r] = (mono(__uint_as_float(rr[0])) & 0xFFFFFF80u) | (unsigned)(kt * 32 + att::crow(r, 0));
                        tb[r] = (mono(__uint_as_float(rr[1])) & 0xFFFFFF80u) | (unsigned)(kt * 32 + att::crow(r, 1));
                    }
                    sort16_desc(ta); sort16_desc(tb);
                    if (kt == 0) {
#pragma unroll
                        for (int q = 0; q < 16; ++q) Lt[q] = ta[q];
                    } else merge_top16(Lt, ta);
                    merge_top16(Lt, tb);
                }
                unsigned L1[16], L2[16]; float v1[16], v2[16];
#pragma unroll
                for (int q = 0; q < 16; ++q) { auto rr = __builtin_amdgcn_permlane32_swap(Lt[q], Lt[q], false, false); L1[q] = rr[0]; L2[q] = rr[1];
                    v1[q] = unmono(L1[q] & 0xFFFFFF80u); v2[q] = unmono(L2[q] & 0xFFFFFF80u); }
#define CK(ia, ib) ((mono(v1[ia] + v2[ib]) & 0xFFFFFF00u) | (unsigned)((ia) * 16 + (ib)))
                unsigned Cd[16];
#pragma unroll
                for (int q = 0; q < 16; ++q) Cd[q] = CK(0, q);
                { unsigned t[16];
#pragma unroll
                  for (int q = 0; q < 8; ++q) { t[q] = CK(1, q); t[8 + q] = CK(15 - q, 0); }
                  bmerge16_desc(t); merge_top16(Cd, t); }
                { unsigned t[16] = {CK(2, 0), CK(2, 1), CK(2, 2), CK(2, 3), CK(2, 4), CK(3, 0), CK(3, 1), CK(3, 2), CK(3, 3), CK(4, 0), CK(4, 1), CK(4, 2), CK(5, 0), CK(5, 1), CK(6, 0), CK(6, 1)};
                  sort16_desc(t); merge_top16(Cd, t); }
                INS16(Cd, CK(7, 0)); INS16(Cd, CK(7, 1));
#undef CK
                unsigned P1[4] = {0u, 0u, 0u, 0u}, P2[4] = {0u, 0u, 0u, 0u};
#pragma unroll
                for (int q = 0; q < 16; ++q) { P1[q >> 2] |= (L1[q] & 127u) << (8 * (q & 3)); P2[q >> 2] |= (L2[q] & 127u) << (8 * (q & 3)); }
                int eid[16];
#pragma unroll
                for (int q = 0; q < 16; ++q) {
                    const unsigned ia = (Cd[q] >> 4) & 15u, ib = Cd[q] & 15u;
                    const unsigned w1 = (ia >> 2) == 0 ? P1[0] : ((ia >> 2) == 1 ? P1[1] : ((ia >> 2) == 2 ? P1[2] : P1[3]));
                    const unsigned w2 = (ib >> 2) == 0 ? P2[0] : ((ib >> 2) == 1 ? P2[1] : ((ib >> 2) == 2 ? P2[2] : P2[3]));
                    eid[q] = (int)(((w1 >> (8 * (ia & 3))) & 127u) * 128u + ((w2 >> (8 * (ib & 3))) & 127u));
                }
                {
                    const float mx = unmono(Cd[0] & 0xFFFFFF00u); float ev[16], su = 0.f;
#pragma unroll
                    for (int q = 0; q < 16; ++q) { ev[q] = __expf(unmono(Cd[q] & 0xFFFFFF00u) - mx); su += ev[q]; }
                    const float inv = 1.f / su;
                    if (hi == 0 && pvalid) {
                        int* ip = IDXL + tl * 128 + h * 16; float* gp = GATEL + tl * 128 + h * 16;
#pragma unroll
                        for (int q = 0; q < 16; ++q) { ip[q] = eid[q]; gp[q] = ev[q] * inv; }
                    }
                }
            }
            }
            __syncthreads();
            const int* IDXL = (const int*)((const char*)lds + 65536); const float* GATEL = (const float*)((const char*)lds + 65536 + 34 * 128 * 4);
            int rowS[NS]; unsigned ka[NS], kb_[NS]; float ga[NS], gb[NS], cfa[NS], cfb[NS], sxs[NS]; int xq[NS][8]; int pos[NS], pbeg[NS], pend[NS];
#pragma unroll
            for (int sl = 0; sl < NS; ++sl) {
                const int ti = sl < 4 ? wave + 8 * sl : 32 + (wave >> 2);
                const bool have = sl < 4 || !last; const int tg = vcu * TPB + (have ? ti : 0);
                const int row = last ? tg + 256 * (1 + tg / 4096) : tg; rowS[sl] = have ? row : -1;
                pbeg[sl] = !have ? 128 : (sl < 4 ? 0 : 32 * (wave & 3)); pend[sl] = !have ? 128 : (sl < 4 ? 128 : 32 * (wave & 3) + 32);
                const int til = have ? ti : 0;
                unsigned k0 = ((unsigned)IDXL[til * 128 + lane] << 7) | (unsigned)lane, k1 = ((unsigned)IDXL[til * 128 + 64 + lane] << 7) | (unsigned)(64 + lane);
                const float g0 = GATEL[til * 128 + lane], g1 = GATEL[til * 128 + 64 + lane];
#pragma unroll
                for (int k = 2; k <= 128; k <<= 1)
#pragma unroll
                    for (int j = k >> 1; j > 0; j >>= 1) {
                        if (j == 64) { const unsigned lo_ = k0 < k1 ? k0 : k1, hi_ = k0 < k1 ? k1 : k0; k0 = lo_; k1 = hi_; }
                        else { const bool lower = (lane & j) == 0; const bool up0 = (lane & k) == 0, up1 = ((lane + 64) & k) == 0;
                            const unsigned o0 = (unsigned)(j == 1 ? lane_xor<1>((int)k0, lane) : j == 2 ? lane_xor<2>((int)k0, lane) : j == 4 ? lane_xor<4>((int)k0, lane) : j == 8 ? lane_xor<8>((int)k0, lane) : j == 16 ? lane_xor<16>((int)k0, lane) : lane_xor<32>((int)k0, lane));
                            const unsigned o1 = (unsigned)(j == 1 ? lane_xor<1>((int)k1, lane) : j == 2 ? lane_xor<2>((int)k1, lane) : j == 4 ? lane_xor<4>((int)k1, lane) : j == 8 ? lane_xor<8>((int)k1, lane) : j == 16 ? lane_xor<16>((int)k1, lane) : lane_xor<32>((int)k1, lane));
                            const unsigned mn0 = k0 < o0 ? k0 : o0, mx0 = k0 < o0 ? o0 : k0, mn1 = k1 < o1 ? k1 : o1, mx1 = k1 < o1 ? o1 : k1;
                            k0 = (lower == up0) ? mn0 : mx0; k1 = (lower == up1) ? mn1 : mx1; }
                    }
                { const int o0 = (int)(k0 & 127u), o1 = (int)(k1 & 127u);
                  const float a0 = __shfl(g0, o0 & 63), b0 = __shfl(g1, o0 & 63), a1 = __shfl(g0, o1 & 63), b1 = __shfl(g1, o1 & 63);
                  ga[sl] = o0 < 64 ? a0 : b0; gb[sl] = o1 < 64 ? a1 : b1; }
                ka[sl] = k0; kb_[sl] = k1; cfa[sl] = 0.f; cfb[sl] = 0.f; pos[sl] = pbeg[sl];
                float xf[32];
                { const int bq = row / RPB, rq = row % RPB, vq = rq < CTX ? 2 : bq; const float* mq = modl + (size_t)vq * NMOD; const float* w2 = a.norm_w + (size_t)(Lr * 2 + 1) * DM;
                  float t = lane < 32 ? SSQ[(size_t)row * 32 + lane] : 0.f; t = wave_sum(t); const float rstd = 1.f / sqrtf(t * (1.f / DM) + EPS);
#pragma unroll
                  for (int hf = 0; hf < 2; ++hf)
#pragma unroll
                      for (int q = 0; q < 4; ++q) { const int c = hf * 1024 + lane * 16 + q * 4;
                          const f32x4 xv = bf4(*(const u32x2*)(X + (size_t)row * DM + c)), wv = *(const f32x4*)(w2 + c), sc = *(const f32x4*)(mq + 4 * DM + c), sh = *(const f32x4*)(mq + 3 * DM + c);
                          const f32x4 f = (xv * rstd * wv) * (sc + 1.f) + sh; xf[hf * 16 + q * 4 + 0] = f.x; xf[hf * 16 + q * 4 + 1] = f.y; xf[hf * 16 + q * 4 + 2] = f.z; xf[hf * 16 + q * 4 + 3] = f.w; } }
                float am = 0.f;
#pragma unroll
                for (int q = 0; q < 32; ++q) am = fmaxf(am, fabsf(xf[q]));
#pragma unroll
                for (int o = 1; o < 64; o <<= 1) am = fmaxf(am, shx(am, o));
                am = fmaxf(am, 1e-30f); const float xinv = 127.f / am; sxs[sl] = am * (1.f / 127.f);
#pragma unroll
                for (int q = 0; q < 8; ++q) { const int q0 = (int)__builtin_rintf(xf[4 * q] * xinv), q1 = (int)__builtin_rintf(xf[4 * q + 1] * xinv), q2 = (int)__builtin_rintf(xf[4 * q + 2] * xinv), q3 = (int)__builtin_rintf(xf[4 * q + 3] * xinv);
                    xq[sl][q] = (int)((unsigned)(q0 & 255) | ((unsigned)(q1 & 255) << 8) | ((unsigned)(q2 & 255) << 16) | ((unsigned)(q3 & 255) << 24)); }
            }
            asm volatile("s_waitcnt vmcnt(0)" ::: "memory");
            __syncthreads();
            for (int hi_e = RSZ; hi_e <= NEXP; hi_e += RSZ) {
#pragma unroll
                for (int sl = 0; sl < NS; ++sl) {
                    while (pos[sl] < pend[sl] && (int)((unsigned)__builtin_amdgcn_readlane((int)(pos[sl] < 64 ? ka[sl] : kb_[sl]), pos[sl] & 63) >> 7) < hi_e) {
                        const int p0 = pos[sl]; const unsigned ksrc = p0 < 64 ? ka[sl] : kb_[sl]; const float gsrc = p0 < 64 ? ga[sl] : gb[sl]; const int kb = p0 & 63;
                        u32x4 uw[8][2];
#pragma unroll
                        for (int j = 0; j < 8; ++j) { const int e = (int)((unsigned)__builtin_amdgcn_readlane((int)ksrc, kb + j) >> 7);
                            const GAS u32x4* ur = (const GAS u32x4*)(Ul + (size_t)e * DM); uw[j][0] = ur[lane]; uw[j][1] = ur[64 + lane]; }
                        const int eo = (int)((unsigned)__shfl((int)ksrc, kb + myx) >> 7); const float go = __shfl(gsrc, kb + myx); const float suo = sul[eo], svo = svl[eo];
                        int p[8];
#pragma unroll
                        for (int j = 0; j < 8; ++j) { int d = 0;
                            d = __builtin_amdgcn_sdot4((int)uw[j][0].x, xq[sl][0], d, false); d = __builtin_amdgcn_sdot4((int)uw[j][0].y, xq[sl][1], d, false);
                            d = __builtin_amdgcn_sdot4((int)uw[j][0].z, xq[sl][2], d, false); d = __builtin_amdgcn_sdot4((int)uw[j][0].w, xq[sl][3], d, false);
                            d = __builtin_amdgcn_sdot4((int)uw[j][1].x, xq[sl][4], d, false); d = __builtin_amdgcn_sdot4((int)uw[j][1].y, xq[sl][5], d, false);
                            d = __builtin_amdgcn_sdot4((int)uw[j][1].z, xq[sl][6], d, false); d = __builtin_amdgcn_sdot4((int)uw[j][1].w, xq[sl][7], d, false);
                            p[j] = d; }
                        int q4[4], q2[2], q1;
#pragma unroll
                        for (int j = 0; j < 4; ++j) { const int snd = (lane & 1) ? p[j] : p[j + 4], kp = (lane & 1) ? p[j + 4] : p[j]; q4[j] = kp + shx(snd, 1); }
#pragma unroll
                        for (int j = 0; j < 2; ++j) { const int snd = (lane & 2) ? q4[j] : q4[j + 2], kp = (lane & 2) ? q4[j + 2] : q4[j]; q2[j] = kp + shx(snd, 2); }
                        { const int snd = (lane & 4) ? q2[0] : q2[1], kp = (lane & 4) ? q2[1] : q2[0]; q1 = kp + shx(snd, 4); }
                        q1 += shx(q1, 8); q1 += shx(q1, 16); q1 += shx(q1, 32);
                        const float cown = gelu_tanh((float)q1 * suo * sxs[sl]) * go * svo;
                        { const int dj = lane - kb; const int srcl = ((dj & 1) << 2) | (dj & 2) | ((dj >> 2) & 1); const float cv = __shfl(cown, srcl & 63);
                          const bool mine = (unsigned)dj < 8u;
                          if (p0 < 64) cfa[sl] = mine ? cv : cfa[sl]; else cfb[sl] = mine ? cv : cfb[sl]; }
                        pos[sl] = p0 + 8;
                    }
                }
            }
#pragma unroll 1
            for (int piece = 0; piece < 2; ++piece) {
                f32x2 acc[NS][8];
#pragma unroll
                for (int sl = 0; sl < NS; ++sl) { pos[sl] = pbeg[sl];
#pragma unroll
                    for (int q = 0; q < 8; ++q) acc[sl][q] = (f32x2){0.f, 0.f}; }
                for (int hi_e = RSZB; hi_e <= NEXP; hi_e += RSZB) {
#pragma unroll
                    for (int sl = 0; sl < NS; ++sl) {
                        while (pos[sl] < pend[sl] && (int)((unsigned)__builtin_amdgcn_readlane((int)(pos[sl] < 64 ? ka[sl] : kb_[sl]), pos[sl] & 63) >> 7) < hi_e) {
                            const int p0 = pos[sl]; const unsigned ksrc = p0 < 64 ? ka[sl] : kb_[sl]; const float csrc = p0 < 64 ? cfa[sl] : cfb[sl]; const int kb = p0 & 63;
                            u32x4 vw[16];
#pragma unroll
                            for (int j = 0; j < 16; ++j) { const int e = (int)((unsigned)__builtin_amdgcn_readlane((int)ksrc, kb + j) >> 7);
                                vw[j] = ((const GAS u32x4*)(Vl + (size_t)e * DM))[piece * 64 + lane]; }
#pragma unroll
                            for (int j = 0; j < 16; ++j) { const float cj = __uint_as_float(__builtin_amdgcn_readlane(__float_as_uint(csrc), kb + j));
                                const int w[4] = {(int)vw[j].x, (int)vw[j].y, (int)vw[j].z, (int)vw[j].w};
#pragma unroll
                                for (int q = 0; q < 4; ++q) { const f32x2 lo_ = __builtin_amdgcn_cvt_pk_f32_fp8(w[q], false), hi_ = __builtin_amdgcn_cvt_pk_f32_fp8(w[q], true);
                                    acc[sl][2 * q] = lo_ * cj + acc[sl][2 * q]; acc[sl][2 * q + 1] = hi_ * cj + acc[sl][2 * q + 1]; } }
                            pos[sl] = p0 + 16;
                        }
                    }
                }
                {
                    u32x4 xo[4][2]; f32x4 gvv[4][4];
#pragma unroll
                    for (int sl = 0; sl < 4; ++sl) {
                        const int row = rowS[sl]; const int b = row / RPB, r = row % RPB, v = r < CTX ? 2 : b; const float* g5 = modl + (size_t)v * NMOD + 5 * DM + piece * 1024 + lane * 16;
                        const u32x4* pp = (const u32x4*)(X + (size_t)row * DM + piece * 1024 + lane * 16); xo[sl][0] = pp[0]; xo[sl][1] = pp[1];
#pragma unroll
                        for (int q = 0; q < 4; ++q) gvv[sl][q] = *(const f32x4*)(g5 + q * 4); }
#pragma unroll
                    for (int sl = 0; sl < 4; ++sl) { u32x4 wo[2];
#pragma unroll
                        for (int q = 0; q < 4; ++q) { const u32x4 xw = xo[sl][q >> 1]; const f32x4 gv = gvv[sl][q];
                            f32x4 o = bf4((q & 1) ? (u32x2){xw.z, xw.w} : (u32x2){xw.x, xw.y}); o.x += gv.x * acc[sl][2 * q].x; o.y += gv.y * acc[sl][2 * q].y; o.z += gv.z * acc[sl][2 * q + 1].x; o.w += gv.w * acc[sl][2 * q + 1].y;
                            if (q & 1) { wo[q >> 1].z = pk2(o.x, o.y); wo[q >> 1].w = pk2(o.z, o.w); } else { wo[q >> 1].x = pk2(o.x, o.y); wo[q >> 1].y = pk2(o.z, o.w); } }
                        u32x4* pp = (u32x4*)(X + (size_t)rowS[sl] * DM + piece * 1024 + lane * 16); pp[0] = wo[0]; pp[1] = wo[1]; }
                }
                if (!last) {
                    float* Pq = (float*)lds;
#pragma unroll
                    for (int q = 0; q < 8; ++q) { Pq[(wave * 16 + 2 * q) * 64 + lane] = acc[4][q].x; Pq[(wave * 16 + 2 * q + 1) * 64 + lane] = acc[4][q].y; }
                    __syncthreads();
                    if ((wave & 3) == 0) {
                        const int row = rowS[4]; const int b = row / RPB, r = row % RPB, v = r < CTX ? 2 : b; const float* g5 = modl + (size_t)v * NMOD + 5 * DM; bf16* xr = X + (size_t)row * DM;
                        u32x2 xe[4]; f32x4 ge[4];
#pragma unroll
                        for (int q = 0; q < 4; ++q) { const int col = piece * 1024 + lane * 16 + q * 4; xe[q] = *(const u32x2*)(xr + col); ge[q] = *(const f32x4*)(g5 + col); }
#pragma unroll
                        for (int q = 0; q < 4; ++q) { const int col = piece * 1024 + lane * 16 + q * 4; u32x2* pp = (u32x2*)(xr + col); const f32x4 gv = ge[q]; f32x4 o = bf4(xe[q]); float t4[4];
#pragma unroll
                            for (int e4 = 0; e4 < 4; ++e4) { const int qq = 4 * q + e4; t4[e4] = (Pq[((wave + 0) * 16 + qq) * 64 + lane] + Pq[((wave + 1) * 16 + qq) * 64 + lane]) + (Pq[((wave + 2) * 16 + qq) * 64 + lane] + Pq[((wave + 3) * 16 + qq) * 64 + lane]); }
                            o.x += gv.x * t4[0]; o.y += gv.y * t4[1]; o.z += gv.z * t4[2]; o.w += gv.w * t4[3]; *pp = (u32x2){pk2(o.x, o.y), pk2(o.z, o.w)}; }
                    }
                    __syncthreads();
                }
            }
            asm volatile("s_waitcnt vmcnt(0)" ::: "memory");
            u32x2 xraw[NS][8];
#pragma unroll
            for (int sl = 0; sl < NS; ++sl) { const u32x2* xr = (const u32x2*)(X + (size_t)(rowS[sl] >= 0 ? rowS[sl] : 0) * DM) + lane;
#pragma unroll
                for (int j = 0; j < 8; ++j) xraw[sl][j] = xr[64 * j]; }
#pragma unroll
            for (int sl = 0; sl < NS; ++sl) {
                if (sl == 4 && (last || (wave & 3) != 0)) continue;
                const int row = rowS[sl]; const int b = row / RPB, r = row % RPB, v = r < CTX ? 2 : b;
                if (!last) { const float* mvn = modv + (size_t)(Lr + 1) * 3 * NMOD + (size_t)v * NMOD;
                    norm_mod_row_q<true, true>(xraw[sl], a.norm_w + (size_t)((Lr + 1) * 2) * DM, mvn, mvn + DM, HQ + (size_t)row * DM, SA + row, a.norm_w + (size_t)((Lr + 1) * 2 + 1) * DM, mvn + 4 * DM, SXB + row, lane); }
                else { f32x4 vv[8]; float ss = 0.f;
#pragma unroll
                    for (int j = 0; j < 8; ++j) { vv[j] = bf4(xraw[sl][j]); ss += (vv[j].x * vv[j].x + vv[j].y * vv[j].y) + (vv[j].z * vv[j].z + vv[j].w * vv[j].w); }
                    const float rstd = 1.f / sqrtf(wave_sum(ss) * (1.f / DM) + EPS);
                    f32x4* o = (f32x4*)(a.out + ((size_t)b * SEQ + (r - CTX)) * DM) + lane;
#pragma unroll
                    for (int j = 0; j < 8; ++j) { const f32x4 wv = *((const f32x4*)a.final_norm_w + lane + 64 * j); o[64 * j] = vv[j] * rstd * wv; } }
            }
        }
        SEAM(pb + 8); T1(10);
    }
    if (TMASK != 0) { __syncthreads(); if (blockIdx.x == 0 && threadIdx.x == 0) { asm volatile("s_waitcnt vmcnt(0)" ::: "memory"); a.out[0] += (float)tacc * (0.01f / TSCALE); } }
#undef IN
#undef SEAM
}

extern "C" void kernel_launch(void* const* d_in, const int* in_sizes, int n_in, void* d_out, int out_size, void* d_ws, size_t ws_size, hipStream_t stream) {
    static int grid = 0;
    if (grid == 0) {
        if (n_in != 21 || out_size != NB * SEQ * DM || ws_size < WS_END) { fprintf(stderr, "kernel_launch: unexpected shapes (n_in %d out %d ws %zu)\n", n_in, out_size, ws_size); grid = -1; return; }
        int dev = 0, cus = 0, per_cu = 0;
        if (hipGetDevice(&dev) != hipSuccess || hipDeviceGetAttribute(&cus, hipDeviceAttributeMultiprocessorCount, dev) != hipSuccess) { grid = -1; return; }
        if (hipFuncSetAttribute((const void*)fwd_kernel, hipFuncAttributeMaxDynamicSharedMemorySize, LDS_BYTES) != hipSuccess) { fprintf(stderr, "kernel_launch: hipFuncSetAttribute failed\n"); grid = -1; return; }
        if (hipOccupancyMaxActiveBlocksPerMultiprocessor(&per_cu, (const void*)fwd_kernel, 512, LDS_BYTES) != hipSuccess || per_cu < 1) { fprintf(stderr, "kernel_launch: occupancy query reports %d\n", per_cu); (void)hipGetLastError(); grid = -1; return; }
        grid = cus;
    }
    if (grid < 0) return;
    (void)hipMemsetAsync((char*)d_ws + WS_CTL + 4096 * sizeof(unsigned), 0, 160 * 1024 - 4096 * sizeof(unsigned), stream);
    Args a{};
    const float** f = (const float**)&a;
    for (int i = 0; i < 21; ++i) f[i] = (const float*)d_in[i];
    a.out = (float*)d_out; a.ws = (unsigned char*)d_ws;
#if ONE_LAUNCH
    a.ph_lo = 0; a.ph_hi = NPHASE - 1;
    hipLaunchKernelGGL(fwd_kernel, dim3(grid), dim3(512), LDS_BYTES, stream, a);
#else
    for (int p = 0; p < NPHASE; ++p) {
        if (p == NPHASE - 1) continue;
        if (p >= 2 && p < NPHASE - 1) { const int L = (p - 2) / 9, k = (p - 2) % 9, kind = L % 3; if ((k == 2 && kind != 0) || (k == 3 && kind == 2) || (k == 0 && L > 0)) continue; }
        a.ph_lo = p; a.ph_hi = p + 1;
        hipLaunchKernelGGL(fwd_kernel, dim3(grid), dim3(512), LDS_BYTES, stream, a);
    }
#endif
}
```

```cpp
#include <hip/hip_runtime.h>
#include <cstdio>
#include <cstdint>

#ifndef ONE_LAUNCH
#define ONE_LAUNCH 1
#endif
#ifndef RSZ_A
#define RSZ_A 512
#endif
#ifndef RSZ_B
#define RSZ_B 512
#endif
#ifndef TMASK
#define TMASK 0
#endif
#ifndef TSCALE
#define TSCALE 500.f
#endif
#define TMON(b) ((TMASK >> (b)) & 1)
#ifndef PHMASK
#define PHMASK 0xFFFF
#endif
#define PHM(b) ((PHMASK >> (b)) & 1)
#ifndef MIXMASK
#define MIXMASK 15
#endif
#ifndef PEERMASK
#define PEERMASK 15
#endif
#define MIXON(L) ((MIXMASK >> (L)) & 1)
#define PEERON(L) ((PEERMASK >> (L)) & 1)

constexpr int DM = 2048, NB = 2, SEQ = 4096, CTX = 256, RPB = CTX + SEQ  , MR = NB * RPB  ;
constexpr int NMOD = 6 * DM;
constexpr int NEXP = 16384;
constexpr float EPS = 1e-6f;

#define LAS __attribute__((address_space(3)))
#define GAS __attribute__((address_space(1)))
typedef unsigned short bf16;
typedef short bf16x8 __attribute__((ext_vector_type(8)));
typedef short s16x4 __attribute__((ext_vector_type(4)));
typedef float f32x4 __attribute__((ext_vector_type(4)));
typedef float f32x2 __attribute__((ext_vector_type(2)));
typedef float f32x16 __attribute__((ext_vector_type(16)));
typedef unsigned u32x4 __attribute__((ext_vector_type(4)));
typedef unsigned u32x2 __attribute__((ext_vector_type(2)));
typedef __bf16 bf2v __attribute__((ext_vector_type(2)));

__device__ __forceinline__ unsigned f2bf(float f) { unsigned u = __builtin_bit_cast(unsigned, f); return (u + 0x7fffu + ((u >> 16) & 1u)) >> 16; }
__device__ __forceinline__ unsigned f8x4(float a, float b, float c, float d) { int w = 0; w = __builtin_amdgcn_cvt_pk_fp8_f32(a, b, w, false); w = __builtin_amdgcn_cvt_pk_fp8_f32(c, d, w, true); return (unsigned)w; }
constexpr int F8_ASHIFT = 2, F8_WSHIFT = 7; constexpr float F8_ASCALE = 4.f, F8_WSCALE = 128.f;
__device__ __forceinline__ unsigned pk2(float lo, float hi) { unsigned r; asm volatile("v_cvt_pk_bf16_f32 %0, %1, %2" : "=v"(r) : "v"(lo), "v"(hi)); return r; }
__device__ __forceinline__ float dot2bf(unsigned a, unsigned b, float acc) { const unsigned a_ = a, b_ = b; return __builtin_amdgcn_fdot2_f32_bf16(__builtin_bit_cast(bf2v, a_), __builtin_bit_cast(bf2v, b_), acc, false); }
__device__ __forceinline__ int shx_i(int v, int k) {
    switch (k) {
        case 1:  return __builtin_amdgcn_ds_swizzle(v, (1 << 10) | 0x1F);
        case 2:  return __builtin_amdgcn_ds_swizzle(v, (2 << 10) | 0x1F);
        case 4:  return __builtin_amdgcn_ds_swizzle(v, (4 << 10) | 0x1F);
        case 8:  return __builtin_amdgcn_ds_swizzle(v, (8 << 10) | 0x1F);
        case 16: return __builtin_amdgcn_ds_swizzle(v, (16 << 10) | 0x1F);
        default: { auto rr = __builtin_amdgcn_permlane32_swap((unsigned)v, (unsigned)v, false, false); int r;
                   asm("v_cndmask_b32_e64 %0, %1, %2, %3" : "=v"(r) : "v"(rr[1]), "v"(rr[0]), "s"(0xFFFFFFFF00000000ull)); return r; }
    }
}
__device__ __forceinline__ float shx(float v, int k) { return __builtin_bit_cast(float, shx_i(__builtin_bit_cast(int, v), k)); }
__device__ __forceinline__ int shx(int v, int k) { return shx_i(v, k); }
__device__ __forceinline__ unsigned shx(unsigned v, int k) { return (unsigned)shx_i((int)v, k); }
__device__ __forceinline__ float bflo(unsigned w) { return __builtin_bit_cast(float, w << 16); }
__device__ __forceinline__ float bfhi(unsigned w) { return __builtin_bit_cast(float, w & 0xffff0000u); }
__device__ __forceinline__ f32x4 bf4(u32x2 w) { return (f32x4){bflo(w.x), bfhi(w.x), bflo(w.y), bfhi(w.y)}; }
__device__ __forceinline__ float bf2f(bf16 b) { return __builtin_bit_cast(float, ((unsigned)b) << 16); }
constexpr int TID_TABLE_OFF = 131072 + 320 + 256;
__device__ __forceinline__ unsigned hw_slot() { return (unsigned)__builtin_amdgcn_s_getreg((5 << 11) | 4) & 63u; }
__device__ __forceinline__ int opaque_tid() {
    extern __shared__ __attribute__((aligned(16))) unsigned char lds_tid_[];
    const int w = ((volatile __attribute__((address_space(3))) unsigned char*)lds_tid_)[TID_TABLE_OFF + hw_slot()];
    int t = w * 64 + (int)__builtin_amdgcn_mbcnt_hi(~0u, __builtin_amdgcn_mbcnt_lo(~0u, 0u)); asm volatile("" : "+v"(t)); return t; }
__device__ __forceinline__ float wave_sum(float v) {
#pragma unroll
    for (int o = 1; o < 64; o <<= 1) v += shx(v, o);
    return v;
}

template <int J> __device__ __forceinline__ int lane_xor(int x, int lane) {
    if constexpr (J == 1) return __builtin_amdgcn_mov_dpp(x, 0xB1, 0xf, 0xf, true);
    else if constexpr (J == 2) return __builtin_amdgcn_mov_dpp(x, 0x4E, 0xf, 0xf, true);
    else if constexpr (J == 4) { const int up = __builtin_amdgcn_mov_dpp(x, 0x104, 0xf, 0xf, true), dn = __builtin_amdgcn_mov_dpp(x, 0x114, 0xf, 0xf, true); return (lane & 4) ? dn : up; }
    else if constexpr (J == 8) return __builtin_amdgcn_mov_dpp(x, 0x128, 0xf, 0xf, true);
    else if constexpr (J == 16) { auto r = __builtin_amdgcn_permlane16_swap((unsigned)x, (unsigned)x, false, false); return (int)((lane & 16) ? r[0] : r[1]); }
    else { auto r = __builtin_amdgcn_permlane32_swap((unsigned)x, (unsigned)x, false, false); return (int)((lane & 32) ? r[0] : r[1]); }
}
__device__ __forceinline__ void sincos_rot(float x, float& sn, float& cs) {
    const float n = __builtin_rintf(x * 0.63661977236758134f);
    float r = fmaf(-n, 1.5703125f, x); r = fmaf(-n, 4.837512969970703125e-4f, r); r = fmaf(-n, 7.54978995489188e-8f, r);
    const float r2 = r * r;
    const float sp = r + r * r2 * fmaf(r2, fmaf(r2, fmaf(r2, 2.7557314297e-6f, -1.9841270114e-4f), 8.3333337680e-3f), -1.6666667163e-1f);
    const float cp = fmaf(r2, fmaf(r2, fmaf(r2, fmaf(r2, 2.4801587642e-5f, -1.3888889225e-3f), 4.1666667908e-2f), -0.5f), 1.f);
    const int q = (int)n & 3;
    const float s0 = (q & 1) ? cp : sp, c0 = (q & 1) ? sp : cp;
    sn = (q & 2) ? -s0 : s0; cs = ((q + 1) & 2) ? -c0 : c0;
}

#define XB_TMO      128
#define XB_XCNT(j)  (256  + 64 * (j))
#define XB_XSUB(j)  (1280 + 64 * (j))
#define XB_XGEN(j)  (2304 + 64 * (j))
#define XB_TOP      3328
#define XB_TOPGEN   3392
#define XCD_BAR_WORDS 3456
#define XB_SPIN_CAP (1u << 18)

__device__ __forceinline__ unsigned xb_ld(unsigned* p)              { return __hip_atomic_load(p, __ATOMIC_RELAXED, __HIP_MEMORY_SCOPE_AGENT); }
__device__ __forceinline__ unsigned xb_add(unsigned* p, unsigned v) { return __hip_atomic_fetch_add(p, v, __ATOMIC_RELAXED, __HIP_MEMORY_SCOPE_AGENT); }
__device__ __forceinline__ unsigned xb_xcc_id() { return (unsigned)__builtin_amdgcn_s_getreg((3 << 11) | 20) & 0xFu; }
#define XB_SPIN(cond, bar) do { unsigned _sp = 0; while (cond) { __builtin_amdgcn_s_sleep(1); \
    if ((++_sp & 255u) == 0u) { if (xb_ld(&(bar)[XB_TMO])) break; if (_sp > XB_SPIN_CAP) { atomicAdd(&(bar)[XB_TMO], 1u); break; } } } } while (0)

struct XcdBarrier { unsigned* bar; unsigned x; volatile LAS unsigned* st; };

__device__ __forceinline__ XcdBarrier xcd_barrier_post(unsigned* bar, volatile LAS unsigned* st) {
    XcdBarrier b; b.bar = bar; b.x = xb_xcc_id(); b.st = st;
    if (threadIdx.x == 0) (void)xb_add(&bar[XB_XCNT(b.x)], 1u);
    return b;
}
__device__ __forceinline__ void xcd_barrier_complete(unsigned* bar, unsigned x, unsigned& nloc, unsigned& nx) {
    const unsigned G = gridDim.x * gridDim.y * gridDim.z;
    unsigned sum, cnt, mine, sp = 0u;
    for (;;) {
        sum = 0u; cnt = 0u; mine = 0u;
#pragma unroll
        for (unsigned j = 0; j < 16; ++j) { const unsigned c = xb_ld(&bar[XB_XCNT(j)]); sum += c; cnt += (c > 0u) ? 1u : 0u; mine = (j == x) ? c : mine; }
        if (sum == G) break;
        __builtin_amdgcn_s_sleep(1);
        if ((++sp & 255u) == 0u) { if (xb_ld(&bar[XB_TMO])) break; if (sp > XB_SPIN_CAP) { atomicAdd(&bar[XB_TMO], 1u); break; } }
    }
    nloc = mine > 0u ? mine : 1u; nx = cnt > 0u ? cnt : 1u;
}
__device__ __forceinline__ void xcd_barrier(const XcdBarrier& b) {
    asm volatile("s_waitcnt vmcnt(0)" ::: "memory");
    __syncthreads();
    if (threadIdx.x == 0) {
        unsigned* bar = b.bar;
        __builtin_amdgcn_s_waitcnt(0);
        unsigned nloc = b.st[0], nx = b.st[1];
        if (nloc == 0u) { xcd_barrier_complete(bar, b.x, nloc, nx); b.st[0] = nloc; b.st[1] = nx; }
        const unsigned old = xb_add(&bar[XB_XSUB(b.x)], 1u);
        const unsigned gen = old / nloc;
        if (old + 1u == (gen + 1u) * nloc) {
            __builtin_amdgcn_fence(__ATOMIC_RELEASE, "agent");
            asm volatile("s_waitcnt vmcnt(0)" ::: "memory");
            const unsigned og = xb_add(&bar[XB_TOP], 1u);
            const unsigned tg = og / nx;
            if (og + 1u == (tg + 1u) * nx) xb_add(&bar[XB_TOPGEN], 1u);
            else XB_SPIN(xb_ld(&bar[XB_TOPGEN]) == tg, bar);
            __builtin_amdgcn_fence(__ATOMIC_ACQUIRE, "agent");
            xb_add(&bar[XB_XGEN(b.x)], 1u);
            asm volatile("s_waitcnt vmcnt(0)" ::: "memory");
        } else {
            XB_SPIN(xb_ld(&bar[XB_XGEN(b.x)]) == gen, bar);
            __builtin_amdgcn_fence(__ATOMIC_ACQUIRE, "agent");
            asm volatile("s_waitcnt vmcnt(0)" ::: "memory");
        }
    }
    __syncthreads();
}

namespace pg8 {
constexpr int BM = 256, BK = 64, HALF = 128, HTB = HALF * BK * 2, STAGE_BYTES = 8 * HTB, NXCD = 8, WGM = 8;
__host__ __device__ __forceinline__ int lds_byte(int r, int c) { const int st = (r >> 4) * 2 + (c >> 5), rr = r & 15, cc = c & 31, ob = rr * 64 + cc * 2; return st * 1024 + (ob ^ (((ob >> 9) & 1) << 5)); }
__host__ __device__ __forceinline__ void stage_rc(int b, int& R, int& C) { const int st = b / 1024, sb = b % 1024, swz = sb ^ (((sb >> 9) & 1) << 5); R = (st >> 1) * 16 + swz / 64; C = (st & 1) * 32 + (swz % 64) / 2; }
__host__ __device__ __forceinline__ int perm32(int rho) { const int n = rho >> 4, i = rho & 15; return 8 * (i >> 2) + 4 * n + (i & 3); }

struct Unit { int pm, pn; };
struct Gemm { const bf16* A; const bf16* Bt; int M, N, K; };

struct StaticOrder {
    int nM, nN, nwg, G, c;
    __host__ __device__ void init(int M, int N, int G_, int c_) { nM = M / BM; nN = N / BM; nwg = nM * nN; G = G_; c = c_; }
    __host__ __device__ bool next(int i, Unit& u) const {
        const long L = (long)i * G + c; if (L >= nwg) return false;
        int wgid = (int)L; { const int q = nwg / NXCD, r = nwg % NXCD, xcd = wgid % NXCD, off = wgid / NXCD; wgid = (xcd < r ? xcd * (q + 1) : r * (q + 1) + (xcd - r) * q) + off; }
        const int nig = WGM * nN, gid = wgid / nig, fm = gid * WGM, gsz = (nM - fm) < WGM ? (nM - fm) : WGM;
        u.pm = fm + ((wgid % nig) % gsz); u.pn = (wgid % nig) / gsz; return true;
    }
    __device__ __forceinline__ void a_ready(const Unit&) const {}
    __device__ __forceinline__ void done(const Unit&) const {}
};
struct FlexOrder {
    int nM, nN, nwg, G, c, grouped;
    __device__ void init(int M, int N, int G_, int c_, int grouped_) { nM = grouped_ == 2 ? 32 : M / BM; nN = N / BM; nwg = grouped_ == 1 ? 272 : (grouped_ == 3 ? 256 : nM * nN); G = G_; c = c_; grouped = grouped_; }
    __device__ bool next(int i, Unit& u) const {
        const long L = (long)i * G + c; if (L >= nwg) return false;
        if (grouped == 1) { const int g = (int)L / 68, r = (int)L % 68; u.pm = g * 34 + (r >> 1); u.pn = g * 2 + (r & 1); return true; }
        if (grouped == 3) { const int g = (int)L / 64, r = (int)L % 64, pl = r >> 1; u.pm = g * 34 + pl + 1 + (pl >= 16 ? 1 : 0); u.pn = g * 2 + (r & 1); return true; }
        int wgid = (int)L; { const int q = nwg / NXCD, r = nwg % NXCD, xcd = wgid % NXCD, off = wgid / NXCD; wgid = (xcd < r ? xcd * (q + 1) : r * (q + 1) + (xcd - r) * q) + off; }
        const int nig = WGM * nN, gid = wgid / nig, fm = gid * WGM, gsz = (nM - fm) < WGM ? (nM - fm) : WGM;
        u.pm = fm + ((wgid % nig) % gsz); u.pn = (wgid % nig) / gsz; if (grouped == 2) u.pm += 1 + (u.pm >= 16 ? 1 : 0); return true;
    }
    __device__ __forceinline__ void a_ready(const Unit&) const {}
    __device__ __forceinline__ void done(const Unit&) const {}
};

struct EpiBf16 {
    static constexpr bool PERM = true, AFTER_DRAIN = false;
    bf16* O; int ldc;
    __device__ __forceinline__ void operator()(const f32x4 (&acc)[2][2][4][2], const Unit& u, int wr, int wc, int fr, int fq) const {
        const int row0 = u.pm * BM + wr * 64 + fr; const int col0 = u.pn * BM + wc * 32 + 8 * fq;
#pragma unroll
        for (int ai = 0; ai < 2; ++ai)
#pragma unroll
            for (int m = 0; m < 4; ++m) { bf16* rowp = O + (size_t)(row0 + ai * HALF + m * 16) * ldc + col0;
#pragma unroll
                for (int bj = 0; bj < 2; ++bj) { const f32x4 v0 = acc[ai][bj][m][0], v1 = acc[ai][bj][m][1];
                    u32x4 w; w.x = pk2(v0[0], v0[1]); w.y = pk2(v0[2], v0[3]); w.z = pk2(v1[0], v1[1]); w.w = pk2(v1[2], v1[3]);
                    *(u32x4*)(rowp + bj * HALF) = w; } }
    }
};
struct EpiResid {
    static constexpr bool PERM = true, AFTER_DRAIN = false;
    bf16* X; const float* modl; int gate_off; const float* ls; int pm_mod;
    signed char* XQ; float* ssq; const float* w2; const float* sxb; const float* x_in; const float* ctx_in;
    __device__ __forceinline__ void operator()(const f32x4 (&acc)[2][2][4][2], const Unit& u, int wr, int wc, int fr, int fq) const {
        const int pm = u.pm % pm_mod; const int bb = pm / 17, isctx = (pm % 17) == 0; const int v = isctx ? 2 : bb;
        const float* gate = modl + (size_t)v * NMOD + gate_off; const float* m4 = modl + (size_t)v * NMOD + 4 * DM;
        const int row0 = pm * BM + wr * 64 + fr, col0 = u.pn * BM + wc * 32 + 8 * fq;
        const float* srcf = x_in ? (isctx ? ctx_in + (size_t)bb * CTX * DM : x_in + ((size_t)bb * SEQ + (pm % 17 - 1) * 256) * DM) : nullptr;
        f32x4 gv[2][2], gs[2][2];
#pragma unroll
        for (int bj = 0; bj < 2; ++bj)
#pragma unroll
            for (int n = 0; n < 2; ++n) { const int c = col0 + bj * HALF + n * 4; gv[bj][n] = *(const f32x4*)(gate + c); if (ls) gv[bj][n] = gv[bj][n] * *(const f32x4*)(ls + c);
                gs[bj][n] = *(const f32x4*)(w2 + c) * (*(const f32x4*)(m4 + c) + 1.f); }
#pragma unroll
        for (int ai = 0; ai < 2; ++ai)
#pragma unroll
          for (int mp = 0; mp < 2; ++mp) {
            u32x4 xin[4][2]; float qiv[4];
#pragma unroll
            for (int m = 2 * mp; m < 2 * mp + 2; ++m) { const int row = row0 + ai * HALF + m * 16; qiv[m] = sxb[row];
                if (!srcf) { const bf16* rp = X + (size_t)row * DM + col0; xin[m][0] = *(const u32x4*)rp; xin[m][1] = *(const u32x4*)(rp + HALF); } }
#pragma unroll
            for (int m = 2 * mp; m < 2 * mp + 2; ++m) { const int row = row0 + ai * HALF + m * 16; bf16* rowp = X + (size_t)row * DM + col0; signed char* rowb = XQ + (size_t)row * DM + col0; float ss = 0.f;
                const unsigned soff = (unsigned)((row - pm * BM) * DM + col0);
                const float qi = 1.f / qiv[m];
#pragma unroll
                for (int bj = 0; bj < 2; ++bj) { u32x4* p = (u32x4*)(rowp + bj * HALF); f32x4 r0, r1;
                    if (srcf) { const f32x4* ps = (const f32x4*)(srcf + soff + bj * HALF); r0 = ps[0]; r1 = ps[1]; }
                    else { const u32x4 w = xin[m][bj]; r0 = bf4((u32x2){w.x, w.y}); r1 = bf4((u32x2){w.z, w.w}); }
                    const f32x4 x0 = r0 + acc[ai][bj][m][0] * gv[bj][0], x1 = r1 + acc[ai][bj][m][1] * gv[bj][1];
                    { u32x4 w; w.x = pk2(x0.x, x0.y); w.y = pk2(x0.z, x0.w); w.z = pk2(x1.x, x1.y); w.w = pk2(x1.z, x1.w); *p = w; }
                    ss += ((x0.x * x0.x + x0.y * x0.y) + (x0.z * x0.z + x0.w * x0.w)) + ((x1.x * x1.x + x1.y * x1.y) + (x1.z * x1.z + x1.w * x1.w));
                    const f32x4 h0 = x0 * gs[bj][0] * qi, h1 = x1 * gs[bj][1] * qi; int q[8] = {(int)__builtin_rintf(h0.x), (int)__builtin_rintf(h0.y), (int)__builtin_rintf(h0.z), (int)__builtin_rintf(h0.w), (int)__builtin_rintf(h1.x), (int)__builtin_rintf(h1.y), (int)__builtin_rintf(h1.z), (int)__builtin_rintf(h1.w)};
#pragma unroll
                    for (int e = 0; e < 8; ++e) q[e] = q[e] < -127 ? -127 : (q[e] > 127 ? 127 : q[e]);
                    u32x2 w; w.x = (unsigned)(q[0] & 255) | ((unsigned)(q[1] & 255) << 8) | ((unsigned)(q[2] & 255) << 16) | ((unsigned)(q[3] & 255) << 24);
                    w.y = (unsigned)(q[4] & 255) | ((unsigned)(q[5] & 255) << 8) | ((unsigned)(q[6] & 255) << 16) | ((unsigned)(q[7] & 255) << 24); *(u32x2*)(rowb + bj * HALF) = w; }
                ss += shx(ss, 16); ss += shx(ss, 32);
                if (fq == 0) ssq[(size_t)row * 32 + u.pn * 4 + wc] = ss; }
        }
    }
};
struct EpiBf16Q {
    static constexpr bool PERM = true, AFTER_DRAIN = false;
    bf16* O; int ldc; const float* sa; const unsigned* cmax;
    __device__ __forceinline__ void operator()(const f32x4 (&acc)[2][2][4][2], const Unit& u, int wr, int wc, int fr, int fq) const {
        const int row0 = u.pm * BM + wr * 64 + fr; const int col0 = u.pn * BM + wc * 32 + 8 * fq;
#pragma unroll
        for (int ai = 0; ai < 2; ++ai)
#pragma unroll
            for (int m = 0; m < 4; ++m) { const int row = row0 + ai * HALF + m * 16; bf16* rowp = O + (size_t)row * ldc + col0;
#pragma unroll
                for (int bj = 0; bj < 2; ++bj) { const f32x4 v0 = acc[ai][bj][m][0], v1 = acc[ai][bj][m][1];
                    u32x4 w; w.x = pk2(v0[0], v0[1]); w.y = pk2(v0[2], v0[3]); w.z = pk2(v1[0], v1[1]); w.w = pk2(v1[2], v1[3]);
                    *(u32x4*)(rowp + bj * HALF) = w; } }
    }
};
struct EpiPQ {
    static constexpr bool PERM = true, AFTER_DRAIN = false;
    bf16* O; const float* cvl; const LAS float* rs; const unsigned* cmax;
    __device__ __forceinline__ void operator()(const f32x4 (&acc)[2][2][4][2], const Unit& u, int wr, int wc, int fr, int fq) const {
        const int bb = u.pm / 17, isctx = (u.pm % 17) == 0; const float* cv = cvl + (size_t)(isctx ? 2 : bb) * DM;
        const int lrow0 = wr * 64 + fr; const int col0 = u.pn * BM + wc * 32 + 8 * fq;
        f32x4 c0[2], c1[2], s0[2], s1[2];
#pragma unroll
        for (int bj = 0; bj < 2; ++bj) { c0[bj] = *(const f32x4*)(cv + col0 + bj * HALF); c1[bj] = *(const f32x4*)(cv + col0 + bj * HALF + 4);
            const u32x4 a_ = *(const u32x4*)(cmax + col0 + bj * HALF), b_ = *(const u32x4*)(cmax + col0 + bj * HALF + 4);
            s0[bj] = (f32x4){__uint_as_float(a_.x), __uint_as_float(a_.y), __uint_as_float(a_.z), __uint_as_float(a_.w)} * (1.f / 127.f);
            s1[bj] = (f32x4){__uint_as_float(b_.x), __uint_as_float(b_.y), __uint_as_float(b_.z), __uint_as_float(b_.w)} * (1.f / 127.f); }
#pragma unroll
        for (int ai = 0; ai < 2; ++ai)
#pragma unroll
            for (int m = 0; m < 4; ++m) { const int lr = lrow0 + ai * HALF + m * 16; const float r = rs[lr]; bf16* rowp = O + (size_t)(u.pm * BM + lr) * DM + col0;
#pragma unroll
                for (int bj = 0; bj < 2; ++bj) { const f32x4 v0 = acc[ai][bj][m][0] * (s0[bj] * r) + c0[bj], v1 = acc[ai][bj][m][1] * (s1[bj] * r) + c1[bj];
                    u32x4 w; w.x = pk2(v0[0], v0[1]); w.y = pk2(v0[2], v0[3]); w.z = pk2(v1[0], v1[1]); w.w = pk2(v1[2], v1[3]);
                    *(u32x4*)(rowp + bj * HALF) = w; } }
    }
};

typedef int i32x4 __attribute__((ext_vector_type(4)));
typedef int i32x8 __attribute__((ext_vector_type(8)));
template <class Epi, class Sched, bool I8 = false, bool F8 = false>
__device__ __forceinline__ void gemm_phase(LAS unsigned char* lds, const Gemm g, const Sched& S, const Epi& E) {
    const int tid = opaque_tid(), wid = __builtin_amdgcn_readfirstlane(tid >> 6), lane = tid & 63, wr = wid >> 2, wc = wid & 3, fr = lane & 15, fq = lane >> 4;
    const int K = I8 ? g.K / 2 : g.K  , nt = K / BK;
    unsigned voffA[2], voffB[2];
#pragma unroll
    for (int i = 0; i < 2; ++i) { int R, C; stage_rc(tid * 16 + i * 8192, R, C); const int Rb = Epi::PERM ? ((R & ~31) + perm32(R & 31)) : R;
        voffA[i] = (unsigned)(R * K + C) * 2u; voffB[i] = (unsigned)(Rb * K + C) * 2u; }
    const size_t kstep = (size_t)(BK * 2);
    const size_t hstep = (size_t)HALF * K * 2;
    const size_t tstep = 2 * hstep;
    const unsigned ldsw = (unsigned)wid * 1024u;
    const int aoff = lds_byte(wr * 64 + fr, fq * 8), boff = lds_byte(wc * 32 + fr, fq * 8);
#define PG8_SA(b, h) (((b) * 2 + (h)) * HTB)
#define PG8_SB(b, h) ((4 + (b) * 2 + (h)) * HTB)
#define PG8_STAGE(bufoff, gbase, voff) do { _Pragma("unroll") for (int _i = 0; _i < 2; ++_i) \
        __builtin_amdgcn_global_load_lds((const unsigned*)((const char*)(gbase) + (voff)[_i]), (LAS unsigned*)(lds + (bufoff) + ldsw + _i * 8192), 16, 0, 0); } while (0)
#define PG8_LDA(dst, b, h) do { _Pragma("unroll") for (int m = 0; m < 4; ++m) { if constexpr (F8) { dst##8[m].lo = *(const LAS i32x4*)(lds + PG8_SA(b, h) + aoff + m * 2048); dst##8[m].hi = *(const LAS i32x4*)(lds + PG8_SA(b, h) + aoff + m * 2048 + 1024); } \
        else { _Pragma("unroll") for (int k = 0; k < 2; ++k) dst[m][k] = *(const LAS bf16x8*)(lds + PG8_SA(b, h) + aoff + m * 2048 + k * 1024); } } } while (0)
#define PG8_LDB(dst, b, h) do { _Pragma("unroll") for (int n = 0; n < 2; ++n) { if constexpr (F8) { dst##8[n].lo = *(const LAS i32x4*)(lds + PG8_SB(b, h) + boff + n * 2048); dst##8[n].hi = *(const LAS i32x4*)(lds + PG8_SB(b, h) + boff + n * 2048 + 1024); } \
        else { _Pragma("unroll") for (int k = 0; k < 2; ++k) dst[n][k] = *(const LAS bf16x8*)(lds + PG8_SB(b, h) + boff + n * 2048 + k * 1024); } } } while (0)
#define PG8_MMA(ai, bj, At, Bt) do { __builtin_amdgcn_s_setprio(1); _Pragma("unroll") for (int m = 0; m < 4; ++m) _Pragma("unroll") for (int n = 0; n < 2; ++n) { \
        if constexpr (F8) asm volatile("v_mfma_scale_f32_16x16x128_f8f6f4 %0, %1, %2, %0, %3, %4 op_sel_hi:[0,0,0]" : "+v"(acc[ai][bj][m][n]) : "v"(Bt##8[n]), "v"(At##8[m]), "v"(f8sw), "v"(f8sa)); \
        else _Pragma("unroll") for (int k = 0; k < 2; ++k) { \
        if constexpr (I8) acci[ai][bj][m][n] = __builtin_amdgcn_mfma_i32_16x16x64_i8(__builtin_bit_cast(i32x4, Bt[n][k]), __builtin_bit_cast(i32x4, At[m][k]), acci[ai][bj][m][n], 0, 0, 0); \
        else acc[ai][bj][m][n] = __builtin_amdgcn_mfma_f32_16x16x32_bf16(Bt[n][k], At[m][k], acc[ai][bj][m][n], 0, 0, 0); } } __builtin_amdgcn_s_setprio(0); } while (0)
#define PG8_WAIT_V(n) asm volatile("s_waitcnt vmcnt(" #n ")" ::: "memory")
#define PG8_WAIT_L(n) asm volatile("s_waitcnt lgkmcnt(" #n ")" ::: "memory")
#define PG8_BAR __builtin_amdgcn_s_barrier()
#define PG8_SCHED __builtin_amdgcn_sched_barrier(0)
    Unit cur, nxt; int ui = 0;
    if (!S.next(0, cur)) return;
    f32x4 acc[2][2][4][2]; i32x4 acci[2][2][4][2];
#pragma unroll
    for (int a = 0; a < 2; ++a)
#pragma unroll
        for (int b = 0; b < 2; ++b)
#pragma unroll
            for (int m = 0; m < 4; ++m)
#pragma unroll
                for (int n = 0; n < 2; ++n) { acc[a][b][m][n] = (f32x4){0.f, 0.f, 0.f, 0.f}; acci[a][b][m][n] = (i32x4){0, 0, 0, 0}; if constexpr (F8) asm volatile("" : "+v"(acc[a][b][m][n])); }
    bf16x8 At[4][2], B0[2][2], B1[2][2]; i32x8 At8[4], B08[2], B18[2];
    int f8sw = 127 - F8_WSHIFT, f8sa = 127 - F8_ASHIFT; (void)f8sw; (void)f8sa;
    const char* cA = (const char*)g.A + (size_t)cur.pm * tstep; const char* cB = (const char*)g.Bt + (size_t)cur.pn * tstep;
    S.a_ready(cur);
    PG8_STAGE(PG8_SB(0, 0), cB, voffB); PG8_STAGE(PG8_SA(0, 0), cA, voffA); PG8_STAGE(PG8_SB(0, 1), cB + hstep, voffB); PG8_STAGE(PG8_SA(0, 1), cA + hstep, voffA);
    if (wr == 1) PG8_BAR;
    PG8_WAIT_V(4); PG8_BAR;
    PG8_STAGE(PG8_SB(1, 0), cB + kstep, voffB); PG8_STAGE(PG8_SA(1, 0), cA + kstep, voffA); PG8_STAGE(PG8_SB(1, 1), cB + hstep + kstep, voffB);
    PG8_WAIT_V(6); PG8_BAR;
    for (;;) {
        const bool has_next = S.next(ui + 1, nxt);
        const char* nA = has_next ? (const char*)g.A + (size_t)nxt.pm * tstep : cA; const char* nB = has_next ? (const char*)g.Bt + (size_t)nxt.pn * tstep : cB;
        for (int t = 0; t < nt; t += 2) {
            const bool last = (t == nt - 2);
            const char* a1 = cA + (size_t)(t + 1) * kstep;
            const char* a2 = last ? nA : cA + (size_t)(t + 2) * kstep; const char* b2 = last ? nB : cB + (size_t)(t + 2) * kstep;
            const char* a3 = a2 + kstep; const char* b3 = b2 + kstep;
            if (last && has_next) S.a_ready(nxt);
            PG8_LDB(B0, 0, 0); PG8_SCHED; PG8_LDA(At, 0, 0); PG8_STAGE(PG8_SA(1, 1), a1 + hstep, voffA);
            PG8_WAIT_L(8); PG8_BAR; PG8_WAIT_L(0); PG8_MMA(0, 0, At, B0); PG8_BAR; PG8_SCHED;
            PG8_LDB(B1, 0, 1); PG8_STAGE(PG8_SB(0, 0), b2, voffB);
            PG8_BAR; PG8_WAIT_L(0); PG8_MMA(0, 1, At, B1); PG8_BAR;
            PG8_LDA(At, 0, 1); PG8_STAGE(PG8_SA(0, 0), a2, voffA);
            PG8_BAR; PG8_WAIT_L(0); PG8_MMA(1, 0, At, B0); PG8_BAR; PG8_SCHED;
            PG8_STAGE(PG8_SB(0, 1), b2 + hstep, voffB);
            PG8_WAIT_V(6); PG8_BAR; PG8_MMA(1, 1, At, B1); PG8_BAR;
            PG8_LDB(B0, 1, 0); PG8_SCHED; PG8_LDA(At, 1, 0); PG8_STAGE(PG8_SA(0, 1), a2 + hstep, voffA);
            PG8_WAIT_L(8); PG8_BAR; PG8_WAIT_L(0); PG8_MMA(0, 0, At, B0); PG8_BAR; PG8_SCHED;
            PG8_LDB(B1, 1, 1); PG8_STAGE(PG8_SB(1, 0), b3, voffB);
            PG8_BAR; PG8_WAIT_L(0); PG8_MMA(0, 1, At, B1); PG8_BAR;
            PG8_LDA(At, 1, 1); PG8_STAGE(PG8_SA(1, 0), a3, voffA);
            PG8_BAR; PG8_WAIT_L(0); PG8_MMA(1, 0, At, B0); PG8_BAR; PG8_SCHED;
            PG8_STAGE(PG8_SB(1, 1), b3 + hstep, voffB);
            PG8_WAIT_V(6); PG8_BAR; PG8_MMA(1, 1, At, B1); PG8_BAR;
        }
        if constexpr (F8) asm volatile("s_nop 15\n\ts_nop 15" ::: "memory");
        if constexpr (I8 && !F8) {
#pragma unroll
            for (int a = 0; a < 2; ++a)
#pragma unroll
                for (int b = 0; b < 2; ++b)
#pragma unroll
                    for (int m = 0; m < 4; ++m)
#pragma unroll
                        for (int n = 0; n < 2; ++n) acc[a][b][m][n] = __builtin_convertvector(acci[a][b][m][n], f32x4);
        }
        E(acc, cur, wr, wc, fr, fq); S.done(cur);
        if (!has_next) break;
#pragma unroll
        for (int a = 0; a < 2; ++a)
#pragma unroll
            for (int b = 0; b < 2; ++b)
#pragma unroll
                for (int m = 0; m < 4; ++m)
#pragma unroll
                    for (int n = 0; n < 2; ++n) { acc[a][b][m][n] = (f32x4){0.f, 0.f, 0.f, 0.f}; acci[a][b][m][n] = (i32x4){0, 0, 0, 0}; if constexpr (F8) asm volatile("" : "+v"(acc[a][b][m][n])); }
        cur = nxt; cA = nA; cB = nB; ++ui;
    }
    PG8_WAIT_V(0);
    if (wr == 0) PG8_BAR;
    PG8_BAR;
#undef PG8_SA
#undef PG8_SB
#undef PG8_STAGE
#undef PG8_LDA
#undef PG8_LDB
#undef PG8_MMA
#undef PG8_WAIT_V
#undef PG8_WAIT_L
#undef PG8_BAR
#undef PG8_SCHED
}
}

namespace att {
constexpr int D = 128, NW = 8, QBLK = 32, KVBLK = 64;
constexpr float SCALE = 0.088388347648318440f;
constexpr float THR = 8.f;
constexpr size_t SHM_V = KVBLK * D * 2, SHM_K = KVBLK * D * 2, SHM_ATTN = 2 * SHM_V + 2 * SHM_K + NW * 64 * 4;
#define KSWZ(row, colB) ((row) * 256 + ((colB) ^ (((row) & 7) << 4)))
#define SBAR() __builtin_amdgcn_sched_barrier(0)
__device__ __forceinline__ int crow(int r, int hi) { return (r & 3) + 8 * (r >> 2) + 4 * hi; }

__device__ __forceinline__ void partialSM(f32x16& p0, f32x16& p1, float& m_reg, float& mn, float& alpha) {
  constexpr float C = SCALE * 1.4426950408889634f;
  float pmax = p0[0];
#pragma unroll
  for (int r = 1; r < 16; ++r) pmax = fmaxf(pmax, p0[r]);
#pragma unroll
  for (int r = 0; r < 16; ++r) pmax = fmaxf(pmax, p1[r]);
  { auto rr = __builtin_amdgcn_permlane32_swap(__float_as_uint(pmax), __float_as_uint(pmax), false, false);
    pmax = fmaxf(__uint_as_float(rr[0]), __uint_as_float(rr[1])); }
  if (__builtin_expect(__all(pmax - m_reg <= THR / SCALE), 1)) { mn = m_reg; alpha = 1.f; }
  else { mn = fmaxf(m_reg, pmax); alpha = __builtin_amdgcn_exp2f((m_reg - mn) * C); m_reg = mn; }
  float mnC = -mn * C;
#pragma unroll
  for (int r = 0; r < 16; ++r) p0[r] = fmaf(p0[r], C, mnC);
#pragma unroll
  for (int r = 0; r < 16; ++r) p1[r] = fmaf(p1[r], C, mnC);
#pragma unroll
  for (int r = 0; r < 16; ++r) p0[r] = __builtin_amdgcn_exp2f(p0[r]);
}
__device__ __forceinline__ void finishSM(f32x16& p0, f32x16& p1, float alpha, float& l_reg, bf16x8& pa0, bf16x8& pa1, bf16x8& pa2, bf16x8& pa3) {
#pragma unroll
  for (int r = 0; r < 16; ++r) p1[r] = __builtin_amdgcn_exp2f(p1[r]);
  float ps = 0;
#pragma unroll
  for (int r = 0; r < 16; ++r) ps += p0[r];
#pragma unroll
  for (int r = 0; r < 16; ++r) ps += p1[r];
  { auto rr = __builtin_amdgcn_permlane32_swap(__float_as_uint(ps), __float_as_uint(ps), false, false);
    ps = __uint_as_float(rr[0]) + __uint_as_float(rr[1]); }
  l_reg = l_reg * alpha + ps;
#define PK4(P, BASE, OUT) do { unsigned a0 = pk2(P[BASE + 0], P[BASE + 1]), a1 = pk2(P[BASE + 2], P[BASE + 3]);   \
    unsigned b0 = pk2(P[BASE + 4], P[BASE + 5]), b1 = pk2(P[BASE + 6], P[BASE + 7]);                              \
    auto r0 = __builtin_amdgcn_permlane32_swap(a0, b0, false, false); auto r1 = __builtin_amdgcn_permlane32_swap(a1, b1, false, false); \
    u32x4 w = {r0[0], r1[0], r0[1], r1[1]}; OUT = *reinterpret_cast<bf16x8*>(&w); } while (0)
  PK4(p0, 0, pa0); PK4(p0, 8, pa1); PK4(p1, 0, pa2); PK4(p1, 8, pa3);
#undef PK4
}
__device__ __forceinline__ void qkt(f32x16& p0, f32x16& p1, const bf16* Ks, const bf16x8* qr, int r32, int hi) {
  p0 = f32x16{}; p1 = f32x16{};
#pragma unroll
  for (int d0 = 0; d0 < 8; ++d0) { int cb = (d0 * 16 + hi * 8) * 2;
    bf16x8 b0 = *reinterpret_cast<const bf16x8*>((const char*)Ks + KSWZ(r32, cb));
    bf16x8 b1 = *reinterpret_cast<const bf16x8*>((const char*)Ks + KSWZ(32 + r32, cb));
    p0 = __builtin_amdgcn_mfma_f32_32x32x16_bf16(b0, qr[d0], p0, 0, 0, 0);
    p1 = __builtin_amdgcn_mfma_f32_32x32x16_bf16(b1, qr[d0], p1, 0, 0, 0); }
}
typedef int ai32x4 __attribute__((ext_vector_type(4)));
typedef int ai32x8 __attribute__((ext_vector_type(8)));
#define K8ADDR(row, chunk) ((row) * 128 + ((((chunk) ^ ((row) & 7))) << 4))
__device__ __forceinline__ void qkt8(f32x16& p0, f32x16& p1, const f32x16& mC, const char* Ks, const ai32x8* q8, int r32, int hi) {
  p0 = mC; p1 = mC;
#pragma unroll
  for (int s = 0; s < 2; ++s) { const int c = s * 4 + hi * 2; ai32x8 k0, k1;
    k0.lo = *reinterpret_cast<const ai32x4*>(Ks + K8ADDR(r32, c)); k0.hi = *reinterpret_cast<const ai32x4*>(Ks + K8ADDR(r32, c + 1));
    k1.lo = *reinterpret_cast<const ai32x4*>(Ks + 4096 + K8ADDR(r32, c)); k1.hi = *reinterpret_cast<const ai32x4*>(Ks + 4096 + K8ADDR(r32, c + 1));
    p0 = __builtin_amdgcn_mfma_scale_f32_32x32x64_f8f6f4(k0, q8[s], p0, 0, 0, 0, 127, 0, 127);
    p1 = __builtin_amdgcn_mfma_scale_f32_32x32x64_f8f6f4(k1, q8[s], p1, 0, 0, 0, 127, 0, 127); SBAR(); }
}
constexpr float THR8 = 2.5f;
#define V8ADDR(row, chunk) ((row) * 64 + ((((chunk) ^ (((row) >> 2) & 3))) << 4))
__device__ __forceinline__ void partialSM8(f32x16& p0, f32x16& p1, f32x16& mC, float& alpha, const bool force) {
  constexpr float TP = THR8 * 1.4426950408889634f;
  float pmax = p0[0];
#pragma unroll
  for (int r = 1; r < 16; ++r) pmax = fmaxf(pmax, p0[r]);
#pragma unroll
  for (int r = 0; r < 16; ++r) pmax = fmaxf(pmax, p1[r]);
  { auto rr = __builtin_amdgcn_permlane32_swap(__float_as_uint(pmax), __float_as_uint(pmax), false, false);
    pmax = fmaxf(__uint_as_float(rr[0]), __uint_as_float(rr[1])); }
  const float draw = pmax - 5.f;
  if (!force && __builtin_expect(__all(draw <= TP), 1)) alpha = 1.f;
  else { const float delta = force ? draw : fmaxf(draw, 0.f); alpha = force ? 1.f : __builtin_amdgcn_exp2f(-delta);
#pragma unroll
    for (int r = 0; r < 16; ++r) { p0[r] -= delta; p1[r] -= delta; mC[r] -= delta; } }
#pragma unroll
  for (int r = 0; r < 16; ++r) p0[r] = __builtin_amdgcn_exp2f(p0[r]);
}
__device__ __forceinline__ void finishSM8(f32x16& p0, f32x16& p1, ai32x8& pf) {
#pragma unroll
  for (int r = 0; r < 16; ++r) p1[r] = __builtin_amdgcn_exp2f(p1[r]);
#pragma unroll
  for (int i = 0; i < 4; ++i) { pf[i] = (int)f8x4(p0[4 * i], p0[4 * i + 1], p0[4 * i + 2], p0[4 * i + 3]); pf[4 + i] = (int)f8x4(p1[4 * i], p1[4 * i + 1], p1[4 * i + 2], p1[4 * i + 3]); }
}
__device__ __forceinline__ void pv8(f32x16* o, f32x16& lacc, const ai32x8 ones, const char* Vs, const ai32x8 pf, int r32, int hi) {
  lacc = __builtin_amdgcn_mfma_scale_f32_32x32x64_f8f6f4(pf, ones, lacc, 0, 0, 0, 122, 0, 127);
#pragma unroll
  for (int d0 = 0; d0 < 4; ++d0) { const int row = d0 * 32 + r32; ai32x8 v;
    v.lo = *reinterpret_cast<const ai32x4*>(Vs + V8ADDR(row, 2 * hi)); v.hi = *reinterpret_cast<const ai32x4*>(Vs + V8ADDR(row, 2 * hi + 1));
    o[d0] = __builtin_amdgcn_mfma_scale_f32_32x32x64_f8f6f4(pf, v, o[d0], 0, 0, 0, 122, 0, 127); SBAR(); }
}
__device__ __forceinline__ int v_st(int k, int c) { const int kk = (k & ~0xC) | ((k & 4) << 1) | ((k & 8) >> 1); return ((kk >> 3) * 4 + (c >> 5)) * 512 + ((kk & 7) * 32 + (c & 31)) * 2; }
__device__ __forceinline__ int v_rd_base(int lane) { return ((lane & 3) << 3) | (((lane >> 2) & 3) << 6) | (((lane >> 4) & 1) << 5) | (((lane >> 5) & 1) << 8); }
constexpr int v_rd_off(int d0, int ks, int half) { return d0 * 512 + ks * 4096 + half * 2048; }
template <int OFF> __device__ __forceinline__ s16x4 tr_read(int vb) {
  s16x4 r; asm volatile("ds_read_b64_tr_b16 %0, %1 offset:%2" : "=&v"(r) : "v"(vb), "i"(OFF) : "memory"); return r;
}
template <int D0> __device__ __forceinline__ void pv_one(f32x16& od, int vb, bf16x8 pa0, bf16x8 pa1, bf16x8 pa2, bf16x8 pa3) {
  const s16x4 l0 = tr_read<v_rd_off(D0, 0, 0)>(vb), h0 = tr_read<v_rd_off(D0, 0, 1)>(vb), l1 = tr_read<v_rd_off(D0, 1, 0)>(vb), h1 = tr_read<v_rd_off(D0, 1, 1)>(vb);
  const s16x4 l2 = tr_read<v_rd_off(D0, 2, 0)>(vb), h2 = tr_read<v_rd_off(D0, 2, 1)>(vb), l3 = tr_read<v_rd_off(D0, 3, 0)>(vb), h3 = tr_read<v_rd_off(D0, 3, 1)>(vb);
  asm volatile("s_waitcnt lgkmcnt(0)" ::: "memory"); SBAR();
#define PK(L, H) (bf16x8){L[0], L[1], L[2], L[3], H[0], H[1], H[2], H[3]}
  od = __builtin_amdgcn_mfma_f32_32x32x16_bf16(pa0, PK(l0, h0), od, 0, 0, 0);
  od = __builtin_amdgcn_mfma_f32_32x32x16_bf16(pa1, PK(l1, h1), od, 0, 0, 0);
  od = __builtin_amdgcn_mfma_f32_32x32x16_bf16(pa2, PK(l2, h2), od, 0, 0, 0);
  od = __builtin_amdgcn_mfma_f32_32x32x16_bf16(pa3, PK(l3, h3), od, 0, 0, 0);
#undef PK
}
__device__ __forceinline__ void pv_d0(f32x16* o, int vb, bf16x8 pa0, bf16x8 pa1, bf16x8 pa2, bf16x8 pa3) {
  pv_one<0>(o[0], vb, pa0, pa1, pa2, pa3); pv_one<1>(o[1], vb, pa0, pa1, pa2, pa3); pv_one<2>(o[2], vb, pa0, pa1, pa2, pa3); pv_one<3>(o[3], vb, pa0, pa1, pa2, pa3);
}

template <int LD>
__device__ __forceinline__ void attn_body(const bf16* __restrict__ Qb, const unsigned char* __restrict__ K8h  , const unsigned char* __restrict__ V8h  , unsigned char* __restrict__ Ob,
                                          int NT, const float* __restrict__ qgain, int t0, char* lds) {
  const int tid = opaque_tid(), wid = tid >> 6, lane = tid & 63, r32 = lane & 31, hi = lane >> 5;
  bf16* V_lds = (bf16*)lds; bf16* K_lds = (bf16*)(lds + 2 * SHM_V);
  float* ws = (float*)(lds + 2 * SHM_V + 2 * SHM_K) + wid * 64; float* li_l = ws; float* al_l = ws + 32;
  f32x16 o[4] = {}, lacc = {}, mC; bf16x8 qr[8];
#pragma unroll
  for (int r = 0; r < 16; ++r) mC[r] = 5.f;
  ai32x8 ones; { int one4 = 0x38383838; asm volatile("" : "+v"(one4));
#pragma unroll
    for (int i = 0; i < 8; ++i) ones[i] = one4; }
  const bf16* Qw = Qb + (long)(wid * QBLK + r32) * LD + hi * 8;
#pragma unroll
  for (int d0 = 0; d0 < 8; ++d0) qr[d0] = *reinterpret_cast<const bf16x8*>(Qw + d0 * 16);
  if (qgain) {
    float ss = 0.f;
#pragma unroll
    for (int d0 = 0; d0 < 8; ++d0) { const u32x4 w = *reinterpret_cast<const u32x4*>(&qr[d0]); const unsigned ww[4] = {w.x, w.y, w.z, w.w};
#pragma unroll
      for (int j = 0; j < 4; ++j) { const float a_ = bflo(ww[j]), b_ = bfhi(ww[j]); ss += a_ * a_ + b_ * b_; } }
    { auto rr = __builtin_amdgcn_permlane32_swap(__float_as_uint(ss), __float_as_uint(ss), false, false); ss = __uint_as_float(rr[0]) + __uint_as_float(rr[1]); }
    const float rstd = 1.f / sqrtf(ss * (1.f / 128.f) + EPS);
    const int t = t0 + wid * QBLK + r32; const float prow = (float)(t >> 6), pcol = (float)(t & 63);
#pragma unroll
    for (int grp = 0; grp < 4; ++grp) {
      const int dA = (grp >> 1) * 4 + (grp & 1), dB = dA + 2, dd = grp & 1; const float pos = (grp >> 1) ? pcol : prow;
      const u32x4 wa = *reinterpret_cast<const u32x4*>(&qr[dA]), wb = *reinterpret_cast<const u32x4*>(&qr[dB]);
      const unsigned wwa[4] = {wa.x, wa.y, wa.z, wa.w}, wwb[4] = {wb.x, wb.y, wb.z, wb.w};
      const f32x4 ga0 = *(const f32x4*)(qgain + dA * 16 + hi * 8), ga1 = *(const f32x4*)(qgain + dA * 16 + hi * 8 + 4), gb0 = *(const f32x4*)(qgain + dB * 16 + hi * 8), gb1 = *(const f32x4*)(qgain + dB * 16 + hi * 8 + 4);
      const float gA[8] = {ga0.x, ga0.y, ga0.z, ga0.w, ga1.x, ga1.y, ga1.z, ga1.w}, gB[8] = {gb0.x, gb0.y, gb0.z, gb0.w, gb1.x, gb1.y, gb1.z, gb1.w};
      float oa[8], ob[8];
#pragma unroll
      for (int j = 0; j < 8; ++j) {
        const float y1 = ((j & 1) ? bfhi(wwa[j >> 1]) : bflo(wwa[j >> 1])) * rstd * gA[j], y2 = ((j & 1) ? bfhi(wwb[j >> 1]) : bflo(wwb[j >> 1])) * rstd * gB[j];
        float sn = 0.f, cs = 1.f;
        if (t0 >= 0) { const int i = dd * 16 + hi * 8 + j; const float inv = exp2f(-(float)(2 * i) * (1.f / 64.f) * 13.287712379549449f); sincos_rot(pos * inv, sn, cs); }
        oa[j] = y1 * cs - y2 * sn; ob[j] = y2 * cs + y1 * sn;
      }
      u32x4 w; w.x = pk2(oa[0], oa[1]); w.y = pk2(oa[2], oa[3]); w.z = pk2(oa[4], oa[5]); w.w = pk2(oa[6], oa[7]); qr[dA] = *reinterpret_cast<bf16x8*>(&w);
      w.x = pk2(ob[0], ob[1]); w.y = pk2(ob[2], ob[3]); w.z = pk2(ob[4], ob[5]); w.w = pk2(ob[6], ob[7]); qr[dB] = *reinterpret_cast<bf16x8*>(&w);
    }
  }
  ai32x8 q8[2];
#pragma unroll
  for (int s = 0; s < 2; ++s)
#pragma unroll
    for (int i = 0; i < 4; ++i) { const u32x4 w = *reinterpret_cast<const u32x4*>(&qr[4 * s + i]);
      constexpr float QC = SCALE * 1.4426950408889634f;
      q8[s][2 * i] = (int)f8x4(bflo(w.x) * QC, bfhi(w.x) * QC, bflo(w.y) * QC, bfhi(w.y) * QC); q8[s][2 * i + 1] = (int)f8x4(bflo(w.z) * QC, bfhi(w.z) * QC, bflo(w.w) * QC, bfhi(w.w) * QC); }
  const int widu = __builtin_amdgcn_readfirstlane(wid);
  const unsigned char* K8t = K8h + (long)(tid >> 3) * 512 + (((tid & 7) ^ ((tid >> 3) & 7)) << 4);
  const unsigned char* V8t = V8h + tid * 16;
  LAS unsigned char* Ld = (LAS unsigned char*)lds + widu * 1024;
#define DLOAD(t) do { const int t_ = (t); LAS unsigned char* d_ = Ld + (t_ & 3) * 16384;                                                   \
    __builtin_amdgcn_global_load_lds((const unsigned*)(V8t + (long)t_ * 8192), (LAS unsigned*)d_, 16, 0, 0);                             \
    __builtin_amdgcn_global_load_lds((const unsigned*)(K8t + (long)t_ * 64 * 512), (LAS unsigned*)(d_ + 8192), 16, 0, 0); } while (0)
#define DWAIT(more) do { if (more) asm volatile("s_waitcnt vmcnt(2)" ::: "memory"); else asm volatile("s_waitcnt vmcnt(0)" ::: "memory"); } while (0)
#define TBUF(t) ((const char*)lds + ((t) & 3) * 16384)
#define RESC(a) do { if (__any((a) < 1.f)) { if (hi == 0) al_l[r32] = (a); asm volatile("s_waitcnt lgkmcnt(0)" ::: "memory"); \
    _Pragma("unroll") for (int r = 0; r < 16; ++r) { const float al_ = al_l[crow(r, hi)]; lacc[r] *= al_; _Pragma("unroll") for (int d = 0; d < 4; ++d) o[d][r] *= al_; } } } while (0)
  f32x16 pA0, pA1, pB0, pB1; float alA, alB; ai32x8 pf;
  DLOAD(0); DLOAD(1);
  DWAIT(true); __syncthreads();
  qkt8(pA0, pA1, mC, TBUF(0) + 8192, q8, r32, hi); partialSM8(pA0, pA1, mC, alA, true);
  if (2 < NT) DLOAD(2);
  DWAIT(2 < NT); __syncthreads();
  for (int j = 1; j + 1 < NT; j += 2) {
    SBAR(); qkt8(pB0, pB1, mC, TBUF(j) + 8192, q8, r32, hi);
    finishSM8(pA0, pA1, pf); SBAR();
    pv8(o, lacc, ones, TBUF(j - 1), pf, r32, hi); partialSM8(pB0, pB1, mC, alB, false);
    DLOAD(j + 2); DWAIT(true);
    RESC(alB); __syncthreads();
    SBAR(); qkt8(pA0, pA1, mC, TBUF(j + 1) + 8192, q8, r32, hi);
    finishSM8(pB0, pB1, pf); SBAR();
    pv8(o, lacc, ones, TBUF(j), pf, r32, hi); partialSM8(pA0, pA1, mC, alA, false);
    if (j + 3 < NT) DLOAD(j + 3);
    DWAIT(j + 3 < NT);
    RESC(alA); __syncthreads();
  }
  SBAR(); qkt8(pB0, pB1, mC, TBUF(NT - 1) + 8192, q8, r32, hi);
  finishSM8(pA0, pA1, pf); SBAR();
  pv8(o, lacc, ones, TBUF(NT - 2), pf, r32, hi); partialSM8(pB0, pB1, mC, alB, false);
  RESC(alB);
  finishSM8(pB0, pB1, pf); SBAR();
  pv8(o, lacc, ones, TBUF(NT - 1), pf, r32, hi);
  float rli[16];
#pragma unroll
  for (int r = 0; r < 16; ++r) rli[r] = __builtin_amdgcn_rcpf(lacc[r]);
  unsigned char* Ow = Ob + (long)(wid * QBLK) * DM;
#pragma unroll
  for (int r = 0; r < 16; ++r) { const int orow = crow(r, hi); const float sc_ = rli[r] * F8_ASCALE;
    const unsigned w = f8x4(o[0][r] * sc_, o[1][r] * sc_, o[2][r] * sc_, o[3][r] * sc_);
#pragma unroll
    for (int d0 = 0; d0 < 4; ++d0) Ow[(long)orow * DM + d0 * 32 + r32] = (unsigned char)(w >> (8 * d0)); }
  __syncthreads();
#undef DLOAD
#undef DWAIT
#undef TBUF
#undef RESC
}
__device__ __forceinline__ void attn_na_body(const bf16* __restrict__ Qb, const bf16* __restrict__ Kh, const bf16* __restrict__ Vh, unsigned char* __restrict__ Ob,
                                             const int kr_lo, const int qrow0, const float* bl, const int NT, char* lds) {
  constexpr int LD = 6144;
  const int tid = opaque_tid(), wid = tid >> 6, lane = tid & 63, r32 = lane & 31, hi = lane >> 5;
  bf16* V_lds = (bf16*)lds; bf16* K_lds = (bf16*)(lds + 2 * SHM_V);
  float* ws = (float*)(lds + 2 * SHM_V + 2 * SHM_K) + wid * 64; float* li_l = ws; float* al_l = ws + 32;
  float m_reg = -1e30f, l_reg = 0; f32x16 o[4] = {}; bf16x8 qr[8];
  const bf16* Qw = Qb + (long)(wid * QBLK + r32) * LD + hi * 8;
#pragma unroll
  for (int d0 = 0; d0 < 8; ++d0) qr[d0] = *reinterpret_cast<const bf16x8*>(Qw + d0 * 16);
  const int sr = tid >> 4, sc = (tid & 15) * 8, vst0 = v_st(sr, sc), vst1 = v_st(32 + sr, sc);
  const int vb0 = (int)(uintptr_t)V_lds + v_rd_base(lane);
  const int widu = __builtin_amdgcn_readfirstlane(wid);
  const int qrow = qrow0 + (widu >> 1), qcol = (wid & 1) * 32 + r32;
  int r0 = qrow - 4; r0 = r0 < 0 ? 0 : (r0 > 56 ? 56 : r0);
  int c0 = qcol - 8; c0 = c0 < 0 ? 0 : (c0 > 48 ? 48 : c0);
  bf16x8 vs0, vs1, ks0, ks1;
#define NA_TROW(j) ((j) < 4 ? 64 * (j) : 256 + 64 * (kr_lo + (j) - 4))
#define NA_SLOAD(k0) do { const long _k = (k0); vs0 = *reinterpret_cast<const bf16x8*>(&Vh[(_k + sr) * LD + sc]); vs1 = *reinterpret_cast<const bf16x8*>(&Vh[(_k + 32 + sr) * LD + sc]); \
    ks0 = *reinterpret_cast<const bf16x8*>(&Kh[(_k + sr) * LD + sc]); ks1 = *reinterpret_cast<const bf16x8*>(&Kh[(_k + 32 + sr) * LD + sc]); } while (0)
  NA_SLOAD(NA_TROW(0));
  for (int j = 0; j < NT; ++j) {
    __syncthreads();
    *(bf16x8*)((char*)V_lds + vst0) = vs0; *(bf16x8*)((char*)V_lds + vst1) = vs1;
    *(bf16x8*)((char*)K_lds + KSWZ(sr, sc * 2)) = ks0; *(bf16x8*)((char*)K_lds + KSWZ(32 + sr, sc * 2)) = ks1;
    if (j + 1 < NT) NA_SLOAD(NA_TROW(j + 1));
    __syncthreads();
    const int kr = kr_lo + j - 4;
    const bool rowok = (j < 4) || ((unsigned)(kr - r0) < 8u);
    if (rowok) {
      f32x16 p0, p1; float mn, al; bf16x8 pa0, pa1, pa2, pa3;
      qkt(p0, p1, K_lds, qr, r32, hi);
      if (j >= 4) {
        const int bbase = (kr - qrow + 7) * 31 + 15 - qcol;
#pragma unroll
        for (int r = 0; r < 16; ++r) {
          const int kc0 = crow(r, hi), kc1 = 32 + kc0;
          const bool ok0 = (unsigned)(kc0 - c0) < 16u, ok1 = (unsigned)(kc1 - c0) < 16u;
          const float b0 = ok0 ? bl[bbase + kc0] : 0.f, b1 = ok1 ? bl[bbase + kc1] : 0.f;
          p0[r] = ok0 ? p0[r] + b0 : -1e30f; p1[r] = ok1 ? p1[r] + b1 : -1e30f;
        }
      }
      partialSM(p0, p1, m_reg, mn, al);
      if (__any(al < 1.f)) { if (hi == 0) al_l[r32] = al; asm volatile("s_waitcnt lgkmcnt(0)" ::: "memory");
#pragma unroll
        for (int d = 0; d < 4; ++d)
#pragma unroll
          for (int r = 0; r < 16; ++r) o[d][r] *= al_l[crow(r, hi)]; }
      finishSM(p0, p1, al, l_reg, pa0, pa1, pa2, pa3); SBAR();
      pv_d0(o, vb0, pa0, pa1, pa2, pa3);
    }
  }
  if (hi == 0) li_l[r32] = l_reg; asm volatile("s_waitcnt lgkmcnt(0)" ::: "memory");
  float rli[16];
#pragma unroll
  for (int r = 0; r < 16; ++r) rli[r] = __builtin_amdgcn_rcpf(li_l[crow(r, hi)]);
  unsigned char* Ow = Ob + (long)(wid * QBLK) * DM;
#pragma unroll
  for (int r = 0; r < 16; ++r) { const int orow = crow(r, hi); const float sc_ = rli[r] * F8_ASCALE;
    const unsigned w = f8x4(o[0][r] * sc_, o[1][r] * sc_, o[2][r] * sc_, o[3][r] * sc_);
#pragma unroll
    for (int d0 = 0; d0 < 4; ++d0) Ow[(long)orow * DM + d0 * 32 + r32] = (unsigned char)(w >> (8 * d0)); }
  __syncthreads();
#undef NA_TROW
#undef NA_SLOAD
}
}


struct CtxGemm { const void* A; int lda; size_t a_gstride; const void* Bt; size_t b_gstride; int K; int ncb, cb0, ngroups; int out_gcol; };
struct CtxEpi {
    bf16* O; int ldc;
    const float* sa; const unsigned* cmax; const float* ssq_in; const float* sxb_in; const float* cvec;
    bf16* xres; const float* gate; const float* ls; signed char* XQ; float* ssq; const float* w2; const float* m4; const float* sxb; const float* xsrc;
};
template <int RESID, bool I8, bool F8 = false>
__device__ __forceinline__ void ctx_gemm(const CtxGemm cg, int t0, int tstride, char* lds, const CtxEpi ce) {
    const int tid = opaque_tid(), wid = __builtin_amdgcn_readfirstlane(tid >> 6), lane = tid & 63, j32 = lane & 31, hi = lane >> 5;
    const int ntile = cg.ngroups * 8 * cg.ncb; const int ksl = cg.K / 8;
    constexpr int ES = I8 ? 1 : 2, KS = I8 ? 32 : 16;
    float* P = (float*)lds;
    if (t0 < 0) return;
    for (int t = t0; t < ntile; t += tstride) {
        const int g = t / (8 * cg.ncb), rr = t % (8 * cg.ncb), rb = rr / cg.ncb, cb = rr % cg.ncb;
        const int r0 = (rb >> 2) * RPB + (rb & 3) * 64, c0 = (cg.cb0 + cb) * 64;
        const char* Ap = (const char*)cg.A + ((size_t)g * cg.a_gstride + (size_t)(r0 + j32) * cg.lda + wid * ksl) * ES + hi * 16;
        const char* Bp = (const char*)cg.Bt + ((size_t)g * cg.b_gstride + (size_t)(c0 + j32) * cg.K + wid * ksl) * ES + hi * 16;
        const size_t a32 = (size_t)32 * cg.lda * ES, b32 = (size_t)32 * cg.K * ES;
        f32x16 acc[2][2]; typedef int i32x16 __attribute__((ext_vector_type(16))); i32x16 acci[2][2];
#pragma unroll
        for (int m = 0; m < 2; ++m)
#pragma unroll
            for (int n = 0; n < 2; ++n) { acc[m][n] = f32x16{}; acci[m][n] = i32x16{}; }
#pragma unroll 8
        for (int ks = 0; ks < ksl / KS; ++ks) {
            const bf16x8 a0 = *(const bf16x8*)(Ap + ks * 32), a1 = *(const bf16x8*)(Ap + a32 + ks * 32);
            const bf16x8 b0 = *(const bf16x8*)(Bp + ks * 32), b1 = *(const bf16x8*)(Bp + b32 + ks * 32);
            if constexpr (F8) {
                typedef long l64x2 __attribute__((ext_vector_type(2)));
                const l64x2 la0 = __builtin_bit_cast(l64x2, a0), la1 = __builtin_bit_cast(l64x2, a1), lb0 = __builtin_bit_cast(l64x2, b0), lb1 = __builtin_bit_cast(l64x2, b1);
#pragma unroll
                for (int z = 0; z < 2; ++z) {
                    acc[0][0] = __builtin_amdgcn_mfma_f32_32x32x16_fp8_fp8(la0[z], lb0[z], acc[0][0], 0, 0, 0); acc[0][1] = __builtin_amdgcn_mfma_f32_32x32x16_fp8_fp8(la0[z], lb1[z], acc[0][1], 0, 0, 0);
                    acc[1][0] = __builtin_amdgcn_mfma_f32_32x32x16_fp8_fp8(la1[z], lb0[z], acc[1][0], 0, 0, 0); acc[1][1] = __builtin_amdgcn_mfma_f32_32x32x16_fp8_fp8(la1[z], lb1[z], acc[1][1], 0, 0, 0); }
            } else if constexpr (I8) {
                const pg8::i32x4 ia0 = __builtin_bit_cast(pg8::i32x4, a0), ia1 = __builtin_bit_cast(pg8::i32x4, a1), ib0 = __builtin_bit_cast(pg8::i32x4, b0), ib1 = __builtin_bit_cast(pg8::i32x4, b1);
                acci[0][0] = __builtin_amdgcn_mfma_i32_32x32x32_i8(ia0, ib0, acci[0][0], 0, 0, 0); acci[0][1] = __builtin_amdgcn_mfma_i32_32x32x32_i8(ia0, ib1, acci[0][1], 0, 0, 0);
                acci[1][0] = __builtin_amdgcn_mfma_i32_32x32x32_i8(ia1, ib0, acci[1][0], 0, 0, 0); acci[1][1] = __builtin_amdgcn_mfma_i32_32x32x32_i8(ia1, ib1, acci[1][1], 0, 0, 0);
            } else {
                acc[0][0] = __builtin_amdgcn_mfma_f32_32x32x16_bf16(a0, b0, acc[0][0], 0, 0, 0); acc[0][1] = __builtin_amdgcn_mfma_f32_32x32x16_bf16(a0, b1, acc[0][1], 0, 0, 0);
                acc[1][0] = __builtin_amdgcn_mfma_f32_32x32x16_bf16(a1, b0, acc[1][0], 0, 0, 0); acc[1][1] = __builtin_amdgcn_mfma_f32_32x32x16_bf16(a1, b1, acc[1][1], 0, 0, 0);
            }
        }
#pragma unroll
        for (int m = 0; m < 2; ++m)
#pragma unroll
            for (int n = 0; n < 2; ++n)
#pragma unroll
                for (int r = 0; r < 16; ++r) P[(wid * 64 + m * 32 + att::crow(r, hi)) * 64 + n * 32 + j32] = (I8 && !F8) ? (float)acci[m][n][r] : acc[m][n][r];
        __syncthreads();
        { const int row = tid >> 3, c8 = (tid & 7) * 8; f32x4 s0 = {0.f, 0.f, 0.f, 0.f}, s1 = s0;
#pragma unroll
          for (int w = 0; w < 8; ++w) { const f32x4* pp = (const f32x4*)(P + (w * 64 + row) * 64 + c8); s0 += pp[0]; s1 += pp[1]; }
          const int orow = r0 + row, ocol = g * cg.out_gcol + c0 + c8;
          if (F8) { s0 = s0 * (1.f / (F8_ASCALE * F8_WSCALE)); s1 = s1 * (1.f / (F8_ASCALE * F8_WSCALE)); }
          if (RESID) { bf16* xp = ce.xres + (size_t)orow * DM + ocol; f32x4 g0 = *(const f32x4*)(ce.gate + ocol), g1 = *(const f32x4*)(ce.gate + ocol + 4);
              if (ce.ls) { g0 = g0 * *(const f32x4*)(ce.ls + ocol); g1 = g1 * *(const f32x4*)(ce.ls + ocol + 4); }
              f32x4 r0, r1;
              if (ce.xsrc) { const float* xs = ce.xsrc + ((size_t)((rb >> 2) * CTX + (rb & 3) * 64 + row) * DM + ocol); r0 = *(const f32x4*)xs; r1 = *(const f32x4*)(xs + 4); }
              else { const u32x4 w = *(const u32x4*)xp; r0 = bf4((u32x2){w.x, w.y}); r1 = bf4((u32x2){w.z, w.w}); }
              const f32x4 x0 = r0 + s0 * g0, x1 = r1 + s1 * g1;
              { u32x4 w; w.x = pk2(x0.x, x0.y); w.y = pk2(x0.z, x0.w); w.z = pk2(x1.x, x1.y); w.w = pk2(x1.z, x1.w); *(u32x4*)xp = w; }
              const float qi = 1.f / ce.sxb[orow];
              const f32x4 h0 = x0 * (*(const f32x4*)(ce.w2 + ocol) * (*(const f32x4*)(ce.m4 + ocol) + 1.f)) * qi, h1 = x1 * (*(const f32x4*)(ce.w2 + ocol + 4) * (*(const f32x4*)(ce.m4 + ocol + 4) + 1.f)) * qi;
              int q[8] = {(int)__builtin_rintf(h0.x), (int)__builtin_rintf(h0.y), (int)__builtin_rintf(h0.z), (int)__builtin_rintf(h0.w), (int)__builtin_rintf(h1.x), (int)__builtin_rintf(h1.y), (int)__builtin_rintf(h1.z), (int)__builtin_rintf(h1.w)};
#pragma unroll
              for (int e = 0; e < 8; ++e) q[e] = q[e] < -127 ? -127 : (q[e] > 127 ? 127 : q[e]);
              u32x2 w; w.x = (unsigned)(q[0] & 255) | ((unsigned)(q[1] & 255) << 8) | ((unsigned)(q[2] & 255) << 16) | ((unsigned)(q[3] & 255) << 24);
              w.y = (unsigned)(q[4] & 255) | ((unsigned)(q[5] & 255) << 8) | ((unsigned)(q[6] & 255) << 16) | ((unsigned)(q[7] & 255) << 24); *(u32x2*)(ce.XQ + (size_t)orow * DM + ocol) = w;
              float ss = ((x0.x * x0.x + x0.y * x0.y) + (x0.z * x0.z + x0.w * x0.w)) + ((x1.x * x1.x + x1.y * x1.y) + (x1.z * x1.z + x1.w * x1.w));
              ss += shx(ss, 1); ss += shx(ss, 2); ss += shx(ss, 4);
              if ((tid & 7) == 0) ce.ssq[(size_t)orow * 32 + g * cg.ncb + cb] = ss; }
          else { if (I8 && !F8) { float r = ce.sa ? ce.sa[orow] : 1.f;
                  if (ce.ssq_in) { float q = ce.ssq_in[(size_t)orow * 32 + (tid & 7) * 4] + ce.ssq_in[(size_t)orow * 32 + (tid & 7) * 4 + 1] + ce.ssq_in[(size_t)orow * 32 + (tid & 7) * 4 + 2] + ce.ssq_in[(size_t)orow * 32 + (tid & 7) * 4 + 3];
                      q += shx(q, 1); q += shx(q, 2); q += shx(q, 4); r = ce.sxb_in[orow] / sqrtf(q * (1.f / DM) + EPS); }
                  const u32x4 a_ = *(const u32x4*)(ce.cmax + ocol), b_ = *(const u32x4*)(ce.cmax + ocol + 4); r *= (1.f / 127.f);
                  s0 = s0 * ((f32x4){__uint_as_float(a_.x), __uint_as_float(a_.y), __uint_as_float(a_.z), __uint_as_float(a_.w)} * r);
                  s1 = s1 * ((f32x4){__uint_as_float(b_.x), __uint_as_float(b_.y), __uint_as_float(b_.z), __uint_as_float(b_.w)} * r);
                  if (ce.cvec) { s0 = s0 + *(const f32x4*)(ce.cvec + ocol); s1 = s1 + *(const f32x4*)(ce.cvec + ocol + 4); } }
              u32x4 w; w.x = pk2(s0.x, s0.y); w.y = pk2(s0.z, s0.w); w.z = pk2(s1.x, s1.y); w.w = pk2(s1.z, s1.w); *(u32x4*)(ce.O + (size_t)orow * ce.ldc + ocol) = w; } }
        __syncthreads();
    }
}

constexpr size_t MiB = 1u << 20;
constexpr size_t WS_CTL = 0, CTL_ZERO_BYTES = 1 * MiB;
constexpr size_t WS_MODV = 1 * MiB;
constexpr size_t WS_MODP = 2 * MiB;
constexpr size_t WS_X    = 22 * MiB;
constexpr size_t WS_H    = 92 * MiB;
constexpr size_t WS_QKV  = 128 * MiB;
constexpr size_t WS_O    = 232 * MiB;
constexpr size_t WS_PQ   = 268 * MiB;
constexpr size_t WS_IDX  = 304 * MiB;
constexpr size_t WS_GATE = 310 * MiB;
constexpr size_t WS_AWQKV = 316 * MiB;
constexpr size_t WS_AWO   = 340 * MiB;
constexpr size_t WS_BWQKV = 356 * MiB;
constexpr size_t WS_BWO   = 380 * MiB;
constexpr size_t WS_PW    = 388 * MiB;
constexpr size_t WS_PWQ   = 390 * MiB;
constexpr size_t WS_SK    = 422 * MiB;
constexpr size_t WS_SU    = 423 * MiB, WS_SV = WS_SU + 512 * 1024;
constexpr size_t WS_SSQ   = 314 * MiB + 512 * 1024;
constexpr size_t WS_SA    = WS_MODV + 768 * 1024;
constexpr size_t WS_CMAX  = 64 * 1024;
constexpr size_t WS_CVEC  = WS_MODV + 640 * 1024;
constexpr size_t WS_U     = 424 * MiB;
constexpr size_t WS_V     = 552 * MiB;
constexpr size_t WS_END   = 680 * MiB;

constexpr int LDS_BYTES = 147456;
constexpr int MISC_OFF = 131072 + 320;
constexpr int NPHASE = 2 + 4 * 9 + 1;

struct Args {
    const float *x, *c, *ctx, *c_ctx, *mod_w, *mod_b, *norm_w, *final_norm_w, *a_wqkv, *a_q_gain, *a_k_gain, *a_wo, *b_wqkv, *b_rpb, *b_wo, *pool_w, *pool_scale,
                *peer_wq, *peer_sub_keys, *peer_u, *peer_v;
    float* out; unsigned char* ws; int ph_lo, ph_hi;
};

__device__ __forceinline__ void p0_transpose_item(const float* W, int K, int N, bf16* WT, LAS float* scr, int item, int lane) {
    const int nblk = N / 32, kb = item / nblk, nb = item % nblk, k0 = 64 * kb, n0 = 32 * nb;
#pragma unroll
    for (int i = 0; i < 32; ++i) { const int kk = 2 * i + (lane >> 5); scr[kk * 33 + (lane & 31)] = W[(size_t)(k0 + kk) * N + n0 + (lane & 31)]; }
    asm volatile("s_waitcnt lgkmcnt(0)" ::: "memory");
    const int c = lane & 7;
#pragma unroll
    for (int j = 0; j < 4; ++j) { const int n = (lane >> 3) + 8 * j; const LAS float* s = scr + (8 * c) * 33 + n;
        u32x4 o; o.x = pk2(s[0 * 33], s[1 * 33]); o.y = pk2(s[2 * 33], s[3 * 33]); o.z = pk2(s[4 * 33], s[5 * 33]); o.w = pk2(s[6 * 33], s[7 * 33]);
        *(u32x4*)(WT + (size_t)(n0 + n) * K + k0 + 8 * c) = o; }
    asm volatile("s_waitcnt lgkmcnt(0)" ::: "memory");
}

__device__ __forceinline__ void p0_transpose_f8_item(const float* W, int K, int N, unsigned char* WT, LAS float* scr, int item, int lane) {
    const int nblk = N / 32, kb = item / nblk, nb = item % nblk, k0 = 64 * kb, n0 = 32 * nb;
#pragma unroll
    for (int i = 0; i < 32; ++i) { const int kk = 2 * i + (lane >> 5); scr[kk * 33 + (lane & 31)] = W[(size_t)(k0 + kk) * N + n0 + (lane & 31)]; }
    asm volatile("s_waitcnt lgkmcnt(0)" ::: "memory");
    const int c = lane & 7;
#pragma unroll
    for (int j = 0; j < 4; ++j) { const int n = (lane >> 3) + 8 * j; const LAS float* s = scr + (8 * c) * 33 + n;
        u32x2 o; o.x = f8x4(s[0 * 33] * F8_WSCALE, s[1 * 33] * F8_WSCALE, s[2 * 33] * F8_WSCALE, s[3 * 33] * F8_WSCALE); o.y = f8x4(s[4 * 33] * F8_WSCALE, s[5 * 33] * F8_WSCALE, s[6 * 33] * F8_WSCALE, s[7 * 33] * F8_WSCALE);
        *(u32x2*)(WT + (size_t)(n0 + n) * K + k0 + 8 * c) = o; }
    asm volatile("s_waitcnt lgkmcnt(0)" ::: "memory");
}

__device__ __forceinline__ void p0_colmax_item(const float* W, int N, unsigned* cmax, int item, int lane) {
    const int nblk = N / 32, kb = item / nblk, nb = item % nblk, k0 = 64 * kb, n0 = 32 * nb; float m = 0.f;
#pragma unroll
    for (int i = 0; i < 32; ++i) { const int kk = 2 * i + (lane >> 5); m = fmaxf(m, fabsf(W[(size_t)(k0 + kk) * N + n0 + (lane & 31)])); }
    m = fmaxf(m, shx(m, 32));
    if (lane < 32) atomicMax(cmax + n0 + lane, __float_as_uint(m));
}
__device__ __forceinline__ void p1_transpose_q_item(const float* W, int K, int N, signed char* WT, const unsigned* cmax, LAS float* scr, int item, int lane) {
    const int nblk = N / 32, kb = item / nblk, nb = item % nblk, k0 = 64 * kb, n0 = 32 * nb;
#pragma unroll
    for (int i = 0; i < 32; ++i) { const int kk = 2 * i + (lane >> 5); scr[kk * 33 + (lane & 31)] = W[(size_t)(k0 + kk) * N + n0 + (lane & 31)]; }
    asm volatile("s_waitcnt lgkmcnt(0)" ::: "memory");
    const int c = lane & 7;
#pragma unroll
    for (int j = 0; j < 4; ++j) { const int n = (lane >> 3) + 8 * j; const LAS float* sp = scr + (8 * c) * 33 + n; const float inv = 127.f / fmaxf(__uint_as_float(cmax[n0 + n]), 1e-30f);
        int q[8];
#pragma unroll
        for (int e = 0; e < 8; ++e) q[e] = (int)__builtin_rintf(sp[e * 33] * inv);
        u32x2 o; o.x = (unsigned)(q[0] & 255) | ((unsigned)(q[1] & 255) << 8) | ((unsigned)(q[2] & 255) << 16) | ((unsigned)(q[3] & 255) << 24);
        o.y = (unsigned)(q[4] & 255) | ((unsigned)(q[5] & 255) << 8) | ((unsigned)(q[6] & 255) << 16) | ((unsigned)(q[7] & 255) << 24);
        *(u32x2*)(WT + (size_t)(n0 + n) * K + k0 + 8 * c) = o; }
    asm volatile("s_waitcnt lgkmcnt(0)" ::: "memory");
}

template <bool XB16 = false, bool PRE = false>
__device__ __forceinline__ void norm_mod_row_q(const void* xrow  , const float* w, const float* shift, const float* scale, signed char* orow, float* sa, const float* w2, const float* m4, float* sxb, int lane) {
    f32x4 v[8]; float ss = 0.f;
#pragma unroll
    for (int j = 0; j < 8; ++j) { v[j] = PRE ? (XB16 ? bf4(((const u32x2*)xrow)[j]) : ((const f32x4*)xrow)[j]) : (XB16 ? bf4(((const u32x2*)xrow)[lane + 64 * j]) : ((const f32x4*)xrow)[lane + 64 * j]); ss += (v[j].x * v[j].x + v[j].y * v[j].y) + (v[j].z * v[j].z + v[j].w * v[j].w); }
    const float rstd = 1.f / sqrtf(wave_sum(ss) * (1.f / DM) + EPS);
    float am = 0.f, am2 = 0.f;
#pragma unroll
    for (int j = 0; j < 8; ++j) { const int c = (lane + 64 * j) * 4;
        const f32x4 wv = *(const f32x4*)(w + c), sh = *(const f32x4*)(shift + c), sc = *(const f32x4*)(scale + c);
        if (sxb) { const f32x4 g2 = v[j] * (*(const f32x4*)(w2 + c) * (*(const f32x4*)(m4 + c) + 1.f)); am2 = fmaxf(am2, fmaxf(fmaxf(fabsf(g2.x), fabsf(g2.y)), fmaxf(fabsf(g2.z), fabsf(g2.w)))); }
        v[j] = (v[j] * rstd * wv) * (sc + 1.f) + sh; }
#pragma unroll
    for (int o = 1; o < 64; o <<= 1) am2 = fmaxf(am2, shx(am2, o));
    unsigned* o4 = (unsigned*)orow + lane;
#pragma unroll
    for (int j = 0; j < 8; ++j) o4[64 * j] = f8x4(v[j].x * F8_ASCALE, v[j].y * F8_ASCALE, v[j].z * F8_ASCALE, v[j].w * F8_ASCALE);
    (void)am; (void)sa;
    if (lane == 0 && sxb) *sxb = fmaxf(am2, 1e-30f) * (1.25f / 127.f);
}

__device__ __forceinline__ float gelu_tanh(float x) {
    const float z = 0.7978845608028654f * (x + 0.044715f * x * x * x);
    const float e = __expf(2.f * z);
    const float t = 1.f - 2.f / (1.f + e);
    return 0.5f * x * (1.f + t);
}

__device__ __forceinline__ unsigned mono(float f) { const unsigned u = __float_as_uint(f); return u ^ ((unsigned)((int)u >> 31) | 0x80000000u); }
__device__ __forceinline__ float unmono(unsigned m) { const unsigned u = (m & 0x80000000u) ? (m ^ 0x80000000u) : ~m; return __uint_as_float(u); }
#define CEX(a, b) do { const unsigned _h = (a) > (b) ? (a) : (b), _l = (a) > (b) ? (b) : (a); (a) = _h; (b) = _l; } while (0)
__device__ __forceinline__ void bmerge16_desc(unsigned (&t)[16]) {
#pragma unroll
    for (int d = 8; d >= 1; d >>= 1)
#pragma unroll
        for (int i = 0; i < 16; ++i) if ((i & d) == 0) CEX(t[i], t[i + d]);
}
__device__ __forceinline__ void sort16_desc(unsigned (&t)[16]) {
#pragma unroll
    for (int k = 2; k <= 16; k <<= 1)
#pragma unroll
        for (int j = k >> 1; j >= 1; j >>= 1)
#pragma unroll
            for (int i = 0; i < 16; ++i) { const int p = i ^ j; if (p > i) { if ((i & k) == 0) CEX(t[i], t[p]); else CEX(t[p], t[i]); } }
}
__device__ __forceinline__ void merge_top16(unsigned (&a)[16], const unsigned (&b)[16]) {
#pragma unroll
    for (int i = 0; i < 16; ++i) a[i] = a[i] > b[15 - i] ? a[i] : b[15 - i];
    bmerge16_desc(a);
}
#define INS16(L, x) do { unsigned _x = (x); _Pragma("unroll") for (int _j = 0; _j < 16; ++_j) { const unsigned _t = L[_j] > _x ? L[_j] : _x; _x = L[_j] > _x ? _x : L[_j]; L[_j] = _t; } } while (0)

typedef const __attribute__((address_space(4))) Args CArgs;
__global__ void __launch_bounds__(512, 2) fwd_kernel(Args a_kern) {
    CArgs& a = *(CArgs*)__builtin_amdgcn_kernarg_segment_ptr();
    extern __shared__ __attribute__((aligned(16))) unsigned char lds[];
    LAS unsigned char* L3 = (LAS unsigned char*)lds;
    volatile LAS unsigned* MISC = (volatile LAS unsigned*)(L3 + MISC_OFF);
    const int G = gridDim.x; const int bx = blockIdx.x; const int vcu = (G % 8 == 0) ? (bx % 8) * (G / 8) + bx / 8 : bx;
    const int NGW = G * 8;
    if (threadIdx.x < 32) MISC[threadIdx.x] = 0u;
    if ((threadIdx.x & 63) == 0) ((volatile LAS unsigned char*)L3)[TID_TABLE_OFF + hw_slot()] = (unsigned char)(threadIdx.x >> 6);
    __syncthreads();
    XcdBarrier bar; bar.bar = (unsigned*)(a.ws + WS_CTL) + 4096; bar.x = 0; bar.st = nullptr;
#if ONE_LAUNCH
    bar = xcd_barrier_post((unsigned*)(a.ws + WS_CTL) + 4096, MISC + 8);
#endif
    const int lo = a.ph_lo, hi_ph = a.ph_hi;
#define IN(k) (lo <= (k) && (k) < hi_ph)
#if ONE_LAUNCH
#define SEAM(k) do { if (IN(k) && IN((k) + 1)) xcd_barrier(bar); } while (0)
#else
#define SEAM(k) do { } while (0)
#endif
#define WS_LAUNDER() CArgs* ap_ = (CArgs*)__builtin_amdgcn_kernarg_segment_ptr(); asm volatile("" : "+s"(ap_)); CArgs& a = *ap_; GAS unsigned char* wsg_ = (GAS unsigned char*)a.ws; asm volatile("" : "+s"(wsg_)); unsigned char* wsl = (unsigned char*)wsg_;     const int tid = opaque_tid(), lane = tid & 63, wave = __builtin_amdgcn_readfirstlane(tid >> 6), gw = vcu * 8 + wave; (void)lane; (void)gw
#define modv  ((float*)(wsl + WS_MODV))
#define modp  ((float*)(wsl + WS_MODP))
#define X     ((bf16*)(wsl + WS_X))
#define H     ((bf16*)(wsl + WS_H))
#define QKV   ((bf16*)(wsl + WS_QKV))
#define OB    ((unsigned char*)(wsl + WS_O))
#define PQ    ((bf16*)(wsl + WS_PQ))
#define IDX   ((int*)(wsl + WS_IDX))
#define V8T   ((unsigned char*)(wsl + WS_IDX))
#define GATE  ((float*)(wsl + WS_GATE))
#define K8B   ((unsigned char*)(wsl + WS_GATE))
#define AWQKV ((bf16*)(wsl + WS_AWQKV))
#define AWO   ((unsigned char*)(wsl + WS_AWO))
#define BWQKV ((bf16*)(wsl + WS_BWQKV))
#define BWO   ((unsigned char*)(wsl + WS_BWO))
#define PW    ((unsigned char*)(wsl + WS_PW))
#define PWQ   ((bf16*)(wsl + WS_PWQ))
#define SK    ((bf16*)(wsl + WS_SK))
#define U8    ((unsigned char*)(wsl + WS_U))
#define V8    ((unsigned char*)(wsl + WS_V))
#define SU    ((float*)(wsl + WS_SU))
#define SV    ((float*)(wsl + WS_SV))
#define SSQ   ((float*)(wsl + WS_SSQ))
#define HQ    ((signed char*)(wsl + WS_H))
#define SA    ((float*)(wsl + WS_SA))
#define SXB   ((float*)(wsl + WS_SA) + MR)
#define CMAX  ((unsigned*)(wsl + WS_CMAX))
#define AWQKV8 ((signed char*)(wsl + WS_AWQKV))
#define BWQKV8 ((signed char*)(wsl + WS_BWQKV))
#define PWQ8  ((signed char*)(wsl + WS_PWQ))
#define CVEC  ((float*)(wsl + WS_CVEC))
    unsigned long long tacc = 0ull, tbeg = 0ull; (void)tbeg;
#define T0(b) do { if (TMON(b)) tbeg = __builtin_amdgcn_s_memrealtime(); } while (0)
#define T1(b) do { if (TMON(b)) tacc += __builtin_amdgcn_s_memrealtime() - tbeg; } while (0)
    T0(0);
    if (PHM(0) && IN(0)) { WS_LAUNDER();
        float* sm = (float*)lds;
        for (int it = bx; it < 4 * 6 * 32; it += G) {
            const int Lr = it / 192, r = it % 192, cc = r / 32, kc = r % 32;
            __syncthreads();
            if (tid < 192) { const int v = tid >> 6, k = kc * 64 + (tid & 63); const float cv = (v < 2) ? a.c[v * DM + k] : a.c_ctx[k]; sm[tid] = cv / (1.f + __expf(-cv)); }
            __syncthreads();
            const float* W = a.mod_w + ((size_t)Lr * DM + kc * 64) * NMOD + cc * 2048 + tid * 4;
            f32x4 a0 = {0.f, 0.f, 0.f, 0.f}, a1 = a0, a2 = a0;
#pragma unroll 8
            for (int k = 0; k < 64; ++k) { const f32x4 w = __builtin_nontemporal_load((const f32x4*)(W + (size_t)k * NMOD)); a0 += w * sm[k]; a1 += w * sm[64 + k]; a2 += w * sm[128 + k]; }
            float* P = modp + (((size_t)Lr * 32 + kc) * 3) * NMOD + cc * 2048 + tid * 4;
            *(f32x4*)P = a0; *(f32x4*)(P + NMOD) = a1; *(f32x4*)(P + 2 * NMOD) = a2;
        }
        __syncthreads();
        {
            for (int rr = gw; rr < 2 * 4 * NEXP; rr += 2 * NGW) {
                const int rB = rr + NGW; const bool hasB = rB < 2 * 4 * NEXP;
                const bool isuA = rr < 4 * NEXP, isuB = rB < 4 * NEXP; const int rA = isuA ? rr : rr - 4 * NEXP, rBq = hasB ? (isuB ? rB : rB - 4 * NEXP) : rA;
                const f32x4* srcA = (const f32x4*)((isuA ? a.peer_u : a.peer_v) + (size_t)rA * DM) + lane;
                const f32x4* srcB = (const f32x4*)(((hasB ? isuB : isuA) ? a.peer_u : a.peer_v) + (size_t)rBq * DM) + lane;
                f32x4 vA[8], vB[8]; float amA = 0.f, amB = 0.f;
#pragma unroll
                for (int j = 0; j < 8; ++j) { vA[j] = __builtin_nontemporal_load(srcA + 64 * j); vB[j] = __builtin_nontemporal_load(srcB + 64 * j); }
#pragma unroll
                for (int j = 0; j < 8; ++j) { amA = fmaxf(amA, fmaxf(fmaxf(fabsf(vA[j].x), fabsf(vA[j].y)), fmaxf(fabsf(vA[j].z), fabsf(vA[j].w))));
                    amB = fmaxf(amB, fmaxf(fmaxf(fabsf(vB[j].x), fabsf(vB[j].y)), fmaxf(fabsf(vB[j].z), fabsf(vB[j].w)))); }
#pragma unroll
                for (int o = 1; o < 64; o <<= 1) { amA = fmaxf(amA, shx(amA, o)); amB = fmaxf(amB, shx(amB, o)); }
#pragma unroll
                for (int half = 0; half < 2; ++half) {
                    if (half == 1 && !hasB) break;
                    const bool isu = half ? isuB : isuA; const int r = half ? rBq : rA; const float am = fmaxf(half ? amB : amA, 1e-30f);
                    const float inv = (isu ? 127.f : 440.f) / am;
                    unsigned* dst = (unsigned*)((isu ? U8 : V8) + (size_t)r * DM) + lane;
#pragma unroll
                    for (int j = 0; j < 8; ++j) { const f32x4 vv = half ? vB[j] : vA[j];
                        if (isu) { const int q0 = (int)__builtin_rintf(vv.x * inv), q1 = (int)__builtin_rintf(vv.y * inv), q2 = (int)__builtin_rintf(vv.z * inv), q3 = (int)__builtin_rintf(vv.w * inv);
                            dst[64 * j] = (unsigned)(q0 & 255) | ((unsigned)(q1 & 255) << 8) | ((unsigned)(q2 & 255) << 16) | ((unsigned)(q3 & 255) << 24); }
                        else { int w = 0; w = __builtin_amdgcn_cvt_pk_fp8_f32(vv.x * inv, vv.y * inv, w, false); w = __builtin_amdgcn_cvt_pk_fp8_f32(vv.z * inv, vv.w * inv, w, true); dst[64 * j] = (unsigned)w; } }
                    if (lane == 0) (isu ? SU : SV)[r] = am * (isu ? (1.f / 127.f) : (1.f / 440.f));
                }
            }
            const size_t gt = (size_t)bx * 512 + tid, nth = (size_t)G * 512;
            const size_t nk8 = (size_t)4 * 2 * 128 * 128 / 8;
            for (size_t i = gt; i < nk8; i += nth) {
                const f32x4* sp = (const f32x4*)(a.peer_sub_keys + i * 8); const f32x4 x0 = sp[0], x1 = sp[1];
                u32x4 o; o.x = pk2(x0.x, x0.y); o.y = pk2(x0.z, x0.w); o.z = pk2(x1.x, x1.y); o.w = pk2(x1.z, x1.w);
                *(u32x4*)(SK + i * 8) = o;
            }
        }
        {
            LAS float* scr = (LAS float*)(L3 + wave * 16384);
            constexpr int I_AQ = 32 * 96, I_AO = 32 * 64, I_BQ = 32 * 192, I_BO = 32 * 64, I_PW = 8 * 16, I_WQ = 32 * 64;
            constexpr int NIT = 2 * I_AO + I_BO + 4 * I_PW + 2 * I_AQ + I_BQ + 4 * I_WQ;
            for (int it = gw; it < NIT; it += NGW) {
                int r = it;
                if (r < 2 * I_AO) { const int j = r / I_AO; p0_transpose_f8_item(a.a_wo + (size_t)j * DM * DM, DM, DM, AWO + (size_t)j * DM * DM, scr, r % I_AO, lane); continue; } r -= 2 * I_AO;
                if (r < I_BO) { p0_transpose_f8_item(a.b_wo, DM, DM, BWO, scr, r, lane); continue; } r -= I_BO;
                if (r < 4 * I_PW) { const int j = r / I_PW; p0_transpose_f8_item(a.pool_w + (size_t)j * 512 * 512, 512, 512, PW + (size_t)j * 512 * 512, scr, r % I_PW, lane); continue; } r -= 4 * I_PW;
                if (r < 2 * I_AQ) { const int j = r / I_AQ; p0_transpose_f8_item(a.a_wqkv + (size_t)j * DM * 3072, DM, 3072, (unsigned char*)AWQKV8 + (size_t)j * 3072 * DM, scr, r % I_AQ, lane); continue; } r -= 2 * I_AQ;
                if (r < I_BQ) { p0_transpose_f8_item(a.b_wqkv, DM, 6144, (unsigned char*)BWQKV8, scr, r, lane); continue; } r -= I_BQ;
                { const int j = r / I_WQ; p0_colmax_item(a.peer_wq + (size_t)j * DM * DM, DM, CMAX + 12288 + j * DM, r % I_WQ, lane); }
            }
        }
    }
    SEAM(0); T1(0);
    T0(1);
    if (PHM(1) && IN(1)) { WS_LAUNDER();
        for (int i = bx * 512 + tid; i < 4 * 3 * NMOD; i += G * 512) {
            const int Lr = i / (3 * NMOD), r = i % (3 * NMOD), n = r % NMOD;
            float s = a.mod_b[Lr * NMOD + n];
            for (int kc = 0; kc < 32; ++kc) s += modp[((size_t)Lr * 32 + kc) * 3 * NMOD + r];
            modv[i] = s;
        }
        {
            LAS float* scr = (LAS float*)(L3 + wave * 16384);
            constexpr int I_WQ = 32 * 64; constexpr int NIT = 4 * I_WQ;
            for (int it = gw; it < NIT; it += NGW) {
                int r = it;
                { const int j = r / I_WQ; p1_transpose_q_item(a.peer_wq + (size_t)j * DM * DM, DM, DM, PWQ8 + (size_t)j * DM * DM, CMAX + 12288 + j * DM, scr, r % I_WQ, lane); }
            }
        }
    }
    SEAM(1); T1(1);

    for (int Lr = 0; Lr < 4; ++Lr) {
        const int kind = Lr % 3, jj = Lr / 3, pb = 2 + Lr * 9;
#define modl (modv + (size_t)Lr * 3 * NMOD)
        T0(2);
        if (Lr == 0 && MIXON(Lr) && PHM(2) && IN(pb + 0)) { WS_LAUNDER();
            const float* w = a.norm_w + (size_t)(Lr * 2 + 0) * DM;
            for (int row0 = gw; row0 < MR; row0 += 3 * NGW) {
                f32x4 xin[3][8];
#pragma unroll
                for (int n = 0; n < 3; ++n) { const int row = row0 + n * NGW < MR ? row0 + n * NGW : row0; const int b = row / RPB, r = row % RPB;
                    const f32x4* srow = (const f32x4*)(r < CTX ? a.ctx + ((size_t)b * CTX + r) * DM : a.x + ((size_t)b * SEQ + (r - CTX)) * DM) + lane;
#pragma unroll
                    for (int j = 0; j < 8; ++j) xin[n][j] = srow[64 * j]; }
#pragma unroll
                for (int n = 0; n < 3; ++n) { const int row = row0 + n * NGW; if (row >= MR) break; const int b = row / RPB, r = row % RPB, v = r < CTX ? 2 : b; const float* mv = modl + (size_t)v * NMOD;
                    norm_mod_row_q<false, true>(xin[n], w, mv + 0 * DM, mv + 1 * DM, HQ + (size_t)row * DM, SA + row, a.norm_w + (size_t)(Lr * 2 + 1) * DM, mv + 4 * DM, SXB + row, lane); }
            }
            for (int task = gw; task < 4 * DM; task += NGW) {
                const int L4 = task / DM, n = task % DM; const u32x4* wr_ = (const u32x4*)(PWQ8 + ((size_t)L4 * DM + n) * DM) + lane; const float* m3b = modv + (size_t)L4 * 3 * NMOD + 3 * DM;
                float d0 = 0.f, d1 = 0.f, d2 = 0.f;
#pragma unroll
                for (int c = 0; c < 2; ++c) { const u32x4 wv = wr_[c * 64]; const unsigned ww[4] = {wv.x, wv.y, wv.z, wv.w}; const int k0 = c * 1024 + lane * 16;
#pragma unroll
                    for (int j = 0; j < 4; ++j)
#pragma unroll
                        for (int e = 0; e < 4; ++e) { const float wl = (float)(signed char)(ww[j] >> (8 * e)); const int k = k0 + 4 * j + e;
                            d0 += wl * m3b[k]; d1 += wl * m3b[NMOD + k]; d2 += wl * m3b[2 * NMOD + k]; } }
                { const float sbn = __uint_as_float(CMAX[12288 + L4 * DM + n]) * (1.f / 127.f); d0 = wave_sum(d0) * sbn; d1 = wave_sum(d1) * sbn; d2 = wave_sum(d2) * sbn; }
                if (lane == 0) { float* cv = CVEC + (size_t)L4 * 3 * DM + n; cv[0] = d0; cv[DM] = d1; cv[2 * DM] = d2; }
            }
        }
        if (Lr == 0) SEAM(pb + 0);
        T1(2);
        T0(3);
        if (MIXON(Lr) && PHM(3) && IN(pb + 1)) { WS_LAUNDER();
            if (kind != 2) { const int N = kind == 0 ? 3072 : 6144; const signed char* Wt = kind == 0 ? AWQKV8 + (size_t)jj * 3072 * DM : BWQKV8; const unsigned* cm = CMAX + (kind == 0 ? jj * 3072 : 6144);
                pg8::Gemm g{(const bf16*)HQ, (const bf16*)Wt, MR, N, DM};
                pg8::FlexOrder S; S.init(MR, N, G, bx, 2); pg8::EpiBf16Q E{QKV, N, SA, cm};
                pg8::gemm_phase<pg8::EpiBf16Q, pg8::FlexOrder, true, true>(L3, g, S, E);
                const CtxGemm cgm{HQ, DM, 0, Wt, 0, DM, Lr == 3 ? 16 : N / 64, Lr == 3 ? 32 : 0, 1, 0};
                const bool half = (N == 3072) && (G == 256);
                CtxEpi ce{}; ce.O = QKV; ce.ldc = N; ce.sa = SA; ce.cmax = cm;
                ctx_gemm<0, true, true>(cgm, half ? (bx >= 128 ? bx - 128 : -1) : vcu, half ? 128 : G, (char*)lds, ce); }
            else {
                for (int row = gw; row < MR; row += NGW) {
                    const int r = row % RPB; const int isl = r >= CTX; const int t = isl ? r - CTX : r, Ls = isl ? SEQ : CTX; const int row0 = row - t;
                    u32x2 hv[30];
#pragma unroll
                    for (int g = 0; g < 4; ++g) { const int w = 2 << g, ob = w - 2;
#pragma unroll
                        for (int o = 0; o < w; ++o) { const int q = t - w / 2 + o; const bool ok = (q >= 0) && (q < Ls);
                            hv[ob + o] = *(const u32x2*)(HQ + (size_t)(row0 + (ok ? q : t)) * DM + g * 512 + lane * 8); } }
#pragma unroll
                    for (int g = 0; g < 4; ++g) { const int w = 2 << g, ob = w - 2;
                        int lo_ = t - w / 2; lo_ = lo_ < 0 ? 0 : lo_; int hi_ = t + w - w / 2; hi_ = hi_ > Ls ? Ls : hi_;
                        float s[8] = {0.f, 0.f, 0.f, 0.f, 0.f, 0.f, 0.f, 0.f}, hf[8];
#pragma unroll
                        for (int o = 0; o < w; ++o) { const int q = t - w / 2 + o; const float m_ = ((q >= 0) && (q < Ls)) ? 1.f : 0.f; const u32x2 h_ = hv[ob + o];
                            const f32x2 a0 = __builtin_amdgcn_cvt_pk_f32_fp8((int)h_.x, false), a1 = __builtin_amdgcn_cvt_pk_f32_fp8((int)h_.x, true), a2 = __builtin_amdgcn_cvt_pk_f32_fp8((int)h_.y, false), a3 = __builtin_amdgcn_cvt_pk_f32_fp8((int)h_.y, true);
                            s[0] += m_ * a0.x; s[1] += m_ * a0.y; s[2] += m_ * a1.x; s[3] += m_ * a1.y; s[4] += m_ * a2.x; s[5] += m_ * a2.y; s[6] += m_ * a3.x; s[7] += m_ * a3.y;
                            if (o == w / 2) { hf[0] = a0.x; hf[1] = a0.y; hf[2] = a1.x; hf[3] = a1.y; hf[4] = a2.x; hf[5] = a2.y; hf[6] = a3.x; hf[7] = a3.y; } }
                        const float ic = 1.f / (float)(hi_ - lo_);
                        u32x2 o; o.x = f8x4(s[0] * ic - hf[0], s[1] * ic - hf[1], s[2] * ic - hf[2], s[3] * ic - hf[3]);
                        o.y = f8x4(s[4] * ic - hf[4], s[5] * ic - hf[5], s[6] * ic - hf[6], s[7] * ic - hf[7]);
                        *(u32x2*)(OB + ((size_t)g * MR + row) * 512 + lane * 8) = o;
                    }
                }
            }
        }
        SEAM(pb + 1); T1(3);
        T0(4);
        if (MIXON(Lr) && PHM(4) && IN(pb + 2) && kind == 0) { WS_LAUNDER();
            const float* kg = a.a_k_gain + jj * 128;
            const int i = lane & 31, base = (lane >> 5) * 64;
            const float inv = exp2f(-(float)(2 * i) * (1.f / 64.f) * 13.287712379549449f);
            const float g1k = kg[base + i], g2k = kg[base + i + 32];
            for (int row0 = gw; row0 < MR; row0 += 5 * NGW) {
                float x1[5][4], x2[5][4];
#pragma unroll
                for (int n = 0; n < 5; ++n) { const int row = row0 + n * NGW; const bf16* p = QKV + (size_t)(row < MR ? row : row0) * 3072 + 2048;
#pragma unroll
                    for (int s = 0; s < 4; ++s) { const bf16* ph = p + s * 128 + base + i; x1[n][s] = bf2f(ph[0]); x2[n][s] = bf2f(ph[32]); } }
#pragma unroll
                for (int n = 0; n < 5; ++n) { const int row = row0 + n * NGW; if (row >= MR) break;
                    const int r = row % RPB; const bool isl = r >= CTX; const int t = r - CTX;
                    float cs = 1.f, sn = 0.f;
                    if (isl) { const float pos = (float)((lane < 32) ? (t >> 6) : (t & 63)); sincos_rot(pos * inv, sn, cs); }
                    float q2[4];
#pragma unroll
                    for (int s = 0; s < 4; ++s) q2[s] = x1[n][s] * x1[n][s] + x2[n][s] * x2[n][s];
#pragma unroll
                    for (int o = 1; o < 64; o <<= 1) {
#pragma unroll
                        for (int s = 0; s < 4; ++s) q2[s] += shx(q2[s], o); }
#pragma unroll
                    for (int s = 0; s < 4; ++s) { const float rstd = 1.f / sqrtf(q2[s] * (1.f / 128.f) + EPS);
                        const float y1 = x1[n][s] * rstd * g1k, y2 = x2[n][s] * rstd * g2k;
                        const int dA = base + i, dB = dA + 32; const unsigned w = f8x4(y1 * cs - y2 * sn, y2 * cs + y1 * sn, 0.f, 0.f);
                        unsigned char* kq = K8B + (size_t)row * 512 + s * 128;
                        kq[((dA >> 6) << 6) + (((dA >> 3) & 1) << 5) + (((dA >> 4) & 3) << 3) + (dA & 7)] = (unsigned char)w;
                        kq[((dB >> 6) << 6) + (((dB >> 3) & 1) << 5) + (((dB >> 4) & 3) << 3) + (dB & 7)] = (unsigned char)(w >> 8); } }
            }
            for (int it0 = gw; it0 < 136 * 4 * 8; it0 += 3 * NGW) {
                u32x4 w0[3], w1[3];
#pragma unroll
                for (int n = 0; n < 3; ++n) { const int it_ = it0 + n * NGW; const int it = it_ < 136 * 4 * 8 ? it_ : it0; const int dc = it & 7, kvh = (it >> 3) & 3, rt = it >> 5; const int row = rt * 64 + lane;
                    const u32x4* srcv = (const u32x4*)(QKV + (size_t)row * 3072 + 2560 + kvh * 128 + dc * 16); w0[n] = srcv[0]; w1[n] = srcv[1]; }
#pragma unroll
                for (int n = 0; n < 3; ++n) { const int it = it0 + n * NGW; if (it >= 136 * 4 * 8) break;
                    const int dc = it & 7, kvh = (it >> 3) & 3, rt = it >> 5;
                    const unsigned ww[8] = {w0[n].x, w0[n].y, w0[n].z, w0[n].w, w1[n].x, w1[n].y, w1[n].z, w1[n].w};
                    const int kk5 = lane & 31, p = ((kk5 >> 2) & 1) * 32 + (lane >> 5) * 16 + (kk5 & 3) + 4 * (kk5 >> 3);
                    unsigned char* img = V8T + ((size_t)((rt / 68) * 4 + kvh) * 68 + rt % 68) * 8192 + (p & 15);
#pragma unroll
                    for (int e = 0; e < 8; ++e) { const unsigned f = f8x4(bflo(ww[e]), bfhi(ww[e]), 0.f, 0.f); const int d = dc * 16 + 2 * e;
                        img[d * 64 + (((p >> 4) ^ ((d >> 2) & 3)) << 4)] = (unsigned char)f; img[(d + 1) * 64 + (((p >> 4) ^ (((d + 1) >> 2) & 3)) << 4)] = (unsigned char)(f >> 8); } }
            }
        }
        if (kind == 0) SEAM(pb + 2);
        T1(4);
        T0(5);
        if (MIXON(Lr) && PHM(5) && IN(pb + 3) && kind == 0) { WS_LAUNDER();
            for (int it = vcu; it < 512 + (Lr == 3 ? 0 : 32); it += G) {
                const bool isl = it < 512; const int q = isl ? it : it - 512;
                const int qb = isl ? (q & 15) : 0, h = isl ? ((q >> 4) & 15) : (q & 15), b = isl ? (q >> 8) : (q >> 4), kvh = h >> 2;
                const bf16* base = QKV + (size_t)b * RPB * 3072; const int qrow0 = isl ? CTX + qb * 256 : 0;
                att::attn_body<3072>(base + (size_t)qrow0 * 3072 + h * 128, K8B + (size_t)b * RPB * 512 + kvh * 128, V8T + (size_t)(b * 4 + kvh) * 68 * 8192, OB + ((size_t)b * RPB + qrow0) * DM + h * 128, isl ? 68 : 4, a.a_q_gain + jj * 128, isl ? qb * 256 : -1, (char*)lds);
            }
        }
        if (MIXON(Lr) && PHM(12) && IN(pb + 3) && kind == 1) { WS_LAUNDER();
            float* bl = (float*)((char*)lds + att::SHM_ATTN);
            for (int it = vcu; it < 512 + 32; it += G) {
                const bool isl = it < 512; const int q = isl ? it : it - 512;
                const int qb = isl ? (q & 15) : 0, h = isl ? ((q >> 4) & 15) : (q & 15), b = isl ? (q >> 8) : (q >> 4);
                int kr_lo = qb * 4 - 4; kr_lo = kr_lo < 0 ? 0 : (kr_lo > 52 ? 52 : kr_lo);
                { const float* rp = a.b_rpb + (size_t)h * 465; for (int z = tid; z < 465; z += 512) bl[z] = rp[z] * (1.f / att::SCALE); __syncthreads(); }
                const bf16* base = QKV + (size_t)b * RPB * 6144; const int qrow0 = isl ? CTX + qb * 256 : 0;
                att::attn_na_body(base + (size_t)qrow0 * 6144 + h * 128, base + 2048 + h * 128, base + 4096 + h * 128, OB + ((size_t)b * RPB + qrow0) * DM + h * 128, kr_lo, qb * 4, bl, isl ? 16 : 4, (char*)lds);
            }
        }
        if (kind != 2) SEAM(pb + 3);
        T1(5);
        T0(6);
        if (MIXON(Lr) && PHM(6) && IN(pb + 4)) { WS_LAUNDER();
            const bool grp = kind == 2;
            pg8::Gemm g{(const bf16*)OB, (const bf16*)(grp ? PW : (kind == 0 ? AWO + (size_t)jj * DM * DM : BWO)), grp ? 4 * MR : MR, DM, grp ? 512 : DM};
            pg8::FlexOrder S; S.init(MR, DM, G, bx, grp ? 3 : 2); pg8::EpiResid E{X, modl, 2 * DM, grp ? a.pool_scale : nullptr, grp ? 34 : (1 << 20), HQ, SSQ, a.norm_w + (size_t)(Lr * 2 + 1) * DM, SXB, Lr == 0 ? a.x : nullptr, a.ctx};
            pg8::gemm_phase<pg8::EpiResid, pg8::FlexOrder, true, true>(L3, g, S, E);
            if (Lr != 3) {
                const CtxGemm cgm{OB, grp ? 512 : DM, grp ? (size_t)MR * 512 : 0, g.Bt, grp ? (size_t)512 * 512 : 0, grp ? 512 : DM, grp ? 8 : 32, 0, grp ? 4 : 1, grp ? 512 : 0};
                CtxEpi ce{}; ce.xres = X; ce.gate = modl + (size_t)2 * NMOD + 2 * DM; ce.ls = grp ? a.pool_scale : nullptr; ce.XQ = HQ; ce.ssq = SSQ; ce.w2 = a.norm_w + (size_t)(Lr * 2 + 1) * DM; ce.m4 = modl + (size_t)2 * NMOD + 4 * DM; ce.sxb = SXB; ce.xsrc = Lr == 0 ? a.ctx : nullptr;
                ctx_gemm<1, true, true>(cgm, vcu, G, (char*)lds, ce); }
        }
        SEAM(pb + 4); T1(6);
        T0(7);
        T1(7);
        T0(8);
        if (PEERON(Lr) && PHM(8) && IN(pb + 6)) { WS_LAUNDER();
            const signed char* Wt = PWQ8 + (size_t)Lr * DM * DM; const unsigned* cm = CMAX + 12288 + Lr * DM;
            pg8::Gemm g{(const bf16*)HQ, (const bf16*)Wt, MR, DM, DM}; pg8::FlexOrder S; S.init(MR, DM, G, bx, 2);
            LAS float* rs = (LAS float*)(L3 + 133120);
            { pg8::Unit u0; if (S.next(0, u0) && tid < 256) { const int row = u0.pm * 256 + tid; const float* q = SSQ + (size_t)row * 32; float t = 0.f;
#pragma unroll
                  for (int z = 0; z < 32; ++z) t += q[z];
                  rs[tid] = SXB[row] / sqrtf(t * (1.f / DM) + EPS); }
              __syncthreads(); }
            pg8::EpiPQ E{PQ, CVEC + (size_t)Lr * 3 * DM, rs, cm};
            pg8::gemm_phase<pg8::EpiPQ, pg8::FlexOrder, true>(L3, g, S, E);
            if (Lr != 3) { const CtxGemm cgm{HQ, DM, 0, Wt, 0, DM, 32, 0, 1, 0};
                CtxEpi ce{}; ce.O = PQ; ce.ldc = DM; ce.cmax = cm; ce.ssq_in = SSQ; ce.sxb_in = SXB; ce.cvec = CVEC + (size_t)(Lr * 3 + 2) * DM;
                ctx_gemm<0, true>(cgm, vcu, G, (char*)lds, ce); }
        }
        SEAM(pb + 6); T1(8);
        T0(9);

        T1(9);
        T0(10);
        if (PEERON(Lr) && PHM(10) && IN(pb + 8)) { WS_LAUNDER();
            constexpr int NS = 5, RSZ = RSZ_A, RSZB = RSZ_B;
            const GAS unsigned char* Ul = (const GAS unsigned char*)(U8 + (size_t)Lr * NEXP * DM); const GAS unsigned char* Vl = (const GAS unsigned char*)(V8 + (size_t)Lr * NEXP * DM);
            const GAS float* sul = (const GAS float*)(SU + (size_t)Lr * NEXP); const GAS float* svl = (const GAS float*)(SV + (size_t)Lr * NEXP);
            const int myx = ((lane & 1) << 2) | (lane & 2) | ((lane >> 2) & 1);
            const bool last = Lr == 3;
            const int TPB = last ? 32 : 34;
            {
            const int j32 = lane & 31, hi = lane >> 5;
            { const bf16* skg = SK + (size_t)Lr * 2 * 128 * 128;
              u32x4 skv[8];
#pragma unroll
              for (int i = 0; i < 8; ++i) { const int c = tid + 512 * i; skv[i] = *(const u32x4*)(skg + (size_t)(c >> 4) * 128 + (c & 15) * 8); }
#pragma unroll
              for (int i = 0; i < 8; ++i) { const int c = tid + 512 * i; const int row = c >> 4, ch = c & 15; *(u32x4*)((char*)lds + row * 256 + ((ch ^ (row & 7)) << 4)) = skv[i]; }
              __syncthreads(); }
            int* IDXL = (int*)((char*)lds + 65536); float* GATEL = (float*)((char*)lds + 65536 + 34 * 128 * 4);
            for (int task = wave; task < (TPB * 8 + 31) / 32; task += 8) {
                const int pidx = task * 32 + j32; const bool pvalid = pidx < TPB * 8; const int pc = pvalid ? pidx : TPB * 8 - 1;
                const int tl = pc >> 3, h = pc & 7; const int tgq = vcu * TPB + tl; const int tok = last ? tgq + 256 * (1 + tgq / 4096) : tgq;
                const bf16* qrow = PQ + (size_t)tok * DM + h * 256;
                bf16x8 qv[16];
#pragma unroll
                for (int ks = 0; ks < 8; ++ks) { qv[ks] = *(const bf16x8*)(qrow + ks * 16 + hi * 8); qv[8 + ks] = *(const bf16x8*)(qrow + 128 + ks * 16 + hi * 8); }
                f32x16 p1[4], p2[4];
#pragma unroll
                for (int kt = 0; kt < 4; ++kt) { p1[kt] = f32x16{}; p2[kt] = f32x16{}; }
#pragma unroll
                for (int ks = 0; ks < 8; ++ks) {
                    const int chb = ks * 2 + hi;
#pragma unroll
                    for (int kt = 0; kt < 4; ++kt) {
                        const int r1 = kt * 32 + j32, r2 = 128 + kt * 32 + j32;
                        const bf16x8 k1 = *(const bf16x8*)((const char*)lds + r1 * 256 + ((chb ^ (r1 & 7)) << 4));
                        const bf16x8 k2 = *(const bf16x8*)((const char*)lds + r2 * 256 + ((chb ^ (r2 & 7)) << 4));
                        p1[kt] = __builtin_amdgcn_mfma_f32_32x32x16_bf16(k1, qv[ks], p1[kt], 0, 0, 0);
                        p2[kt] = __builtin_amdgcn_mfma_f32_32x32x16_bf16(k2, qv[8 + ks], p2[kt], 0, 0, 0);
                    }
                }
                unsigned Lt[16];
#pragma unroll
                for (int kt = 0; kt < 4; ++kt) {
                    unsigned ta[16], tb[16];
#pragma unroll
                    for (int r = 0; r < 16; ++r) {
                        auto rr = __builtin_amdgcn_permlane32_swap(__float_as_uint(p1[kt][r]), __float_as_uint(p2[kt][r]), false, false);
                        ta[r] = (mono(__uint_as_float(rr[0])) & 0xFFFFFF80u) | (unsigned)(kt * 32 + att::crow(r, 0));
                        tb[r] = (mono(__uint_as_float(rr[1])) & 0xFFFFFF80u) | (unsigned)(kt * 32 + att::crow(r, 1));
                    }
                    sort16_desc(ta); sort16_desc(tb);
                    if (kt == 0) {
#pragma unroll
                        for (int q = 0; q < 16; ++q) Lt[q] = ta[q];
                    } else merge_top16(Lt, ta);
                    merge_top16(Lt, tb);
                }
                unsigned L1[16], L2[16]; float v1[16], v2[16];
#pragma unroll
                for (int q = 0; q < 16; ++q) { auto rr = __builtin_amdgcn_permlane32_swap(Lt[q], Lt[q], false, false); L1[q] = rr[0]; L2[q] = rr[1];
                    v1[q] = unmono(L1[q] & 0xFFFFFF80u); v2[q] = unmono(L2[q] & 0xFFFFFF80u); }
#define CK(ia, ib) ((mono(v1[ia] + v2[ib]) & 0xFFFFFF00u) | (unsigned)((ia) * 16 + (ib)))
                unsigned Cd[16];
#pragma unroll
                for (int q = 0; q < 16; ++q) Cd[q] = CK(0, q);
                { unsigned t[16];
#pragma unroll
                  for (int q = 0; q < 8; ++q) { t[q] = CK(1, q); t[8 + q] = CK(15 - q, 0); }
                  bmerge16_desc(t); merge_top16(Cd, t); }
                { unsigned t[16] = {CK(2, 0), CK(2, 1), CK(2, 2), CK(2, 3), CK(2, 4), CK(3, 0), CK(3, 1), CK(3, 2), CK(3, 3), CK(4, 0), CK(4, 1), CK(4, 2), CK(5, 0), CK(5, 1), CK(6, 0), CK(6, 1)};
                  sort16_desc(t); merge_top16(Cd, t); }
                INS16(Cd, CK(7, 0)); INS16(Cd, CK(7, 1));
#undef CK
                unsigned P1[4] = {0u, 0u, 0u, 0u}, P2[4] = {0u, 0u, 0u, 0u};
#pragma unroll
                for (int q = 0; q < 16; ++q) { P1[q >> 2] |= (L1[q] & 127u) << (8 * (q & 3)); P2[q >> 2] |= (L2[q] & 127u) << (8 * (q & 3)); }
                int eid[16];
#pragma unroll
                for (int q = 0; q < 16; ++q) {
                    const unsigned ia = (Cd[q] >> 4) & 15u, ib = Cd[q] & 15u;
                    const unsigned w1 = (ia >> 2) == 0 ? P1[0] : ((ia >> 2) == 1 ? P1[1] : ((ia >> 2) == 2 ? P1[2] : P1[3]));
                    const unsigned w2 = (ib >> 2) == 0 ? P2[0] : ((ib >> 2) == 1 ? P2[1] : ((ib >> 2) == 2 ? P2[2] : P2[3]));
                    eid[q] = (int)(((w1 >> (8 * (ia & 3))) & 127u) * 128u + ((w2 >> (8 * (ib & 3))) & 127u));
                }
                {
                    const float mx = unmono(Cd[0] & 0xFFFFFF00u); float ev[16], su = 0.f;
#pragma unroll
                    for (int q = 0; q < 16; ++q) { ev[q] = __expf(unmono(Cd[q] & 0xFFFFFF00u) - mx); su += ev[q]; }
                    const float inv = 1.f / su;
                    if (hi == 0 && pvalid) {
                        int* ip = IDXL + tl * 128 + h * 16; float* gp = GATEL + tl * 128 + h * 16;
#pragma unroll
                        for (int q = 0; q < 16; ++q) { ip[q] = eid[q]; gp[q] = ev[q] * inv; }
                    }
                }
            }
            }
            __syncthreads();
            const int* IDXL = (const int*)((const char*)lds + 65536); const float* GATEL = (const float*)((const char*)lds + 65536 + 34 * 128 * 4);
            int rowS[NS]; unsigned ka[NS], kb_[NS]; float ga[NS], gb[NS], cfa[NS], cfb[NS], sxs[NS]; int xq[NS][8]; int pos[NS], pbeg[NS], pend[NS];
#pragma unroll
            for (int sl = 0; sl < NS; ++sl) {
                const int ti = sl < 4 ? wave + 8 * sl : 32 + (wave >> 2);
                const bool have = sl < 4 || !last; const int tg = vcu * TPB + (have ? ti : 0);
                const int row = last ? tg + 256 * (1 + tg / 4096) : tg; rowS[sl] = have ? row : -1;
                pbeg[sl] = !have ? 128 : (sl < 4 ? 0 : 32 * (wave & 3)); pend[sl] = !have ? 128 : (sl < 4 ? 128 : 32 * (wave & 3) + 32);
                const int til = have ? ti : 0;
                unsigned k0 = ((unsigned)IDXL[til * 128 + lane] << 7) | (unsigned)lane, k1 = ((unsigned)IDXL[til * 128 + 64 + lane] << 7) | (unsigned)(64 + lane);
                const float g0 = GATEL[til * 128 + lane], g1 = GATEL[til * 128 + 64 + lane];
#pragma unroll
                for (int k = 2; k <= 128; k <<= 1)
#pragma unroll
                    for (int j = k >> 1; j > 0; j >>= 1) {
                        if (j == 64) { const unsigned lo_ = k0 < k1 ? k0 : k1, hi_ = k0 < k1 ? k1 : k0; k0 = lo_; k1 = hi_; }
                        else { const bool lower = (lane & j) == 0; const bool up0 = (lane & k) == 0, up1 = ((lane + 64) & k) == 0;
                            const unsigned o0 = (unsigned)(j == 1 ? lane_xor<1>((int)k0, lane) : j == 2 ? lane_xor<2>((int)k0, lane) : j == 4 ? lane_xor<4>((int)k0, lane) : j == 8 ? lane_xor<8>((int)k0, lane) : j == 16 ? lane_xor<16>((int)k0, lane) : lane_xor<32>((int)k0, lane));
                            const unsigned o1 = (unsigned)(j == 1 ? lane_xor<1>((int)k1, lane) : j == 2 ? lane_xor<2>((int)k1, lane) : j == 4 ? lane_xor<4>((int)k1, lane) : j == 8 ? lane_xor<8>((int)k1, lane) : j == 16 ? lane_xor<16>((int)k1, lane) : lane_xor<32>((int)k1, lane));
                            const unsigned mn0 = k0 < o0 ? k0 : o0, mx0 = k0 < o0 ? o0 : k0, mn1 = k1 < o1 ? k1 : o1, mx1 = k1 < o1 ? o1 : k1;
                            k0 = (lower == up0) ? mn0 : mx0; k1 = (lower == up1) ? mn1 : mx1; }
                    }
                { const int o0 = (int)(k0 & 127u), o1 = (int)(k1 & 127u);
                  const float a0 = __shfl(g0, o0 & 63), b0 = __shfl(g1, o0 & 63), a1 = __shfl(g0, o1 & 63), b1 = __shfl(g1, o1 & 63);
                  ga[sl] = o0 < 64 ? a0 : b0; gb[sl] = o1 < 64 ? a1 : b1; }
                ka[sl] = k0; kb_[sl] = k1; cfa[sl] = 0.f; cfb[sl] = 0.f; pos[sl] = pbeg[sl];
                float xf[32];
                { const int bq = row / RPB, rq = row % RPB, vq = rq < CTX ? 2 : bq; const float* mq = modl + (size_t)vq * NMOD; const float* w2 = a.norm_w + (size_t)(Lr * 2 + 1) * DM;
                  float t = lane < 32 ? SSQ[(size_t)row * 32 + lane] : 0.f; t = wave_sum(t); const float rstd = 1.f / sqrtf(t * (1.f / DM) + EPS);
#pragma unroll
                  for (int hf = 0; hf < 2; ++hf)
#pragma unroll
                      for (int q = 0; q < 4; ++q) { const int c = hf * 1024 + lane * 16 + q * 4;
                          const f32x4 xv = bf4(*(const u32x2*)(X + (size_t)row * DM + c)), wv = *(const f32x4*)(w2 + c), sc = *(const f32x4*)(mq + 4 * DM + c), sh = *(const f32x4*)(mq + 3 * DM + c);
                          const f32x4 f = (xv * rstd * wv) * (sc + 1.f) + sh; xf[hf * 16 + q * 4 + 0] = f.x; xf[hf * 16 + q * 4 + 1] = f.y; xf[hf * 16 + q * 4 + 2] = f.z; xf[hf * 16 + q * 4 + 3] = f.w; } }
                float am = 0.f;
#pragma unroll
                for (int q = 0; q < 32; ++q) am = fmaxf(am, fabsf(xf[q]));
#pragma unroll
                for (int o = 1; o < 64; o <<= 1) am = fmaxf(am, shx(am, o));
                am = fmaxf(am, 1e-30f); const float xinv = 127.f / am; sxs[sl] = am * (1.f / 127.f);
#pragma unroll
                for (int q = 0; q < 8; ++q) { const int q0 = (int)__builtin_rintf(xf[4 * q] * xinv), q1 = (int)__builtin_rintf(xf[4 * q + 1] * xinv), q2 = (int)__builtin_rintf(xf[4 * q + 2] * xinv), q3 = (int)__builtin_rintf(xf[4 * q + 3] * xinv);
                    xq[sl][q] = (int)((unsigned)(q0 & 255) | ((unsigned)(q1 & 255) << 8) | ((unsigned)(q2 & 255) << 16) | ((unsigned)(q3 & 255) << 24)); }
            }
            asm volatile("s_waitcnt vmcnt(0)" ::: "memory");
            __syncthreads();
            for (int hi_e = RSZ; hi_e <= NEXP; hi_e += RSZ) {
#pragma unroll
                for (int sl = 0; sl < NS; ++sl) {
                    while (pos[sl] < pend[sl] && (int)((unsigned)__builtin_amdgcn_readlane((int)(pos[sl] < 64 ? ka[sl] : kb_[sl]), pos[sl] & 63) >> 7) < hi_e) {
                        const int p0 = pos[sl]; const unsigned ksrc = p0 < 64 ? ka[sl] : kb_[sl]; const float gsrc = p0 < 64 ? ga[sl] : gb[sl]; const int kb = p0 & 63;
                        u32x4 uw[8][2];
#pragma unroll
                        for (int j = 0; j < 8; ++j) { const int e = (int)((unsigned)__builtin_amdgcn_readlane((int)ksrc, kb + j) >> 7);
                            const GAS u32x4* ur = (const GAS u32x4*)(Ul + (size_t)e * DM); uw[j][0] = ur[lane]; uw[j][1] = ur[64 + lane]; }
                        const int eo = (int)((unsigned)__shfl((int)ksrc, kb + myx) >> 7); const float go = __shfl(gsrc, kb + myx); const float suo = sul[eo], svo = svl[eo];
                        int p[8];
#pragma unroll
                        for (int j = 0; j < 8; ++j) { int d = 0;
                            d = __builtin_amdgcn_sdot4((int)uw[j][0].x, xq[sl][0], d, false); d = __builtin_amdgcn_sdot4((int)uw[j][0].y, xq[sl][1], d, false);
                            d = __builtin_amdgcn_sdot4((int)uw[j][0].z, xq[sl][2], d, false); d = __builtin_amdgcn_sdot4((int)uw[j][0].w, xq[sl][3], d, false);
                            d = __builtin_amdgcn_sdot4((int)uw[j][1].x, xq[sl][4], d, false); d = __builtin_amdgcn_sdot4((int)uw[j][1].y, xq[sl][5], d, false);
                            d = __builtin_amdgcn_sdot4((int)uw[j][1].z, xq[sl][6], d, false); d = __builtin_amdgcn_sdot4((int)uw[j][1].w, xq[sl][7], d, false);
                            p[j] = d; }
                        int q4[4], q2[2], q1;
#pragma unroll
                        for (int j = 0; j < 4; ++j) { const int snd = (lane & 1) ? p[j] : p[j + 4], kp = (lane & 1) ? p[j + 4] : p[j]; q4[j] = kp + shx(snd, 1); }
#pragma unroll
                        for (int j = 0; j < 2; ++j) { const int snd = (lane & 2) ? q4[j] : q4[j + 2], kp = (lane & 2) ? q4[j + 2] : q4[j]; q2[j] = kp + shx(snd, 2); }
                        { const int snd = (lane & 4) ? q2[0] : q2[1], kp = (lane & 4) ? q2[1] : q2[0]; q1 = kp + shx(snd, 4); }
                        q1 += shx(q1, 8); q1 += shx(q1, 16); q1 += shx(q1, 32);
                        const float cown = gelu_tanh((float)q1 * suo * sxs[sl]) * go * svo;
                        { const int dj = lane - kb; const int srcl = ((dj & 1) << 2) | (dj & 2) | ((dj >> 2) & 1); const float cv = __shfl(cown, srcl & 63);
                          const bool mine = (unsigned)dj < 8u;
                          if (p0 < 64) cfa[sl] = mine ? cv : cfa[sl]; else cfb[sl] = mine ? cv : cfb[sl]; }
                        pos[sl] = p0 + 8;
                    }
                }
            }
#pragma unroll 1
            for (int piece = 0; piece < 2; ++piece) {
                f32x2 acc[NS][8];
#pragma unroll
                for (int sl = 0; sl < NS; ++sl) { pos[sl] = pbeg[sl];
#pragma unroll
                    for (int q = 0; q < 8; ++q) acc[sl][q] = (f32x2){0.f, 0.f}; }
                for (int hi_e = RSZB; hi_e <= NEXP; hi_e += RSZB) {
#pragma unroll
                    for (int sl = 0; sl < NS; ++sl) {
                        while (pos[sl] < pend[sl] && (int)((unsigned)__builtin_amdgcn_readlane((int)(pos[sl] < 64 ? ka[sl] : kb_[sl]), pos[sl] & 63) >> 7) < hi_e) {
                            const int p0 = pos[sl]; const unsigned ksrc = p0 < 64 ? ka[sl] : kb_[sl]; const float csrc = p0 < 64 ? cfa[sl] : cfb[sl]; const int kb = p0 & 63;
                            u32x4 vw[16];
#pragma unroll
                            for (int j = 0; j < 16; ++j) { const int e = (int)((unsigned)__builtin_amdgcn_readlane((int)ksrc, kb + j) >> 7);
                                vw[j] = ((const GAS u32x4*)(Vl + (size_t)e * DM))[piece * 64 + lane]; }
#pragma unroll
                            for (int j = 0; j < 16; ++j) { const float cj = __uint_as_float(__builtin_amdgcn_readlane(__float_as_uint(csrc), kb + j));
                                const int w[4] = {(int)vw[j].x, (int)vw[j].y, (int)vw[j].z, (int)vw[j].w};
#pragma unroll
                                for (int q = 0; q < 4; ++q) { const f32x2 lo_ = __builtin_amdgcn_cvt_pk_f32_fp8(w[q], false), hi_ = __builtin_amdgcn_cvt_pk_f32_fp8(w[q], true);
                                    acc[sl][2 * q] = lo_ * cj + acc[sl][2 * q]; acc[sl][2 * q + 1] = hi_ * cj + acc[sl][2 * q + 1]; } }
                            pos[sl] = p0 + 16;
                        }
                    }
                }
                {
                    u32x4 xo[4][2]; f32x4 gvv[4][4];
#pragma unroll
                    for (int sl = 0; sl < 4; ++sl) {
                        const int row = rowS[sl]; const int b = row / RPB, r = row % RPB, v = r < CTX ? 2 : b; const float* g5 = modl + (size_t)v * NMOD + 5 * DM + piece * 1024 + lane * 16;
                        const u32x4* pp = (const u32x4*)(X + (size_t)row * DM + piece * 1024 + lane * 16); xo[sl][0] = pp[0]; xo[sl][1] = pp[1];
#pragma unroll
                        for (int q = 0; q < 4; ++q) gvv[sl][q] = *(const f32x4*)(g5 + q * 4); }
#pragma unroll
                    for (int sl = 0; sl < 4; ++sl) { u32x4 wo[2];
#pragma unroll
                        for (int q = 0; q < 4; ++q) { const u32x4 xw = xo[sl][q >> 1]; const f32x4 gv = gvv[sl][q];
                            f32x4 o = bf4((q & 1) ? (u32x2){xw.z, xw.w} : (u32x2){xw.x, xw.y}); o.x += gv.x * acc[sl][2 * q].x; o.y += gv.y * acc[sl][2 * q].y; o.z += gv.z * acc[sl][2 * q + 1].x; o.w += gv.w * acc[sl][2 * q + 1].y;
                            if (q & 1) { wo[q >> 1].z = pk2(o.x, o.y); wo[q >> 1].w = pk2(o.z, o.w); } else { wo[q >> 1].x = pk2(o.x, o.y); wo[q >> 1].y = pk2(o.z, o.w); } }
                        u32x4* pp = (u32x4*)(X + (size_t)rowS[sl] * DM + piece * 1024 + lane * 16); pp[0] = wo[0]; pp[1] = wo[1]; }
                }
                if (!last) {
                    float* Pq = (float*)lds;
#pragma unroll
                    for (int q = 0; q < 8; ++q) { Pq[(wave * 16 + 2 * q) * 64 + lane] = acc[4][q].x; Pq[(wave * 16 + 2 * q + 1) * 64 + lane] = acc[4][q].y; }
                    __syncthreads();
                    if ((wave & 3) == 0) {
                        const int row = rowS[4]; const int b = row / RPB, r = row % RPB, v = r < CTX ? 2 : b; const float* g5 = modl + (size_t)v * NMOD + 5 * DM; bf16* xr = X + (size_t)row * DM;
#pragma unroll
                        for (int q = 0; q < 4; ++q) { const int col = piece * 1024 + lane * 16 + q * 4; u32x2* pp = (u32x2*)(xr + col); const f32x4 gv = *(const f32x4*)(g5 + col); f32x4 o = bf4(*pp); float t4[4];
#pragma unroll
                            for (int e4 = 0; e4 < 4; ++e4) { const int qq = 4 * q + e4; t4[e4] = (Pq[((wave + 0) * 16 + qq) * 64 + lane] + Pq[((wave + 1) * 16 + qq) * 64 + lane]) + (Pq[((wave + 2) * 16 + qq) * 64 + lane] + Pq[((wave + 3) * 16 + qq) * 64 + lane]); }
                            o.x += gv.x * t4[0]; o.y += gv.y * t4[1]; o.z += gv.z * t4[2]; o.w += gv.w * t4[3]; *pp = (u32x2){pk2(o.x, o.y), pk2(o.z, o.w)}; }
                    }
                    __syncthreads();
                }
            }
            asm volatile("s_waitcnt vmcnt(0)" ::: "memory");
            u32x2 xraw[NS][8];
#pragma unroll
            for (int sl = 0; sl < NS; ++sl) { const u32x2* xr = (const u32x2*)(X + (size_t)(rowS[sl] >= 0 ? rowS[sl] : 0) * DM) + lane;
#pragma unroll
                for (int j = 0; j < 8; ++j) xraw[sl][j] = xr[64 * j]; }
#pragma unroll
            for (int sl = 0; sl < NS; ++sl) {
                if (sl == 4 && (last || (wave & 3) != 0)) continue;
                const int row = rowS[sl]; const int b = row / RPB, r = row % RPB, v = r < CTX ? 2 : b;
                if (!last) { const float* mvn = modv + (size_t)(Lr + 1) * 3 * NMOD + (size_t)v * NMOD;
                    norm_mod_row_q<true, true>(xraw[sl], a.norm_w + (size_t)((Lr + 1) * 2) * DM, mvn, mvn + DM, HQ + (size_t)row * DM, SA + row, a.norm_w + (size_t)((Lr + 1) * 2 + 1) * DM, mvn + 4 * DM, SXB + row, lane); }
                else { f32x4 vv[8]; float ss = 0.f;
#pragma unroll
                    for (int j = 0; j < 8; ++j) { vv[j] = bf4(xraw[sl][j]); ss += (vv[j].x * vv[j].x + vv[j].y * vv[j].y) + (vv[j].z * vv[j].z + vv[j].w * vv[j].w); }
                    const float rstd = 1.f / sqrtf(wave_sum(ss) * (1.f / DM) + EPS);
                    f32x4* o = (f32x4*)(a.out + ((size_t)b * SEQ + (r - CTX)) * DM) + lane;
#pragma unroll
                    for (int j = 0; j < 8; ++j) { const f32x4 wv = *((const f32x4*)a.final_norm_w + lane + 64 * j); o[64 * j] = vv[j] * rstd * wv; } }
            }
        }
        SEAM(pb + 8); T1(10);
    }
    if (TMASK != 0) { __syncthreads(); if (blockIdx.x == 0 && threadIdx.x == 0) { asm volatile("s_waitcnt vmcnt(0)" ::: "memory"); a.out[0] += (float)tacc * (0.01f / TSCALE); } }
#undef IN
#undef SEAM
}

extern "C" void kernel_launch(void* const* d_in, const int* in_sizes, int n_in, void* d_out, int out_size, void* d_ws, size_t ws_size, hipStream_t stream) {
    static int grid = 0;
    if (grid == 0) {
        if (n_in != 21 || out_size != NB * SEQ * DM || ws_size < WS_END) { fprintf(stderr, "kernel_launch: unexpected shapes (n_in %d out %d ws %zu)\n", n_in, out_size, ws_size); grid = -1; return; }
        int dev = 0, cus = 0, per_cu = 0;
        if (hipGetDevice(&dev) != hipSuccess || hipDeviceGetAttribute(&cus, hipDeviceAttributeMultiprocessorCount, dev) != hipSuccess) { grid = -1; return; }
        if (hipFuncSetAttribute((const void*)fwd_kernel, hipFuncAttributeMaxDynamicSharedMemorySize, LDS_BYTES) != hipSuccess) { fprintf(stderr, "kernel_launch: hipFuncSetAttribute failed\n"); grid = -1; return; }
        if (hipOccupancyMaxActiveBlocksPerMultiprocessor(&per_cu, (const void*)fwd_kernel, 512, LDS_BYTES) != hipSuccess || per_cu < 1) { fprintf(stderr, "kernel_launch: occupancy query reports %d\n", per_cu); (void)hipGetLastError(); grid = -1; return; }
        grid = cus;
    }
    if (grid < 0) return;
    (void)hipMemsetAsync((char*)d_ws + WS_CTL + 4096 * sizeof(unsigned), 0, 160 * 1024 - 4096 * sizeof(unsigned), stream);
    Args a{};
    const float** f = (const float**)&a;
    for (int i = 0; i < 21; ++i) f[i] = (const float*)d_in[i];
    a.out = (float*)d_out; a.ws = (unsigned char*)d_ws;
#if ONE_LAUNCH
    a.ph_lo = 0; a.ph_hi = NPHASE - 1;
    hipLaunchKernelGGL(fwd_kernel, dim3(grid), dim3(512), LDS_BYTES, stream, a);
#else
    for (int p = 0; p < NPHASE; ++p) {
        if (p == NPHASE - 1) continue;
        if (p >= 2 && p < NPHASE - 1) { const int L = (p - 2) / 9, k = (p - 2) % 9, kind = L % 3; if ((k == 2 && kind != 0) || (k == 3 && kind == 2) || (k == 0 && L > 0)) continue; }
        a.ph_lo = p; a.ph_hi = p + 1;
        hipLaunchKernelGGL(fwd_kernel, dim3(grid), dim3(512), LDS_BYTES, stream, a);
    }
#endif
}
```
